# Optimizing an MI355X kernel written in HIP

```python
import jax
import jax.numpy as jnp
from jax import lax
import numpy as np

D_MODEL = 1024
BATCH = 16
SEQ = 2048
DEPTH = 1

MIX_WIDTH = D_MODEL
N_ATTN_HEADS = 8
ATTN_HEAD_DIM = 64
N_KV_HEADS = 2
N_IDX_HEADS = 4
IDX_HEAD_DIM = 64
TOPK_KEYS = 256
Q_BLOCK = 128
N_GLA_HEADS = 4
GLA_KEY_DIM = 64
GLA_VAL_DIM = 128
GLA_GATE_RANK = 16
GLA_GATE_TAU = 16.0
GLA_CHUNK = 64
ROPE_THETA = 500000.0
ROPE_FRACTION = 4
N_EXPERTS = 256
N_EXPERT_GROUPS = 8
TOPK_GROUPS = 4
TOPK_EXPERTS = 8
EXPERT_DIM = 256
ROUTED_SCALE = 2.5
EXPERT_BLOCK = 128
NORM_EPS = 1e-6
IN_SIZES = (
    N_ATTN_HEADS * ATTN_HEAD_DIM,
    N_KV_HEADS * ATTN_HEAD_DIM,
    N_KV_HEADS * ATTN_HEAD_DIM,
    N_IDX_HEADS * IDX_HEAD_DIM,
    IDX_HEAD_DIM,
    N_IDX_HEADS,
    N_GLA_HEADS * GLA_KEY_DIM,
    N_GLA_HEADS * GLA_KEY_DIM,
    N_GLA_HEADS * GLA_VAL_DIM,
    GLA_GATE_RANK,
    N_GLA_HEADS * GLA_VAL_DIM,
)
IN_WIDTH = sum(IN_SIZES)

kernel_name = 'hybrid_dsa_gla_moe_block'


def rms_norm(x, w):
    xf = x.astype(jnp.float32)
    y = xf * lax.rsqrt(jnp.mean(xf * xf, axis=-1, keepdims=True) + NORM_EPS)
    return (y * w.astype(jnp.float32)).astype(x.dtype)


def partial_rope(x, positions):
    d = x.shape[-1]
    rot = d // ROPE_FRACTION
    half = rot // 2
    inv_freq = jnp.power(jnp.float32(ROPE_THETA), -jnp.arange(half, dtype=jnp.float32) / half)
    ang = positions.astype(jnp.float32)[:, :, None, None] * inv_freq
    cos, sin = jnp.cos(ang), jnp.sin(ang)
    xf = x.astype(jnp.float32)
    x1, x2, xp = xf[..., :half], xf[..., half:rot], xf[..., rot:]
    out = jnp.concatenate([x1 * cos - x2 * sin, x2 * cos + x1 * sin, xp], axis=-1)
    return out.astype(x.dtype)


def dsa_attention(q, k, v, q_idx, k_idx, w_idx):
    B, S, H, dh = q.shape
    n_sel = min(TOPK_KEYS, S // 4)
    n_blk = S // Q_BLOCK
    rep = H // N_KV_HEADS
    key_pos = jnp.arange(S, dtype=jnp.int32)
    gather_rows = jax.vmap(lambda a, i: a[i])

    def to_blocks(a):
        return jnp.swapaxes(a.reshape((B, n_blk, Q_BLOCK) + a.shape[2:]), 0, 1)

    def block(args):
        qb, qib, wib, blk = args
        q_pos = blk * Q_BLOCK + jnp.arange(Q_BLOCK, dtype=jnp.int32)
        dots = jnp.einsum('bqhd,bsd->bqhs', qib, k_idx, preferred_element_type=jnp.float32)
        score = jnp.einsum('bqh,bqhs->bqs', wib.astype(jnp.float32), jax.nn.relu(dots))
        score = jnp.where((key_pos[None, :] <= q_pos[:, None])[None], score, -jnp.inf)
        _, sel = lax.top_k(score, n_sel)
        valid = sel <= q_pos[None, :, None]
        k_sel = gather_rows(k, sel)
        v_sel = gather_rows(v, sel)
        qg = qb.reshape(B, Q_BLOCK, N_KV_HEADS, rep, dh)
        logits = jnp.einsum('bqgrd,bqkgd->bqgrk', qg, k_sel,
                            preferred_element_type=jnp.float32) * (dh ** -0.5)
        logits = jnp.where(valid[:, :, None, None, :], logits, -jnp.inf)
        p = jax.nn.softmax(logits, axis=-1).astype(v.dtype)
        o = jnp.einsum('bqgrk,bqkgd->bqgrd', p, v_sel)
        return o.reshape(B, Q_BLOCK, H, dh)

    out = lax.map(block, (to_blocks(q), to_blocks(q_idx), to_blocks(w_idx),
                          jnp.arange(n_blk, dtype=jnp.int32)))
    return jnp.swapaxes(out, 0, 1).reshape(B, S, H, dh)


def gla_chunked(q, k, v, log_a):
    B, S, H, dk = q.shape
    dv = v.shape[-1]
    n = S // GLA_CHUNK

    def chunks(a):
        return a.astype(jnp.float32).reshape(B, n, GLA_CHUNK, H, a.shape[-1]).transpose(1, 0, 3, 2, 4)

    qc = chunks(q) * (dk ** -0.5)
    kc, vc, gc = chunks(k), chunks(v), chunks(log_a)
    tri = jnp.tril(jnp.ones((GLA_CHUNK, GLA_CHUNK), dtype=bool))[:, :, None]

    def step(state, inp):
        qb, kb, vb, gb = inp
        b = jnp.cumsum(gb, axis=2)
        diff = jnp.where(tri, b[:, :, :, None, :] - b[:, :, None, :, :], -jnp.inf)
        a = jnp.einsum('bhtsd,bhsd->bhts', qb[:, :, :, None, :] * jnp.exp(diff), kb)
        intra = jnp.einsum('bhts,bhsv->bhtv', a, vb)
        inter = jnp.einsum('bhtd,bhdv->bhtv', qb * jnp.exp(b), state)
        b_end = b[:, :, -1, :]
        new_state = state * jnp.exp(b_end)[..., None] + jnp.einsum(
            'bhsd,bhsv->bhdv', kb * jnp.exp(b_end[:, :, None, :] - b), vb)
        return new_state, intra + inter

    _, o = lax.scan(step, jnp.zeros((B, H, dk, dv), jnp.float32), (qc, kc, vc, gc))
    return o.transpose(1, 0, 3, 2, 4).reshape(B, S, H, dv)


def moe_ffn(h, w_router, b_router, we_gate, we_up, we_down, ws_gate, ws_up, ws_down):
    B, S, D = h.shape
    T = B * S
    xt = h.reshape(T, D)
    per_group = N_EXPERTS // N_EXPERT_GROUPS
    scores = jax.nn.sigmoid(jnp.einsum('td,de->te', xt, w_router, preferred_element_type=jnp.float32))
    biased = scores + b_router.astype(jnp.float32)
    group_score = lax.top_k(biased.reshape(T, N_EXPERT_GROUPS, per_group), 2)[0].sum(-1)
    _, top_groups = lax.top_k(group_score, TOPK_GROUPS)
    group_mask = jnp.any(top_groups[:, :, None] == jnp.arange(N_EXPERT_GROUPS)[None, None, :], axis=1)
    masked = jnp.where(jnp.repeat(group_mask, per_group, axis=1), biased, -jnp.inf)
    _, sel = lax.top_k(masked, TOPK_EXPERTS)
    w = jnp.take_along_axis(scores, sel, axis=-1)
    w = w / jnp.sum(w, axis=-1, keepdims=True) * ROUTED_SCALE
    M = EXPERT_BLOCK
    A = T * TOPK_EXPERTS
    e_flat = sel.reshape(A)
    tok_flat = jnp.repeat(jnp.arange(T, dtype=jnp.int32), TOPK_EXPERTS)
    w_flat = w.reshape(A)
    order = jnp.argsort(e_flat)
    e_sorted, tok_sorted, w_sorted = e_flat[order], tok_flat[order], w_flat[order]
    counts = jnp.zeros((N_EXPERTS,), jnp.int32).at[e_flat].add(1)
    padded = (counts + M - 1) // M * M
    pad_end = jnp.cumsum(padded)
    pad_start = pad_end - padded
    start = jnp.cumsum(counts) - counts
    dest = pad_start[e_sorted] + jnp.arange(A, dtype=jnp.int32) - start[e_sorted]
    n_rows = (A + M - 1) // M * M + N_EXPERTS * M
    n_blocks = n_rows // M
    buf_tok = jnp.full((n_rows,), T, jnp.int32).at[dest].set(tok_sorted)
    buf_w = jnp.zeros((n_rows,), jnp.float32).at[dest].set(w_sorted)
    blk_expert = jnp.minimum(
        jnp.searchsorted(pad_end, jnp.arange(n_blocks, dtype=jnp.int32) * M, side='right'),
        N_EXPERTS - 1)
    x_pad = jnp.concatenate([xt, jnp.zeros((1, D), xt.dtype)], axis=0)
    xb = x_pad[buf_tok].reshape(n_blocks, M, D)

    def expert_block(args):
        xblk, e = args
        return (jax.nn.silu(xblk @ we_gate[e]) * (xblk @ we_up[e])) @ we_down[e]

    yb = lax.map(expert_block, (xb, blk_expert)).reshape(n_rows, D)
    routed = jax.ops.segment_sum(yb * buf_w[:, None].astype(yb.dtype), buf_tok,
                                 num_segments=T + 1)[:T]
    shared = (jax.nn.silu(xt @ ws_gate) * (xt @ ws_up)) @ ws_down
    return (routed + shared).reshape(B, S, D)


def setup_inputs(seed: int = 0) -> dict:
    key = jax.random.key(seed)
    ks = jax.random.split(key, 24)
    f32 = jnp.float32
    L, D = DEPTH, D_MODEL

    def nrm(k, shape, scale):
        return jax.random.normal(k, shape, f32) * scale

    def gain(k, shape):
        return 1.0 + 0.02 * jax.random.normal(k, shape, f32)

    x = nrm(ks[0], (BATCH, SEQ, D), 1.0)
    c = nrm(ks[1], (BATCH, D), 1.0)
    offsets = jax.random.randint(ks[2], (BATCH, 1), 0, 4096, dtype=jnp.int32)
    positions = offsets + jnp.arange(SEQ, dtype=jnp.int32)[None, :]
    return {
        'x': x,
        'c': c,
        'positions': positions,
        'norm1_w': gain(ks[3], (L, D)),
        'norm2_w': gain(ks[4], (L, D)),
        'w_ada': nrm(ks[5], (L, D, 6 * D), 0.5 * D ** -0.5),
        'b_ada': nrm(ks[6], (L, 6 * D), 0.01),
        'w_in': nrm(ks[7], (L, D, IN_WIDTH), D ** -0.5),
        'q_norm_w': gain(ks[8], (L, ATTN_HEAD_DIM)),
        'k_norm_w': gain(ks[9], (L, ATTN_HEAD_DIM)),
        'attn_out_norm_w': gain(ks[10], (L, N_ATTN_HEADS, ATTN_HEAD_DIM)),
        'w_gk2': nrm(ks[11], (L, GLA_GATE_RANK, N_GLA_HEADS * GLA_KEY_DIM), GLA_GATE_RANK ** -0.5),
        'b_gk': nrm(ks[12], (L, N_GLA_HEADS * GLA_KEY_DIM), 0.1),
        'gla_norm_w': gain(ks[13], (L, N_GLA_HEADS, GLA_VAL_DIM)),
        'w_out': nrm(ks[14], (L, MIX_WIDTH, D), MIX_WIDTH ** -0.5),
        'w_router': nrm(ks[15], (L, D, N_EXPERTS), D ** -0.5),
        'b_router': nrm(ks[16], (L, N_EXPERTS), 0.01),
        'we_gate': nrm(ks[17], (L, N_EXPERTS, D, EXPERT_DIM), D ** -0.5),
        'we_up': nrm(ks[18], (L, N_EXPERTS, D, EXPERT_DIM), D ** -0.5),
        'we_down': nrm(ks[19], (L, N_EXPERTS, EXPERT_DIM, D), EXPERT_DIM ** -0.5),
        'ws_gate': nrm(ks[20], (L, D, EXPERT_DIM), D ** -0.5),
        'ws_up': nrm(ks[21], (L, D, EXPERT_DIM), D ** -0.5),
        'ws_down': nrm(ks[22], (L, EXPERT_DIM, D), EXPERT_DIM ** -0.5),
    }


def reference(x, c, positions, norm1_w, norm2_w, w_ada, b_ada, w_in, q_norm_w, k_norm_w,
              attn_out_norm_w, w_gk2, b_gk, gla_norm_w, w_out, w_router, b_router,
              we_gate, we_up, we_down, ws_gate, ws_up, ws_down):
    B, S, D = x.shape
    split_at = np.cumsum(IN_SIZES)[:-1].tolist()
    cond = jax.nn.silu(c.astype(jnp.float32))
    for l in range(DEPTH):
        mod = (cond @ w_ada[l].astype(jnp.float32) + b_ada[l].astype(jnp.float32)).astype(x.dtype)
        sh1, sc1, g1, sh2, sc2, g2 = [m[:, None, :] for m in jnp.split(mod, 6, axis=-1)]
        h = rms_norm(x, norm1_w[l]) * (1 + sc1) + sh1
        proj = h @ w_in[l]
        qa, ka, va, qi, ki, wi, qg, kg, vg, gk, go = jnp.split(proj, split_at, axis=-1)
        qa = partial_rope(rms_norm(qa.reshape(B, S, N_ATTN_HEADS, ATTN_HEAD_DIM), q_norm_w[l]), positions)
        ka = partial_rope(rms_norm(ka.reshape(B, S, N_KV_HEADS, ATTN_HEAD_DIM), k_norm_w[l]), positions)
        va = va.reshape(B, S, N_KV_HEADS, ATTN_HEAD_DIM)
        qi = partial_rope(qi.reshape(B, S, N_IDX_HEADS, IDX_HEAD_DIM), positions)
        ki = partial_rope(ki.reshape(B, S, 1, IDX_HEAD_DIM), positions)[:, :, 0, :]
        wi = wi * ((N_IDX_HEADS * IDX_HEAD_DIM) ** -0.5)
        attn = dsa_attention(qa, ka, va, qi, ki, wi)
        attn = rms_norm(attn, attn_out_norm_w[l]).reshape(B, S, N_ATTN_HEADS * ATTN_HEAD_DIM)
        log_a = jax.nn.log_sigmoid((gk @ w_gk2[l] + b_gk[l]).astype(jnp.float32)) / GLA_GATE_TAU
        o = gla_chunked(qg.reshape(B, S, N_GLA_HEADS, GLA_KEY_DIM),
                        kg.reshape(B, S, N_GLA_HEADS, GLA_KEY_DIM),
                        vg.reshape(B, S, N_GLA_HEADS, GLA_VAL_DIM),
                        log_a.reshape(B, S, N_GLA_HEADS, GLA_KEY_DIM))
        gla = rms_norm(o.astype(x.dtype), gla_norm_w[l]).reshape(B, S, N_GLA_HEADS * GLA_VAL_DIM)
        gla = gla * jax.nn.silu(go)
        mixed = jnp.concatenate([attn, gla], axis=-1) @ w_out[l]
        x = x + g1 * mixed
        h2 = rms_norm(x, norm2_w[l]) * (1 + sc2) + sh2
        x = x + g2 * moe_ffn(h2, w_router[l], b_router[l], we_gate[l], we_up[l], we_down[l],
                             ws_gate[l], ws_up[l], ws_down[l])
    return x
```

```cpp
#include <hip/hip_runtime.h>
#include <hip/hip_bf16.h>
#include <cstdio>
#include <cstdint>

#define D_MODEL 1024
#define BATCH 16
#define SEQ 2048
#define NTOK (BATCH * SEQ)
#define IN_WIDTH 2644
#define NEXP 256
#define EDIM 256
#define TOPK 8
#define NASSIGN (NTOK * TOPK)

#define C_QA 0
#define C_KA 512
#define C_VA 640
#define C_QI 768
#define C_KI 1024
#define C_WI 1088
#define C_QG 1092
#define C_KG 1348
#define C_VG 1604
#define C_GK 2116
#define C_GO 2132

struct P {
  const float* x; const float* c; const int* pos; const float* norm1_w; const float* norm2_w;
  const float* w_ada; const float* b_ada; const float* w_in; const float* q_norm_w; const float* k_norm_w;
  const float* attn_out_norm_w; const float* w_gk2; const float* b_gk; const float* gla_norm_w;
  const float* w_out; const float* w_router; const float* b_router;
  const float* we_gate; const float* we_up; const float* we_down;
  const float* ws_gate; const float* ws_up; const float* ws_down;
  float* out;
  float* mod;
  float* bufA;
  float* proj;
  float* h2;
  float* act_s;
  float* rscore;
  float* qa; float* ka; float* qi; float* ki; float* wi; float* log_a;
  float* scores;
  float* act;
  unsigned* mask;
  int* sel; float* selw; int* counts; int* offsets; int* cursor; int* list;
};

__device__ __forceinline__ float silu_f(float v) { return v / (1.f + expf(-v)); }
__device__ __forceinline__ float wave_sum(float v) {
#pragma unroll
  for (int o = 32; o > 0; o >>= 1) v += __shfl_xor(v, o);
  return v;
}
__device__ __forceinline__ float wave_max(float v) {
#pragma unroll
  for (int o = 32; o > 0; o >>= 1) v = fmaxf(v, __shfl_xor(v, o));
  return v;
}

typedef unsigned short bf16_t;
typedef short bf16x8 __attribute__((ext_vector_type(8)));
typedef float f32x16 __attribute__((ext_vector_type(16)));
typedef float f32x4v __attribute__((ext_vector_type(4)));
typedef float f32x2v __attribute__((ext_vector_type(2)));
typedef __bf16 bf16x2v __attribute__((ext_vector_type(2)));
typedef unsigned u32x4 __attribute__((ext_vector_type(4)));
typedef unsigned u32x2 __attribute__((ext_vector_type(2)));
#define LDSP __attribute__((address_space(3)))
#define NTHR 512
#define LCAP 32768
#define LDS_BYTES 163840
#define ATT_C2 (0.125f * 1.4426950408889634f)

#define D_QA 0
#define D_KA 512
#define D_VA 640
#define D_QI 768
#define D_KI 1024
#define D_MISC 1088
#define D_QG 1152
#define D_KG 1408
#define D_VG 1664
#define D_GO 2176
#define NP 2688

__device__ __forceinline__ unsigned pk_bf16(float lo, float hi) { f32x2v v = {lo, hi}; bf16x2v b = __builtin_convertvector(v, bf16x2v); return __builtin_bit_cast(unsigned, b); }
typedef int v8i_t __attribute__((ext_vector_type(8)));
typedef int v4i_t __attribute__((ext_vector_type(4)));
__device__ __forceinline__ unsigned pk4_fp8(float a, float b, float c, float d) {
  a = __builtin_amdgcn_fmed3f(a, -448.f, 448.f); b = __builtin_amdgcn_fmed3f(b, -448.f, 448.f);
  c = __builtin_amdgcn_fmed3f(c, -448.f, 448.f); d = __builtin_amdgcn_fmed3f(d, -448.f, 448.f);
  int w = __builtin_amdgcn_cvt_pk_fp8_f32(a, b, 0, false);
  w = __builtin_amdgcn_cvt_pk_fp8_f32(c, d, w, true);
  return (unsigned)w;
}
__device__ __forceinline__ float bf_lo(unsigned w) { return __uint_as_float(w << 16); }
__device__ __forceinline__ float bf_hi(unsigned w) { return __uint_as_float(w & 0xffff0000u); }

struct Q;
struct Q {
  P p;
  bf16_t* wt_in;
  bf16_t* wt_out;
  bf16_t* wt_router;
  bf16_t* h1;
  float* rope;
  bf16_t* proj2;
  float* misc;
  bf16_t* mixer;
  bf16_t* h2;
  unsigned char* wgu8;
  unsigned char* h2f8;
  unsigned char* wd8;
  unsigned char* ybuf;
  int* list;
  unsigned char* actg;
  unsigned* barw;
  int* ictr;
  int ph_lo, ph_hi;
};
typedef const __attribute__((address_space(4))) Q CQ;
typedef const __attribute__((address_space(4))) P CP;


__device__ __forceinline__ int win_src(int n) {
  if (n < D_MISC) return n;
  if (n < D_MISC + 4) return C_WI + (n - D_MISC);
  if (n < D_MISC + 20) return C_GK + (n - D_MISC - 4);
  if (n < D_QG) return -1;
  if (n < D_VG + 512) return C_QG + (n - D_QG);
  return C_GO + (n - D_GO);
}

template <class F>
__device__ __forceinline__ void conv_tile(const F& f, int k0, bf16_t* dst, int ldd, int nd0, LDSP float* T, int tid) {
  {
    const int j4 = (tid & 15) * 4;
    int ld; const float* pcol = f(j4, ld);
#pragma unroll
    for (int hh = 0; hh < 2; ++hh) {
      const int kr = (tid >> 4) + hh * 32;
      float4 v = make_float4(0.f, 0.f, 0.f, 0.f);
      if (pcol) v = *(const float4*)(pcol + (size_t)(k0 + kr) * ld);
      T[kr * 65 + j4 + 0] = v.x; T[kr * 65 + j4 + 1] = v.y; T[kr * 65 + j4 + 2] = v.z; T[kr * 65 + j4 + 3] = v.w;
    }
  }
  __syncthreads();
  {
    const int n = tid >> 3, kc = tid & 7;
    float v[8];
#pragma unroll
    for (int i = 0; i < 8; ++i) v[i] = T[(kc * 8 + i) * 65 + n];
    u32x4 w; w.x = pk_bf16(v[0], v[1]); w.y = pk_bf16(v[2], v[3]); w.z = pk_bf16(v[4], v[5]); w.w = pk_bf16(v[6], v[7]);
    *(u32x4*)(dst + (size_t)(nd0 + n) * ldd + k0 + kc * 8) = w;
  }
  __syncthreads();
}

struct SrcWin { const float* w; __device__ __forceinline__ const float* operator()(int j4, int& ld) const { ld = IN_WIDTH; return nullptr; } };

__device__ __forceinline__ void phase0(CQ& q, LDSP char* lds, int tid) {
  CP& p = q.p;
  const int G = gridDim.x, bid = blockIdx.x;
  for (int item = bid; item < 96; item += G) {
    LDSP float* cond = (LDSP float*)lds;
    LDSP float* red = (LDSP float*)(lds + 65536);
    for (int i = tid; i < 16 * 1024; i += NTHR) { const int b = i >> 10, k = i & 1023; cond[k * 16 + b] = silu_f(p.c[i]); }
    __syncthreads();
    const int kg = tid >> 6, cl = tid & 63, col = item * 64 + cl;
    float acc[16];
#pragma unroll
    for (int b = 0; b < 16; ++b) acc[b] = 0.f;
    for (int k = kg * 128; k < kg * 128 + 128; ++k) {
      const float w = p.w_ada[(size_t)k * 6144 + col];
#pragma unroll
      for (int b4 = 0; b4 < 4; ++b4) {
        const f32x4v cv = *(LDSP const f32x4v*)(cond + k * 16 + b4 * 4);
        acc[b4 * 4 + 0] += cv[0] * w; acc[b4 * 4 + 1] += cv[1] * w; acc[b4 * 4 + 2] += cv[2] * w; acc[b4 * 4 + 3] += cv[3] * w;
      }
    }
#pragma unroll
    for (int b = 0; b < 16; ++b) red[(kg * 16 + b) * 64 + cl] = acc[b];
    __syncthreads();
    for (int o = tid; o < 1024; o += NTHR) {
      const int b = o >> 6, c2 = o & 63;
      float s = 0.f;
#pragma unroll
      for (int g = 0; g < 8; ++g) s += red[(g * 16 + b) * 64 + c2];
      p.mod[b * 6144 + item * 64 + c2] = s + p.b_ada[item * 64 + c2];
    }
    __syncthreads();
  }
  LDSP float* T = (LDSP float*)lds;
  const int n_in = 16 * 42, n_out = 16 * 16, n_rt = 16 * 4;
  const int total = n_in + n_out + n_rt;
  for (int it = (bid + G - 96 % G) % G; it < total; it += G) {
    if (it < n_in) {
      const int kt = it / 42, nt = it % 42;
      const float* w = p.w_in;
      auto f = [w, nt](int j4, int& ld) -> const float* { ld = IN_WIDTH; const int s = win_src(nt * 64 + j4); return s < 0 ? nullptr : w + s; };
      conv_tile(f, kt * 64, q.wt_in, 1024, nt * 64, T, tid);
    } else if (it < n_in + n_out) {
      const int i2 = it - n_in; const int kt = i2 / 16, nt = i2 % 16;
      const float* w = p.w_out;
      auto f = [w, nt](int j4, int& ld) -> const float* { ld = 1024; return w + nt * 64 + j4; };
      conv_tile(f, kt * 64, q.wt_out, 1024, nt * 64, T, tid);
    } else {
      const int i2 = it - n_in - n_out; const int kt = i2 / 4, nt = i2 % 4;
      const float* w = p.w_router;
      auto f = [w, nt](int j4, int& ld) -> const float* { ld = 256; return w + nt * 64 + j4; };
      conv_tile(f, kt * 64, q.wt_router, 1024, nt * 64, T, tid);
    }
  }
}

__device__ __forceinline__ void phase1(CQ& q, int tid) {
  CP& p = q.p;
  const int lane = tid & 63, wv = tid >> 6;
  const int nwv = gridDim.x * 8;
  for (int t0 = (blockIdx.x * 8 + wv) * 2; t0 < NTOK; t0 += nwv * 2) {
    float4 v[2][4];
#pragma unroll
    for (int u = 0; u < 2; ++u)
#pragma unroll
      for (int i = 0; i < 4; ++i) v[u][i] = *(const float4*)(p.x + (size_t)(t0 + u) * D_MODEL + i * 256 + lane * 4);
#pragma unroll
    for (int u = 0; u < 2; ++u) {
      const int t = t0 + u;
      const int b = t / SEQ;
      float ss = 0.f;
#pragma unroll
      for (int i = 0; i < 4; ++i) ss += v[u][i].x * v[u][i].x + v[u][i].y * v[u][i].y + v[u][i].z * v[u][i].z + v[u][i].w * v[u][i].w;
      ss = wave_sum(ss);
      const float r = rsqrtf(ss / D_MODEL + 1e-6f);
      const float* md = p.mod + b * 6144;
#pragma unroll
      for (int i = 0; i < 4; ++i) {
        const int d = i * 256 + lane * 4;
        const float4 w = *(const float4*)(p.norm1_w + d);
        const float4 sh = *(const float4*)(md + 0 + d);
        const float4 sc = *(const float4*)(md + 1024 + d);
        u32x2 w2; w2.x = pk_bf16(v[u][i].x * r * w.x * (1.f + sc.x) + sh.x, v[u][i].y * r * w.y * (1.f + sc.y) + sh.y);
        w2.y = pk_bf16(v[u][i].z * r * w.z * (1.f + sc.z) + sh.z, v[u][i].w * r * w.w * (1.f + sc.w) + sh.w);
        *(u32x2*)(q.h1 + (size_t)t * D_MODEL + d) = w2;
      }
      if (lane < 8) {
        const float inv_freq = powf(500000.0f, -(float)lane / 8.0f);
        const float ang = (float)p.pos[t] * inv_freq;
        q.rope[(size_t)t * 16 + lane] = cosf(ang);
        q.rope[(size_t)t * 16 + 8 + lane] = sinf(ang);
      }
    }
  }
}

template <int WR, int WC>
struct GemmCore {
  static constexpr int BR = 64 * WR, BC = 64 * WC;
  static constexpr int STAGE = (BR + BC) * 128;
  static __device__ __forceinline__ void run(f32x16 (&acc)[2][2], const bf16_t* const (&rp)[WR], const bf16_t* const (&cp)[WC],
                                             int K, LDSP char* lds, int tid) {
    static_assert(WR * WC == 8, "8 waves");
    const int lane = tid & 63, wid = tid >> 6;
    const int wr = wid / WC, wc = wid % WC;
    const int crow = tid >> 3, cch = tid & 7;
    const int l31 = lane & 31, h = lane >> 5, sw = (lane >> 1) & 7;
    int wo_r[WR], wo_c[WC];
#pragma unroll
    for (int i = 0; i < WR; ++i) { const int row = crow + 64 * i; wo_r[i] = row * 128 + ((cch ^ ((row >> 1) & 7)) << 4); }
#pragma unroll
    for (int i = 0; i < WC; ++i) { const int row = crow + 64 * i; wo_c[i] = BR * 128 + row * 128 + ((cch ^ ((row >> 1) & 7)) << 4); }
    const int fr_base = (wr * 64 + l31) * 128;
    const int fc_base = BR * 128 + (wc * 64 + l31) * 128;
    u32x4 rreg[WR], creg[WC];
#pragma unroll
    for (int i = 0; i < WR; ++i) rreg[i] = *(const u32x4*)(rp[i]);
#pragma unroll
    for (int i = 0; i < WC; ++i) creg[i] = *(const u32x4*)(cp[i]);
    __syncthreads();
#pragma unroll
    for (int i = 0; i < WR; ++i) *(LDSP u32x4*)(lds + wo_r[i]) = rreg[i];
#pragma unroll
    for (int i = 0; i < WC; ++i) *(LDSP u32x4*)(lds + wo_c[i]) = creg[i];
    __syncthreads();
    const int nk = K >> 6;
    for (int kt = 0; kt < nk; ++kt) {
      const int cur = kt & 1;
      if (kt + 1 < nk) {
#pragma unroll
        for (int i = 0; i < WR; ++i) rreg[i] = *(const u32x4*)(rp[i] + (kt + 1) * 64);
#pragma unroll
        for (int i = 0; i < WC; ++i) creg[i] = *(const u32x4*)(cp[i] + (kt + 1) * 64);
      }
      LDSP char* st = lds + cur * STAGE;
#pragma unroll
      for (int kk = 0; kk < 4; ++kk) {
        const int co = (((kk * 2 + h) ^ sw) << 4);
        bf16x8 fr[2], fc[2];
#pragma unroll
        for (int ri = 0; ri < 2; ++ri) fr[ri] = *(LDSP const bf16x8*)(st + fr_base + ri * 4096 + co);
#pragma unroll
        for (int ci = 0; ci < 2; ++ci) fc[ci] = *(LDSP const bf16x8*)(st + fc_base + ci * 4096 + co);
#pragma unroll
        for (int ri = 0; ri < 2; ++ri)
#pragma unroll
          for (int ci = 0; ci < 2; ++ci) acc[ri][ci] = __builtin_amdgcn_mfma_f32_32x32x16_bf16(fr[ri], fc[ci], acc[ri][ci], 0, 0, 0);
      }
      if (kt + 1 < nk) {
        LDSP char* sn = lds + (cur ^ 1) * STAGE;
#pragma unroll
        for (int i = 0; i < WR; ++i) *(LDSP u32x4*)(sn + wo_r[i]) = rreg[i];
#pragma unroll
        for (int i = 0; i < WC; ++i) *(LDSP u32x4*)(sn + wo_c[i]) = creg[i];
      }
      __syncthreads();
    }
  }
};


__device__ __forceinline__ void glds16g(const void* gsrc, unsigned lds_dst) { unsigned keep;
  asm volatile("s_mov_b32 %0, m0\n\ts_mov_b32 m0, %2\n\ts_nop 0\n\tglobal_load_lds_dwordx4 %1, off\n\ts_mov_b32 m0, %0" : "=&s"(keep) : "v"(gsrc), "s"(lds_dst) : "memory"); }
__device__ __forceinline__ void glds16g_sc1(const void* gsrc, unsigned lds_dst) { unsigned keep;
  asm volatile("s_mov_b32 %0, m0\n\ts_mov_b32 m0, %2\n\ts_nop 0\n\tglobal_load_lds_dwordx4 %1, off sc1\n\ts_mov_b32 m0, %0" : "=&s"(keep) : "v"(gsrc), "s"(lds_dst) : "memory"); }
#define VMW(N) asm volatile("s_waitcnt vmcnt(" #N ")" ::: "memory")
template <int WR, int WC, int NST, bool CSC1 = false>
struct GemmCoreD {
  static constexpr int BR = 64 * WR, BC = 64 * WC;
  static constexpr int STAGE = (BR + BC) * 128;
  static __device__ __forceinline__ void prefetch0(const bf16_t* const (&rrow)[WR], const bf16_t* const (&crw)[WC], LDSP char* lds, int tid) {
    const int wid = __builtin_amdgcn_readfirstlane(tid >> 6);
    const int crow = tid >> 3, cch = tid & 7;
    const int sc8 = (cch ^ ((crow >> 1) & 7)) << 3;
    const unsigned l0 = (unsigned)(uintptr_t)lds + (unsigned)wid * 1024u;
#pragma unroll
    for (int i = 0; i < WR; ++i) glds16g(rrow[i] + sc8, (unsigned)__builtin_amdgcn_readfirstlane(l0 + (unsigned)(i * 8192)));
#pragma unroll
    for (int i = 0; i < WC; ++i) { if (CSC1) glds16g_sc1(crw[i] + sc8, (unsigned)__builtin_amdgcn_readfirstlane(l0 + (unsigned)(BR * 128 + i * 8192))); else glds16g(crw[i] + sc8, (unsigned)__builtin_amdgcn_readfirstlane(l0 + (unsigned)(BR * 128 + i * 8192))); }
  }
  static __device__ __forceinline__ void run(f32x16 (&acc)[2][2], const bf16_t* const (&rrow)[WR], const bf16_t* const (&crw)[WC],
                                             int K, LDSP char* lds, int tid, bool pre = false) {
    static_assert(WR * WC == 8 && WR + WC == 6 && NST == 3, "8 waves, 6 DMA pieces per wave and tile, 3-stage ring");
    const int lane = tid & 63; const int wid = __builtin_amdgcn_readfirstlane(tid >> 6);
    const int wr = wid / WC, wc = wid % WC;
    const int crow = tid >> 3, cch = tid & 7;
    const int l31 = lane & 31, h = lane >> 5, sw = (lane >> 1) & 7;
    const int sc8 = (cch ^ ((crow >> 1) & 7)) << 3;
    const bf16_t* rs[WR]; const bf16_t* cs[WC];
#pragma unroll
    for (int i = 0; i < WR; ++i) rs[i] = rrow[i] + sc8;
#pragma unroll
    for (int i = 0; i < WC; ++i) cs[i] = crw[i] + sc8;
    const unsigned l0 = (unsigned)(uintptr_t)lds + (unsigned)wid * 1024u;
    const int fr_base = (wr * 64 + l31) * 128;
    const int fc_base = BR * 128 + (wc * 64 + l31) * 128;
    const int nk = K >> 6;
    const bool grp1 = wid >= 4;
#define GD_ISSUE(t, st) do { \
      _Pragma("unroll") for (int i = 0; i < WR; ++i) glds16g(rs[i] + (t) * 64, (unsigned)__builtin_amdgcn_readfirstlane(l0 + (unsigned)((st) * STAGE + i * 8192))); \
      _Pragma("unroll") for (int i = 0; i < WC; ++i) { if (CSC1) glds16g_sc1(cs[i] + (t) * 64, (unsigned)__builtin_amdgcn_readfirstlane(l0 + (unsigned)((st) * STAGE + BR * 128 + i * 8192))); else glds16g(cs[i] + (t) * 64, (unsigned)__builtin_amdgcn_readfirstlane(l0 + (unsigned)((st) * STAGE + BR * 128 + i * 8192))); } } while (0)
    asm volatile("s_waitcnt lgkmcnt(0)\n\ts_barrier" ::: "memory");
    if (!pre) GD_ISSUE(0, 0);
    if (nk > 1) { GD_ISSUE(1, 1); VMW(6); } else VMW(0);
    if (grp1) asm volatile("s_barrier" ::: "memory");
    int st = 0;
    for (int t = 0; t < nk; ++t) {
      asm volatile("s_barrier" ::: "memory");
      __builtin_amdgcn_sched_barrier(0);
      LDSP char* sp = lds + st * STAGE;
      bf16x8 fr[4][2], fc[4][2];
#pragma unroll
      for (int kk = 0; kk < 4; ++kk) {
        const int co = (((kk * 2 + h) ^ sw) << 4);
#pragma unroll
        for (int ri = 0; ri < 2; ++ri) fr[kk][ri] = *(LDSP const bf16x8*)(sp + fr_base + ri * 4096 + co);
#pragma unroll
        for (int ci = 0; ci < 2; ++ci) fc[kk][ci] = *(LDSP const bf16x8*)(sp + fc_base + ci * 4096 + co);
      }
      if (t + 2 < nk) { const int s2 = (st >= 1) ? st - 1 : 2; GD_ISSUE(t + 2, s2); VMW(6); }
      else VMW(0);
      asm volatile("s_waitcnt lgkmcnt(0)\n\ts_barrier" ::: "memory");
      __builtin_amdgcn_sched_barrier(0);
      __builtin_amdgcn_s_setprio(1);
#pragma unroll
      for (int kk = 0; kk < 4; ++kk)
#pragma unroll
        for (int ri = 0; ri < 2; ++ri)
#pragma unroll
          for (int ci = 0; ci < 2; ++ci) acc[ri][ci] = __builtin_amdgcn_mfma_f32_32x32x16_bf16(fr[kk][ri], fc[kk][ci], acc[ri][ci], 0, 0, 0);
      __builtin_amdgcn_s_setprio(0);
      __builtin_amdgcn_sched_barrier(0);
      st = (st == 2) ? 0 : st + 1;
    }
    if (!grp1) asm volatile("s_barrier" ::: "memory");
    asm volatile("s_barrier" ::: "memory");
#undef GD_ISSUE
  }

  static __device__ __forceinline__ LDSP char* free_stage(LDSP char* lds, int st) { return lds + ((st >= 1) ? st - 1 : 2) * STAGE; }
};

struct RunDesc {
  const char* rbase; unsigned rstride;
  const char* cbase; unsigned clo0, clo1;
  unsigned rlo; int nk; bool sc1; bool fp8;
  int bscale;
};
__device__ __forceinline__ const char* uni64(const char* p) {
  const unsigned lo = __builtin_amdgcn_readfirstlane((unsigned)(uintptr_t)p), hi = __builtin_amdgcn_readfirstlane((unsigned)((uintptr_t)p >> 32));
  return (const char*)(((uintptr_t)hi << 32) | (uintptr_t)lo);
}
__device__ __forceinline__ void glds16s(const char* sbase, unsigned voff, unsigned lds_dst) { unsigned keep; sbase = uni64(sbase);
  asm volatile("s_mov_b32 %0, m0\n\ts_mov_b32 m0, %3\n\ts_nop 0\n\tglobal_load_lds_dwordx4 %1, %2\n\ts_mov_b32 m0, %0" : "=&s"(keep) : "v"(voff), "s"(sbase), "s"(lds_dst) : "memory"); }
__device__ __forceinline__ void glds16s_sc1(const char* sbase, unsigned voff, unsigned lds_dst) { unsigned keep; sbase = uni64(sbase);
  asm volatile("s_mov_b32 %0, m0\n\ts_mov_b32 m0, %3\n\ts_nop 0\n\tglobal_load_lds_dwordx4 %1, %2 sc1\n\ts_mov_b32 m0, %0" : "=&s"(keep) : "v"(voff), "s"(sbase), "s"(lds_dst) : "memory"); }

struct StreamCore {
  static constexpr int BR = 256, BC = 128, STAGE = (BR + BC) * 128, WC = 2;
  static __device__ __forceinline__ LDSP char* free_stage(LDSP char* lds, int st) { return lds + ((st >= 1) ? st - 1 : 2) * STAGE; }
  static __device__ __forceinline__ void issue_tile(const RunDesc& d, int tile, unsigned dst) {
    const unsigned t128 = (unsigned)tile * 128u;
#pragma unroll
    for (int i = 0; i < 4; ++i) glds16s(d.rbase, d.rlo + (unsigned)i * d.rstride + t128, (unsigned)__builtin_amdgcn_readfirstlane(dst + (unsigned)(i * 8192)));
    if (d.sc1) {
      glds16s_sc1(d.cbase, d.clo0 + t128, (unsigned)__builtin_amdgcn_readfirstlane(dst + (unsigned)(BR * 128)));
      glds16s_sc1(d.cbase, d.clo1 + t128, (unsigned)__builtin_amdgcn_readfirstlane(dst + (unsigned)(BR * 128 + 8192)));
    } else {
      glds16s(d.cbase, d.clo0 + t128, (unsigned)__builtin_amdgcn_readfirstlane(dst + (unsigned)(BR * 128)));
      glds16s(d.cbase, d.clo1 + t128, (unsigned)__builtin_amdgcn_readfirstlane(dst + (unsigned)(BR * 128 + 8192)));
    }
  }
  template <bool F8, class NextF>
  static __device__ __forceinline__ void run_stream(f32x16 (&acc)[2][2], const RunDesc& d, const NextF& next, bool drain_first,
                                                    LDSP char* lds, int tid, int& st, int& pre) {
    const int lane = tid & 63; const int wid = __builtin_amdgcn_readfirstlane(tid >> 6);
    const int wr = wid / WC, wc = wid % WC;
    const int l31 = lane & 31, h = lane >> 5, sw = (lane >> 1) & 7;
    const unsigned l0 = (unsigned)(uintptr_t)lds + (unsigned)wid * 1024u;
    const int fr_base = (wr * 64 + l31) * 128;
    const int fc_base = BR * 128 + (wc * 64 + l31) * 128;
    const int nk = d.nk;
    const bool grp1 = wid >= 4;
    if (pre == 0) {
      if (drain_first) asm volatile("s_waitcnt vmcnt(0) lgkmcnt(0)\n\ts_barrier" ::: "memory");
      else asm volatile("s_waitcnt lgkmcnt(0)\n\ts_barrier" ::: "memory");
      issue_tile(d, 0, l0 + (unsigned)(st * STAGE));
      issue_tile(d, 1, l0 + (unsigned)(((st == 2) ? 0 : st + 1) * STAGE));
      VMW(6);
    } else {
      if (drain_first) asm volatile("s_waitcnt vmcnt(0) lgkmcnt(0)" ::: "memory");
      else asm volatile("s_waitcnt lgkmcnt(0)" ::: "memory");
    }
    if (grp1) asm volatile("s_barrier" ::: "memory");
    bool nvalid = false;
    for (int t = 0; t < nk; ++t) {
      asm volatile("s_barrier" ::: "memory");
      __builtin_amdgcn_sched_barrier(0);
      LDSP char* sp = lds + st * STAGE;
      bf16x8 fr[4][2], fc[4][2];
      v8i_t fa[2][2], fb[2][2];
      if (F8) {
#pragma unroll
        for (int s2 = 0; s2 < 2; ++s2) {
          const int co0 = (((s2 * 4 + 2 * h) ^ sw) << 4), co1 = (((s2 * 4 + 2 * h + 1) ^ sw) << 4);
#pragma unroll
          for (int ri = 0; ri < 2; ++ri) {
            const v4i_t lo = *(LDSP const v4i_t*)(sp + fr_base + ri * 4096 + co0), hi = *(LDSP const v4i_t*)(sp + fr_base + ri * 4096 + co1);
            fa[s2][ri] = __builtin_shufflevector(lo, hi, 0, 1, 2, 3, 4, 5, 6, 7);
          }
#pragma unroll
          for (int ci = 0; ci < 2; ++ci) {
            const v4i_t lo = *(LDSP const v4i_t*)(sp + fc_base + ci * 4096 + co0), hi = *(LDSP const v4i_t*)(sp + fc_base + ci * 4096 + co1);
            fb[s2][ci] = __builtin_shufflevector(lo, hi, 0, 1, 2, 3, 4, 5, 6, 7);
          }
        }
      } else {
#pragma unroll
        for (int kk = 0; kk < 4; ++kk) {
          const int co = (((kk * 2 + h) ^ sw) << 4);
#pragma unroll
          for (int ri = 0; ri < 2; ++ri) fr[kk][ri] = *(LDSP const bf16x8*)(sp + fr_base + ri * 4096 + co);
#pragma unroll
          for (int ci = 0; ci < 2; ++ci) fc[kk][ci] = *(LDSP const bf16x8*)(sp + fc_base + ci * 4096 + co);
        }
      }
      const unsigned d2 = l0 + (unsigned)(((st >= 1) ? st - 1 : 2) * STAGE);
      bool issued = false;
      if (t + 2 < nk) { issue_tile(d, t + 2, d2); issued = true; }
      else {
        RunDesc dn;
        if (next(dn)) { issue_tile(dn, t + 2 - nk, d2); issued = true; nvalid = true; }
      }
      if (issued) VMW(6); else VMW(0);
      asm volatile("s_waitcnt lgkmcnt(0)\n\ts_barrier" ::: "memory");
      __builtin_amdgcn_sched_barrier(0);
      __builtin_amdgcn_s_setprio(1);
      if (F8) {
#pragma unroll
        for (int s2 = 0; s2 < 2; ++s2)
#pragma unroll
          for (int ri = 0; ri < 2; ++ri)
#pragma unroll
            for (int ci = 0; ci < 2; ++ci)
              acc[ri][ci] = __builtin_amdgcn_mfma_scale_f32_32x32x64_f8f6f4(fa[s2][ri], fb[s2][ci], acc[ri][ci], 0, 0, 0, 0x77777777, 0, d.bscale);
      } else {
#pragma unroll
        for (int kk = 0; kk < 4; ++kk)
#pragma unroll
          for (int ri = 0; ri < 2; ++ri)
#pragma unroll
            for (int ci = 0; ci < 2; ++ci) acc[ri][ci] = __builtin_amdgcn_mfma_f32_32x32x16_bf16(fr[kk][ri], fc[kk][ci], acc[ri][ci], 0, 0, 0);
      }
      __builtin_amdgcn_s_setprio(0);
      __builtin_amdgcn_sched_barrier(0);
      st = (st == 2) ? 0 : st + 1;
    }
    if (!grp1) asm volatile("s_barrier" ::: "memory");
    pre = nvalid ? 2 : 0;
  }
};


struct Desc2 { const char* rbase; unsigned rlo, rstride; const char* cbase; unsigned clo, cstride; int nk; };
struct Core256 {
  static constexpr int STAGE = 32768;
  static __device__ __forceinline__ unsigned lane_off(int tid, unsigned pitch) { const int row = tid >> 2, pos = tid & 3; return (unsigned)row * pitch + (unsigned)((pos ^ ((row >> 2) & 3)) << 4); }
  static __device__ __forceinline__ void issue_tile(const Desc2& d, int tile, unsigned dst) {
    const unsigned t64 = (unsigned)tile * 64u;
#pragma unroll
    for (int i = 0; i < 2; ++i) glds16s(d.rbase, d.rlo + (unsigned)i * d.rstride + t64, (unsigned)__builtin_amdgcn_readfirstlane(dst + (unsigned)(i * 8192)));
#pragma unroll
    for (int i = 0; i < 2; ++i) glds16s(d.cbase, d.clo + (unsigned)i * d.cstride + t64, (unsigned)__builtin_amdgcn_readfirstlane(dst + (unsigned)(16384 + i * 8192)));
  }
  static __device__ __forceinline__ void prefetch0(const Desc2& d, LDSP char* lds, int tid) {
    const int wid = __builtin_amdgcn_readfirstlane(tid >> 6);
    issue_tile(d, 0, (unsigned)(uintptr_t)lds + (unsigned)wid * 1024u);
  }
  static __device__ __forceinline__ void run(f32x16 (&acc)[4][2], const Desc2& d, LDSP char* lds, int tid, bool pre) {
    const int lane = tid & 63; const int wid = __builtin_amdgcn_readfirstlane(tid >> 6);
    const int wr = wid >> 2, wc = wid & 3;
    const int l31 = lane & 31, h = lane >> 5, sw2 = (lane >> 2) & 3;
    const unsigned l0 = (unsigned)(uintptr_t)lds + (unsigned)wid * 1024u;
    const int fr_base = (wr * 128 + l31) * 64;
    const int fc_base = 16384 + (wc * 64 + l31) * 64;
    const int nk = d.nk;
    const bool grp1 = wid >= 4;
    asm volatile("s_waitcnt lgkmcnt(0)\n\ts_barrier" ::: "memory");
    if (!pre) issue_tile(d, 0, l0);
    issue_tile(d, 1, l0 + STAGE); issue_tile(d, 2, l0 + 2 * STAGE); VMW(8);
    if (grp1) asm volatile("s_barrier" ::: "memory");
    int st = 0;
    for (int t = 0; t < nk; ++t) {
      asm volatile("s_barrier" ::: "memory");
      __builtin_amdgcn_sched_barrier(0);
      LDSP char* sp = lds + st * STAGE;
      bf16x8 fr[2][4], fc[2][2];
#pragma unroll
      for (int kk = 0; kk < 2; ++kk) {
        const int co = (((kk * 2 + h) ^ sw2) << 4);
#pragma unroll
        for (int ri = 0; ri < 4; ++ri) fr[kk][ri] = *(LDSP const bf16x8*)(sp + fr_base + ri * 2048 + co);
#pragma unroll
        for (int ci = 0; ci < 2; ++ci) fc[kk][ci] = *(LDSP const bf16x8*)(sp + fc_base + ci * 2048 + co);
      }
      if (t + 2 < nk) VMW(4); else VMW(0);
      asm volatile("s_waitcnt lgkmcnt(0)\n\ts_barrier" ::: "memory");
      __builtin_amdgcn_sched_barrier(0);
      __builtin_amdgcn_s_setprio(1);
#pragma unroll
      for (int ri = 0; ri < 4; ++ri)
#pragma unroll
        for (int ci = 0; ci < 2; ++ci) acc[ri][ci] = __builtin_amdgcn_mfma_f32_32x32x16_bf16(fr[0][ri], fc[0][ci], acc[ri][ci], 0, 0, 0);
      __builtin_amdgcn_sched_barrier(0);
      if (t + 3 < nk) issue_tile(d, t + 3, l0 + (unsigned)(((st + 3) & 3) * STAGE));
      __builtin_amdgcn_sched_barrier(0);
#pragma unroll
      for (int ri = 0; ri < 4; ++ri)
#pragma unroll
        for (int ci = 0; ci < 2; ++ci) acc[ri][ci] = __builtin_amdgcn_mfma_f32_32x32x16_bf16(fr[1][ri], fc[1][ci], acc[ri][ci], 0, 0, 0);
      __builtin_amdgcn_s_setprio(0);
      __builtin_amdgcn_sched_barrier(0);
      st = (st + 1) & 3;
    }
    if (!grp1) asm volatile("s_barrier" ::: "memory");
    asm volatile("s_barrier" ::: "memory");
  }
};

__device__ __forceinline__ void stage_tile(const f32x16 (&acc)[2][2], LDSP char* wl, int lane) {
  const int cl = lane & 31, h = lane >> 5;
#pragma unroll
  for (int ci = 0; ci < 2; ++ci) {
    const int row = ci * 32 + cl; const int sw = (row >> 1) & 7;
#pragma unroll
    for (int ri = 0; ri < 2; ++ri)
#pragma unroll
      for (int g = 0; g < 4; ++g) {
        u32x2 w; w.x = pk_bf16(acc[ri][ci][4 * g + 0], acc[ri][ci][4 * g + 1]); w.y = pk_bf16(acc[ri][ci][4 * g + 2], acc[ri][ci][4 * g + 3]);
        *(LDSP u32x2*)(wl + row * 128 + (((ri * 4 + g) ^ sw) << 4) + 8 * h) = w;
      }
  }
}
__device__ __forceinline__ void read_row(float (&v)[64], LDSP const char* wl, int lane) {
  const int sw = (lane >> 1) & 7;
#pragma unroll
  for (int j = 0; j < 8; ++j) {
    const u32x4 w = *(LDSP const u32x4*)(wl + lane * 128 + ((j ^ sw) << 4));
    v[8 * j + 0] = bf_lo(w.x); v[8 * j + 1] = bf_hi(w.x); v[8 * j + 2] = bf_lo(w.y); v[8 * j + 3] = bf_hi(w.y);
    v[8 * j + 4] = bf_lo(w.z); v[8 * j + 5] = bf_hi(w.z); v[8 * j + 6] = bf_lo(w.w); v[8 * j + 7] = bf_hi(w.w);
  }
}

__device__ __forceinline__ void inproj_epilogue(CQ& q, const f32x16 (&acc)[2][2], int chunk, int mt0, LDSP char* wl, int lane) {
  CP& p = q.p;
    if (chunk == 17) {
      const int cl = lane & 31, h = lane >> 5;
#pragma unroll
      for (int ci = 0; ci < 2; ++ci) {
        float* mrow = q.misc + (size_t)(mt0 + ci * 32 + cl) * 32;
        const f32x16& a = acc[0][ci];
        if (h == 0) {
          *(float4*)(mrow + 0) = make_float4(a[0] * 0.0625f, a[1] * 0.0625f, a[2] * 0.0625f, a[3] * 0.0625f);
          *(float4*)(mrow + 8) = make_float4(a[4], a[5], a[6], a[7]);
          *(float4*)(mrow + 16) = make_float4(a[8], a[9], a[10], a[11]);
        } else {
          *(float4*)(mrow + 4) = make_float4(a[0], a[1], a[2], a[3]);
          *(float4*)(mrow + 12) = make_float4(a[4], a[5], a[6], a[7]);
        }
      }
    } else {
      stage_tile(acc, wl, lane);
      float v[64];
      read_row(v, wl, lane);
      const int tok = mt0 + lane;
      const bool do_norm = chunk < 10;
      const bool do_rope = chunk < 10 || (chunk >= 12 && chunk < 17);
      if (do_norm) {
        const float* nw = (chunk < 8) ? p.q_norm_w : p.k_norm_w;
        float ss = 0.f;
#pragma unroll
        for (int i = 0; i < 64; ++i) ss += v[i] * v[i];
        const float r = rsqrtf(ss * (1.f / 64.f) + 1e-6f);
#pragma unroll
        for (int i = 0; i < 64; ++i) v[i] = v[i] * r * nw[i];
      }
      if (do_rope) {
        const float* rt_ = q.rope + (size_t)tok * 16;
        const float4 c0 = *(const float4*)(rt_), c1 = *(const float4*)(rt_ + 4), s0 = *(const float4*)(rt_ + 8), s1 = *(const float4*)(rt_ + 12);
        const float cs[8] = {c0.x, c0.y, c0.z, c0.w, c1.x, c1.y, c1.z, c1.w};
        const float sn[8] = {s0.x, s0.y, s0.z, s0.w, s1.x, s1.y, s1.z, s1.w};
#pragma unroll
        for (int i = 0; i < 8; ++i) {
          const float x1 = v[i], x2 = v[i + 8];
          v[i] = x1 * cs[i] - x2 * sn[i];
          v[i + 8] = x2 * cs[i] + x1 * sn[i];
        }
      }
      if (chunk < 8) {
#pragma unroll
        for (int i = 0; i < 64; ++i) v[i] *= ATT_C2;
      }
      {
        const int sw2 = (lane >> 1) & 7;
#pragma unroll
        for (int j = 0; j < 8; ++j) {
          u32x4 w; w.x = pk_bf16(v[8 * j], v[8 * j + 1]); w.y = pk_bf16(v[8 * j + 2], v[8 * j + 3]);
          w.z = pk_bf16(v[8 * j + 4], v[8 * j + 5]); w.w = pk_bf16(v[8 * j + 6], v[8 * j + 7]);
          *(LDSP u32x4*)(wl + lane * 128 + ((j ^ sw2) << 4)) = w;
        }
        const int erow = lane >> 3, ech = lane & 7;
#pragma unroll
        for (int i = 0; i < 8; ++i) {
          const int row = erow + 8 * i;
          const u32x4 w = *(LDSP const u32x4*)(wl + row * 128 + ((ech ^ ((row >> 1) & 7)) << 4));
          *(u32x4*)(q.proj2 + (size_t)(mt0 + row) * NP + chunk * 64 + ech * 8) = w;
        }
      }
    }
}

__device__ __forceinline__ void phase2(CQ& q, LDSP char* lds, int tid) {
  const int lane = tid & 63, wid = tid >> 6;
  const int G = gridDim.x, bid = blockIdx.x;
  const int xcd = bid & 7, lix = bid >> 3, per = G >> 3;
  {
    const int wr = wid >> 2, wc = wid & 3;
    const unsigned lo = Core256::lane_off(tid, 2048u);
    bool pre = false;
    for (int it = lix; it < 16 * 10; it += per) {
      const int tt = xcd + 8 * (it / 10), ct = it % 10;
      const int m0 = tt * 256;
      Desc2 d;
      d.rbase = (const char*)(q.wt_in + (size_t)ct * 256 * 1024); d.rlo = lo; d.rstride = 128u * 2048u;
      d.cbase = (const char*)(q.h1 + (size_t)m0 * 1024); d.clo = lo; d.cstride = 128u * 2048u;
      d.nk = 32;
      f32x16 acc[4][2];
#pragma unroll
      for (int a = 0; a < 4; ++a)
#pragma unroll
        for (int b = 0; b < 2; ++b)
#pragma unroll
          for (int r = 0; r < 16; ++r) acc[a][b][r] = 0.f;
      Core256::run(acc, d, lds, tid, pre);
      pre = false;
      if (it + per < 16 * 10) {
        const int it2 = it + per; const int tt2 = xcd + 8 * (it2 / 10), ct2 = it2 % 10;
        Desc2 d2 = d;
        d2.rbase = (const char*)(q.wt_in + (size_t)ct2 * 256 * 1024); d2.cbase = (const char*)(q.h1 + (size_t)tt2 * 256 * 1024);
        Core256::prefetch0(d2, lds, tid);
        pre = true;
      }
      LDSP char* wl = lds + 32768 + wid * 8192;
      const int mt0 = m0 + wc * 64;
      inproj_epilogue(q, *(const f32x16 (*)[2][2])&acc[0], ct * 4 + wr * 2, mt0, wl, lane);
      asm volatile("s_waitcnt lgkmcnt(0)" ::: "memory");
      inproj_epilogue(q, *(const f32x16 (*)[2][2])&acc[2], ct * 4 + wr * 2 + 1, mt0, wl, lane);
    }
  }
  {
    typedef GemmCoreD<2, 4, 3> GC;
    const int wr = wid / 4, wc = wid % 4;
    const int crow = tid >> 3;
    for (int it = lix; it < 16; it += per) {
      const int tt = xcd + 8 * it, rt = 20;
      const int m0 = tt * 256, n0 = rt * 128;
      const bf16_t* rp[2]; const bf16_t* cp[4];
#pragma unroll
      for (int i = 0; i < 2; ++i) rp[i] = q.wt_in + (size_t)(n0 + crow + 64 * i) * 1024;
#pragma unroll
      for (int i = 0; i < 4; ++i) cp[i] = q.h1 + (size_t)(m0 + crow + 64 * i) * 1024;
      f32x16 acc[2][2];
#pragma unroll
      for (int a = 0; a < 2; ++a)
#pragma unroll
        for (int b = 0; b < 2; ++b)
#pragma unroll
          for (int r = 0; r < 16; ++r) acc[a][b][r] = 0.f;
      GC::run(acc, rp, cp, 1024, lds, tid, false);
      inproj_epilogue(q, acc, rt * 2 + wr, m0 + wc * 64, lds + wid * 8192, lane);
    }
  }
}


typedef float f32x4a __attribute__((ext_vector_type(4)));
#define SROW 2052
__device__ __forceinline__ void idx_item(CQ& q, LDSP char* lds, int tid, int b, int qt) {
  CP& p = q.p;
  const int lane = tid & 63, wid = tid >> 6;
  LDSP float* sbuf = (LDSP float*)lds;
  const int q0 = qt * 16;
  const size_t tok0 = (size_t)b * SEQ + q0;
  const int ql = lane & 15, kg = lane >> 4;
  bf16x8 qf[4][2]; float wq[4];
  {
    const bf16_t* qp = q.proj2 + (tok0 + ql) * NP + D_QI + kg * 8;
#pragma unroll
    for (int hd = 0; hd < 4; ++hd)
#pragma unroll
      for (int s2 = 0; s2 < 2; ++s2) qf[hd][s2] = *(const bf16x8*)(qp + hd * 64 + s2 * 32);
    const float4 w4 = *(const float4*)(q.misc + (tok0 + ql) * 32);
    wq[0] = w4.x; wq[1] = w4.y; wq[2] = w4.z; wq[3] = w4.w;
  }
  const int nkt = qt + 1;
  const bf16_t* kbase = q.proj2 + ((size_t)b * SEQ + ql) * NP + D_KI + kg * 8;
  bf16x8 kr0[4], kr1[4];
#pragma unroll
  for (int j = 0; j < 4; ++j) {
    const int kt0 = wid + 8 * j;
    const bf16_t* kp = kbase + (size_t)(kt0 < nkt ? kt0 : 0) * 16 * NP;
    kr0[j] = *(const bf16x8*)(kp); kr1[j] = *(const bf16x8*)(kp + 32);
  }
  for (int kt4 = wid; kt4 < nkt; kt4 += 32) {
#pragma unroll
    for (int j = 0; j < 4; ++j) {
      const int kt = kt4 + 8 * j;
      if (kt < nkt) {
        const bf16x8 k0 = kr0[j], k1 = kr1[j];
        { const int k2t = kt + 32; const bf16_t* kp = kbase + (size_t)(k2t < nkt ? k2t : 0) * 16 * NP; kr0[j] = *(const bf16x8*)(kp); kr1[j] = *(const bf16x8*)(kp + 32); }
        f32x4a sc = {0.f, 0.f, 0.f, 0.f};
#pragma unroll
        for (int hd = 0; hd < 4; ++hd) {
          f32x4a d = {0.f, 0.f, 0.f, 0.f};
          d = __builtin_amdgcn_mfma_f32_16x16x32_bf16(k0, qf[hd][0], d, 0, 0, 0);
          d = __builtin_amdgcn_mfma_f32_16x16x32_bf16(k1, qf[hd][1], d, 0, 0, 0);
#pragma unroll
          for (int jj = 0; jj < 4; ++jj) sc[jj] += wq[hd] * fmaxf(d[jj], 0.f);
        }
        *(LDSP f32x4a*)(sbuf + ql * SROW + kt * 16 + kg * 4) = sc;
      }
    }
  }
  __syncthreads();
  const int qa_ = wid * 2, qb_ = wid * 2 + 1;
  const int ta = q0 + qa_, tb_ = q0 + qb_;
  if (tb_ < 256) {
#pragma unroll
    for (int qq = 0; qq < 2; ++qq) {
      const int t = q0 + wid * 2 + qq;
      const int lo = lane * 32;
      const unsigned w = (t >= lo + 31) ? 0xffffffffu : (t < lo ? 0u : ((2u << (t - lo)) - 1u));
      p.mask[(tok0 + wid * 2 + qq) * 64 + lane] = w;
    }
  } else {
    unsigned ua[32], ub[32];
    const int ngr = (tb_ >> 9) + 1;
#pragma unroll
    for (int i = 0; i < 32; ++i) { ua[i] = 0u; ub[i] = 0u; }
#pragma unroll
    for (int gq = 0; gq < 4; ++gq) {
      if (gq < ngr) {
#pragma unroll
        for (int i = gq * 8; i < gq * 8 + 8; ++i) {
          const int key = lane + 64 * i;
          const float fa = sbuf[qa_ * SROW + key] + 0.0f, fb = sbuf[qb_ * SROW + key] + 0.0f;
          const unsigned ba = __float_as_uint(fa), bb = __float_as_uint(fb);
          const unsigned ea = (ba & 0x80000000u) ? ~ba : (ba | 0x80000000u), eb = (bb & 0x80000000u) ? ~bb : (bb | 0x80000000u);
          ua[i] = (key <= ta) ? ea : 0u; ub[i] = (key <= tb_) ? eb : 0u;
        }
      }
    }
    unsigned taua = 0u, taub = 0u; bool exa = false, exb = false;
    for (int bit = 31; bit >= 0; --bit) {
      if (exa && exb) break;
      const unsigned ca = taua | (1u << bit), cb = taub | (1u << bit);
      unsigned la = 0u, lb = 0u;
#pragma unroll
      for (int gq = 0; gq < 4; ++gq) {
        if (gq < ngr) {
#pragma unroll
          for (int i = gq * 8; i < gq * 8 + 8; ++i) { la += (ua[i] >= ca) ? 1u : 0u; lb += (ub[i] >= cb) ? 1u : 0u; }
        }
      }
      int na = 0, nb = 0;
#pragma unroll
      for (int bt = 0; bt < 6; ++bt) { na += __builtin_popcountll(__ballot((la >> bt) & 1u)) << bt; nb += __builtin_popcountll(__ballot((lb >> bt) & 1u)) << bt; }
      if (!exa && na >= 256) { taua = ca; exa = (na == 256); }
      if (!exb && nb >= 256) { taub = cb; exb = (nb == 256); }
    }
    const unsigned long long ltmask = (1ull << lane) - 1ull;
#pragma unroll
    for (int qq = 0; qq < 2; ++qq) {
      const unsigned tau = qq ? taub : taua; const bool exact = qq ? exb : exa;
      int need = 0;
      if (!exact) {
        unsigned lc = 0u;
#pragma unroll
        for (int i = 0; i < 32; ++i) { const unsigned uv = qq ? ub[i] : ua[i]; lc += (uv > tau) ? 1u : 0u; }
        int cgt = 0;
#pragma unroll
        for (int bt = 0; bt < 6; ++bt) cgt += __builtin_popcountll(__ballot((lc >> bt) & 1u)) << bt;
        need = 256 - cgt;
      }
      int running = 0; unsigned wout = 0u;
#pragma unroll
      for (int gq = 0; gq < 4; ++gq) {
        if (gq < ngr) {
#pragma unroll
          for (int i = gq * 8; i < gq * 8 + 8; ++i) {
            const unsigned uv = qq ? ub[i] : ua[i];
            bool selb;
            if (exact) selb = uv >= tau;
            else {
              const bool tie = (uv == tau);
              const unsigned long long tb2 = __ballot(tie);
              const int pre = running + __builtin_popcountll(tb2 & ltmask);
              running += __builtin_popcountll(tb2);
              selb = (uv > tau) || (tie && pre < need);
            }
            const unsigned long long sb = __ballot(selb);
            if (lane == 2 * i) wout = (unsigned)(sb & 0xffffffffull);
            if (lane == 2 * i + 1) wout = (unsigned)(sb >> 32);
          }
        }
      }
      p.mask[(tok0 + wid * 2 + qq) * 64 + lane] = wout;
    }
  }
  __syncthreads();
}
__device__ __forceinline__ void phase3(CQ& q, LDSP char* lds, int tid) {
  volatile LDSP int* sit = (volatile LDSP int*)(lds + LDS_BYTES - 8);
  int nxt = 0;
  if (tid == 0) nxt = atomicAdd(q.ictr, 1);
  for (;;) {
    if (tid == 0) *sit = nxt;
    __syncthreads();
    const int it = *sit;
    __syncthreads();
    if (it >= BATCH * 128) break;
    if (tid == 0) nxt = atomicAdd(q.ictr, 1);
    const int qt = 127 - (it >> 4), b = it & 15;
    idx_item(q, lds, tid, b, qt);
  }
}

__device__ __forceinline__ int toff(int row, int chunk) { return row * 128 + ((chunk ^ ((row >> 1) & 7)) << 4); }
__device__ __forceinline__ bf16x8 frag(LDSP const char* base, int row0, int kk, int l31, int h) {
  const int row = row0 + l31;
  return *(LDSP const bf16x8*)(base + row * 128 + ((((kk * 2 + h)) ^ ((row >> 1) & 7)) << 4));
}
__device__ __forceinline__ float bfu(unsigned short v) { return __uint_as_float((unsigned)v << 16); }

__device__ __forceinline__ float silu_fast(float v) { return v * __builtin_amdgcn_rcpf(1.f + __expf(-v)); }
__device__ __forceinline__ void gla_unit(CQ& q, LDSP char* lds, int tid, int b, int h) {
  CP& p = q.p;
  const int lane = tid & 63, wid = tid >> 6, l31 = lane & 31, hh = lane >> 5;
  LDSP float* W2S = (LDSP float*)(lds);
  LDSP float* BG = W2S + 1024;
  LDSP float* GB = (LDSP float*)(lds + 4352);
  LDSP float* SEG = (LDSP float*)(lds + 20736);
  LDSP float* DEC = (LDSP float*)(lds + 22784);
  LDSP float* SSQ = (LDSP float*)(lds + 23040);
  LDSP char* QT = lds + 24064;
  LDSP char* KT = lds + 32256;
  LDSP char* KRAW = lds + 40448;
  LDSP char* KH = lds + 48640;
  LDSP char* VRAW = lds + 56832;
  LDSP char* VT = lds + 73216;
  LDSP char* AM = lds + 89600;
  LDSP char* ST = lds + 97792;
  LDSP char* OST = lds + 114176;
  const int t = tid >> 3, c8 = tid & 7;
  __syncthreads();
  for (int i = tid; i < 1024; i += NTHR) W2S[i] = p.w_gk2[(i >> 6) * 256 + h * 64 + (i & 63)];
  if (tid < 64) BG[tid] = p.b_gk[h * 64 + tid];
  for (int i = tid; i < 4096; i += NTHR) ((LDSP unsigned*)ST)[i] = 0u;
  f32x16 Sacc[2];
#pragma unroll
  for (int r = 0; r < 16; ++r) { Sacc[0][r] = 0.f; Sacc[1][r] = 0.f; }
  const size_t tokb = (size_t)b * SEQ;
  u32x4 rq, rk, rv[2], rgo[2]; float4 rgk[4];
  {
    const size_t tok = tokb + t;
    const bf16_t* pr = q.proj2 + tok * NP;
    rq = *(const u32x4*)(pr + D_QG + h * 64 + c8 * 8);
    rk = *(const u32x4*)(pr + D_KG + h * 64 + c8 * 8);
    rv[0] = *(const u32x4*)(pr + D_VG + h * 128 + c8 * 8);
    rv[1] = *(const u32x4*)(pr + D_VG + h * 128 + 64 + c8 * 8);
    rgo[0] = *(const u32x4*)(pr + D_GO + h * 128 + c8 * 8);
    rgo[1] = *(const u32x4*)(pr + D_GO + h * 128 + 64 + c8 * 8);
#pragma unroll
    for (int i = 0; i < 4; ++i) rgk[i] = *(const float4*)(q.misc + tok * 32 + 4 + 4 * i);
  }
  __syncthreads();
  for (int c = 0; c < SEQ / 64; ++c) {
    const size_t tok = tokb + c * 64 + t;
    {
      const float gk[16] = {rgk[0].x, rgk[0].y, rgk[0].z, rgk[0].w, rgk[1].x, rgk[1].y, rgk[1].z, rgk[1].w,
                            rgk[2].x, rgk[2].y, rgk[2].z, rgk[2].w, rgk[3].x, rgk[3].y, rgk[3].z, rgk[3].w};
      float z[8];
#pragma unroll
      for (int j = 0; j < 8; ++j) z[j] = BG[c8 * 8 + j];
#pragma unroll
      for (int r = 0; r < 16; ++r) {
        const f32x4v w0 = *(LDSP const f32x4v*)(W2S + r * 64 + c8 * 8), w1 = *(LDSP const f32x4v*)(W2S + r * 64 + c8 * 8 + 4);
        z[0] += gk[r] * w0[0]; z[1] += gk[r] * w0[1]; z[2] += gk[r] * w0[2]; z[3] += gk[r] * w0[3];
        z[4] += gk[r] * w1[0]; z[5] += gk[r] * w1[1]; z[6] += gk[r] * w1[2]; z[7] += gk[r] * w1[3];
      }
      f32x4v g0, g1;
#pragma unroll
      for (int j = 0; j < 8; ++j) {
        const float ls = (fminf(z[j], 0.f) - __logf(1.f + __expf(-fabsf(z[j])))) * (1.f / 16.f);
        if (j < 4) g0[j] = ls; else g1[j - 4] = ls;
      }
      *(LDSP f32x4v*)(GB + t * 64 + c8 * 8) = g0;
      *(LDSP f32x4v*)(GB + t * 64 + c8 * 8 + 4) = g1;
      *(LDSP u32x4*)(KRAW + t * 128 + c8 * 16) = rk;
      *(LDSP u32x4*)(VRAW + t * 256 + c8 * 16) = rv[0];
      *(LDSP u32x4*)(VRAW + t * 256 + 128 + c8 * 16) = rv[1];
    }
    __syncthreads();
    {
      const int d = lane, seg = wid;
      float run = 0.f;
#pragma unroll
      for (int i = 0; i < 8; ++i) { run += GB[(seg * 8 + i) * 64 + d]; GB[(seg * 8 + i) * 64 + d] = run; }
      SEG[seg * 64 + d] = run;
      __syncthreads();
      float base = 0.f;
      for (int s2 = 0; s2 < seg; ++s2) base += SEG[s2 * 64 + d];
#pragma unroll
      for (int i = 0; i < 8; ++i) GB[(seg * 8 + i) * 64 + d] += base;
      if (seg == 7) DEC[d] = __expf(run + base);
    }
    __syncthreads();
    {
      const f32x4v b0 = *(LDSP const f32x4v*)(GB + t * 64 + c8 * 8), b1 = *(LDSP const f32x4v*)(GB + t * 64 + c8 * 8 + 4);
      const float bv[8] = {b0[0], b0[1], b0[2], b0[3], b1[0], b1[1], b1[2], b1[3]};
      const unsigned qw[4] = {rq.x, rq.y, rq.z, rq.w}, kw[4] = {rk.x, rk.y, rk.z, rk.w};
      unsigned qo[4], ko[4];
#pragma unroll
      for (int j = 0; j < 4; ++j) {
        const float e0 = __expf(bv[2 * j]), e1 = __expf(bv[2 * j + 1]);
        qo[j] = pk_bf16(bf_lo(qw[j]) * 0.125f * e0, bf_hi(qw[j]) * 0.125f * e1);
        ko[j] = pk_bf16(bf_lo(kw[j]) * __builtin_amdgcn_rcpf(e0), bf_hi(kw[j]) * __builtin_amdgcn_rcpf(e1));
      }
      *(LDSP u32x4*)(QT + toff(t, c8)) = (u32x4){qo[0], qo[1], qo[2], qo[3]};
      *(LDSP u32x4*)(KT + toff(t, c8)) = (u32x4){ko[0], ko[1], ko[2], ko[3]};
      {
        const int d = lane, seg = wid;
        const float bend = GB[63 * 64 + d];
        float kh[8];
#pragma unroll
        for (int i = 0; i < 8; ++i) {
          const int s2 = seg * 8 + i;
          kh[i] = bfu(*(LDSP const unsigned short*)(KRAW + (s2 * 64 + d) * 2)) * __expf(bend - GB[s2 * 64 + d]);
        }
        *(LDSP u32x4*)(KH + toff(d, seg)) = (u32x4){pk_bf16(kh[0], kh[1]), pk_bf16(kh[2], kh[3]), pk_bf16(kh[4], kh[5]), pk_bf16(kh[6], kh[7])};
      }
      {
        const int vcol = tid & 127, sg4 = tid >> 7;
#pragma unroll
        for (int half = 0; half < 2; ++half) {
          unsigned short e[8];
#pragma unroll
          for (int i = 0; i < 8; ++i) e[i] = *(LDSP const unsigned short*)(VRAW + ((sg4 * 16 + half * 8 + i) * 128 + vcol) * 2);
          *(LDSP u32x4*)(VT + toff(vcol, sg4 * 2 + half)) = (u32x4){(unsigned)e[0] | ((unsigned)e[1] << 16), (unsigned)e[2] | ((unsigned)e[3] << 16),
                                                                   (unsigned)e[4] | ((unsigned)e[5] << 16), (unsigned)e[6] | ((unsigned)e[7] << 16)};
        }
      }
    }
    __syncthreads();
    if (c + 1 < SEQ / 64) {
      const bf16_t* pr = q.proj2 + (tok + 64) * NP;
      rq = *(const u32x4*)(pr + D_QG + h * 64 + c8 * 8);
      rk = *(const u32x4*)(pr + D_KG + h * 64 + c8 * 8);
      rv[0] = *(const u32x4*)(pr + D_VG + h * 128 + c8 * 8);
      rv[1] = *(const u32x4*)(pr + D_VG + h * 128 + 64 + c8 * 8);
#pragma unroll
      for (int i = 0; i < 4; ++i) rgk[i] = *(const float4*)(q.misc + (tok + 64) * 32 + 4 + 4 * i);
    }
    f32x16 oacc[2];
    if (wid < 4) {
      const int sblk = wid & 1, tblk = wid >> 1;
      f32x16 a;
#pragma unroll
      for (int r = 0; r < 16; ++r) a[r] = 0.f;
      if (!(sblk == 1 && tblk == 0)) {
#pragma unroll
        for (int kk = 0; kk < 4; ++kk) a = __builtin_amdgcn_mfma_f32_32x32x16_bf16(frag(KT, sblk * 32, kk, l31, hh), frag(QT, tblk * 32, kk, l31, hh), a, 0, 0, 0);
      }
      const int tt = tblk * 32 + l31;
#pragma unroll
      for (int r = 0; r < 16; ++r) { const int s2 = sblk * 32 + (r & 3) + 8 * (r >> 2) + 4 * hh; if (s2 > tt) a[r] = 0.f; }
#pragma unroll
      for (int g = 0; g < 4; ++g)
        *(LDSP u32x2*)(AM + toff(tt, sblk * 4 + g) + 8 * hh) = (u32x2){pk_bf16(a[4 * g], a[4 * g + 1]), pk_bf16(a[4 * g + 2], a[4 * g + 3])};
    } else {
      const int j = wid - 4;
#pragma unroll
      for (int tb = 0; tb < 2; ++tb) {
#pragma unroll
        for (int r = 0; r < 16; ++r) oacc[tb][r] = 0.f;
#pragma unroll
        for (int kk = 0; kk < 4; ++kk) oacc[tb] = __builtin_amdgcn_mfma_f32_32x32x16_bf16(frag(ST, j * 32, kk, l31, hh), frag(QT, tb * 32, kk, l31, hh), oacc[tb], 0, 0, 0);
      }
    }
    __syncthreads();
    if (wid >= 4) {
      const int j = wid - 4;
#pragma unroll
      for (int tb = 0; tb < 2; ++tb) {
#pragma unroll
        for (int kk = 0; kk < 4; ++kk) oacc[tb] = __builtin_amdgcn_mfma_f32_32x32x16_bf16(frag(VT, j * 32, kk, l31, hh), frag(AM, tb * 32, kk, l31, hh), oacc[tb], 0, 0, 0);
        float ss = 0.f;
#pragma unroll
        for (int r = 0; r < 16; ++r) ss += oacc[tb][r] * oacc[tb][r];
        ss += __shfl_xor(ss, 32);
        const int tt = tb * 32 + l31;
        if (hh == 0) SSQ[j * 64 + tt] = ss;
#pragma unroll
        for (int g = 0; g < 4; ++g)
          *(LDSP u32x2*)(OST + tt * 256 + (((j * 4 + g) ^ (tt & 15)) << 4) + 8 * hh) = (u32x2){pk_bf16(oacc[tb][4 * g], oacc[tb][4 * g + 1]), pk_bf16(oacc[tb][4 * g + 2], oacc[tb][4 * g + 3])};
      }
    } else {
      const int db = wid & 1;
      float dec[16];
#pragma unroll
      for (int r = 0; r < 16; ++r) dec[r] = DEC[db * 32 + (r & 3) + 8 * (r >> 2) + 4 * hh];
#pragma unroll
      for (int i = 0; i < 2; ++i) {
        const int vb = (wid >> 1) * 2 + i;
#pragma unroll
        for (int r = 0; r < 16; ++r) Sacc[i][r] *= dec[r];
#pragma unroll
        for (int kk = 0; kk < 4; ++kk) Sacc[i] = __builtin_amdgcn_mfma_f32_32x32x16_bf16(frag(KH, db * 32, kk, l31, hh), frag(VT, vb * 32, kk, l31, hh), Sacc[i], 0, 0, 0);
        const int vv = vb * 32 + l31;
#pragma unroll
        for (int g = 0; g < 4; ++g)
          *(LDSP u32x2*)(ST + toff(vv, db * 4 + g) + 8 * hh) = (u32x2){pk_bf16(Sacc[i][4 * g], Sacc[i][4 * g + 1]), pk_bf16(Sacc[i][4 * g + 2], Sacc[i][4 * g + 3])};
      }
    }
    __syncthreads();
    {
      const float ssq = SSQ[t] + SSQ[64 + t] + SSQ[128 + t] + SSQ[192 + t];
      const float rs = rsqrtf(ssq * (1.f / 128.f) + 1e-6f);
#pragma unroll
      for (int k2 = 0; k2 < 2; ++k2) {
        const int c16 = c8 + 8 * k2;
        const u32x4 ov = *(LDSP const u32x4*)(OST + t * 256 + ((c16 ^ (t & 15)) << 4));
        const u32x4 gv = rgo[k2];
        const float4 n0 = *(const float4*)(p.gla_norm_w + h * 128 + c16 * 8), n1 = *(const float4*)(p.gla_norm_w + h * 128 + c16 * 8 + 4);
        const float nw[8] = {n0.x, n0.y, n0.z, n0.w, n1.x, n1.y, n1.z, n1.w};
        const unsigned ow[4] = {ov.x, ov.y, ov.z, ov.w}, gw[4] = {gv.x, gv.y, gv.z, gv.w};
        unsigned yo[4];
#pragma unroll
        for (int j = 0; j < 4; ++j) {
          const float y0 = bf_lo(ow[j]) * rs * nw[2 * j] * silu_fast(bf_lo(gw[j]));
          const float y1 = bf_hi(ow[j]) * rs * nw[2 * j + 1] * silu_fast(bf_hi(gw[j]));
          yo[j] = pk_bf16(y0, y1);
        }
        *(u32x4*)(q.mixer + tok * 1024 + 512 + h * 128 + c16 * 8) = (u32x4){yo[0], yo[1], yo[2], yo[3]};
      }
      if (c + 1 < SEQ / 64) {
        const bf16_t* pr = q.proj2 + (tok + 64) * NP;
        rgo[0] = *(const u32x4*)(pr + D_GO + h * 128 + c8 * 8);
        rgo[1] = *(const u32x4*)(pr + D_GO + h * 128 + 64 + c8 * 8);
      }
    }
  }
  __syncthreads();
}
__device__ __forceinline__ void phase3b(CQ& q, LDSP char* lds, int tid) {
  for (int u = blockIdx.x; u < BATCH * 4; u += gridDim.x) gla_unit(q, lds, tid, u >> 2, u & 3);
}

namespace att {
typedef short s16x4 __attribute__((ext_vector_type(4)));
typedef short v4i16_t __attribute__((ext_vector_type(4)));
typedef __attribute__((address_space(3))) const char* lds_cptr;
constexpr int NW = 8, QBLK = 32, QB = 256, KVBLK = 64;
constexpr int NSLOT = 3, SLOTB = 8192;
constexpr int LDS_K = 0, LDS_V = NSLOT * SLOTB, LDS_WS = 2 * NSLOT * SLOTB, LDS_OST = LDS_WS + NW * 64 * 4, LDS_MASK = LDS_OST + NW * 4096, LDS_END = LDS_MASK + NW * 8192;
static_assert(LDS_END <= LDS_BYTES, "attention LDS");
__device__ __forceinline__ int crow(int r, int hi) { return (r & 3) + 8 * (r >> 2) + 4 * hi; }
#define SBAR() __builtin_amdgcn_sched_barrier(0)
__device__ __forceinline__ void glds16(const void* gsrc, unsigned lds_dst) { unsigned keep;
  asm volatile("s_mov_b32 %0, m0\n\ts_mov_b32 m0, %2\n\ts_nop 0\n\tglobal_load_lds_dwordx4 %1, off\n\ts_mov_b32 m0, %0" : "=&s"(keep) : "v"(gsrc), "s"(lds_dst) : "memory"); }
__device__ __forceinline__ float max3f(float a, float b, float c) { float r; asm("v_max3_f32 %0, %1, %2, %3" : "=v"(r) : "v"(a), "v"(b), "v"(c)); return r; }
__device__ __forceinline__ float max2f(float a, float b) { float r; asm("v_max_f32_e32 %0, %1, %2" : "=v"(r) : "v"(a), "v"(b)); return r; }
__device__ __forceinline__ float fadd_s(float a, float b) { float r; asm("v_add_f32_e32 %0, %1, %2" : "=v"(r) : "v"(a), "v"(b)); return r; }
__device__ __forceinline__ float fsub_s(float a, float b) { float r; asm("v_sub_f32_e32 %0, %1, %2" : "=v"(r) : "v"(a), "v"(b)); return r; }
__device__ __forceinline__ unsigned cvtpk_s(float lo, float hi) { return pk_bf16(lo, hi); }
#define WAIT_BAR(N) asm volatile("s_waitcnt vmcnt(" #N ") lgkmcnt(0)\n\ts_barrier" ::: "memory")

__device__ __forceinline__ void qkt(f32x16& p0, f32x16& p1, const char* Kslot, const bf16x8* qr, int r32, int hi) {
  const f32x16 negm = {};
  const char* kb = Kslot + hi * 1024 + r32 * 16;
#pragma unroll
  for (int d0 = 0; d0 < 4; ++d0) {
    const bf16x8 b0 = *reinterpret_cast<const bf16x8*>(kb + d0 * 2048);
    const bf16x8 b1 = *reinterpret_cast<const bf16x8*>(kb + d0 * 2048 + 512);
    if (d0 == 0) { p0 = __builtin_amdgcn_mfma_f32_32x32x16_bf16(b0, qr[0], negm, 0, 0, 0); p1 = __builtin_amdgcn_mfma_f32_32x32x16_bf16(b1, qr[0], negm, 0, 0, 0); }
    else { p0 = __builtin_amdgcn_mfma_f32_32x32x16_bf16(b0, qr[d0], p0, 0, 0, 0); p1 = __builtin_amdgcn_mfma_f32_32x32x16_bf16(b1, qr[d0], p1, 0, 0, 0); } }
}
__device__ __forceinline__ void kload8(bf16x8* kf, lds_cptr kp) {
  kf[0] = *(const __attribute__((address_space(3))) bf16x8*)(kp);        kf[1] = *(const __attribute__((address_space(3))) bf16x8*)(kp + 512);
  kf[2] = *(const __attribute__((address_space(3))) bf16x8*)(kp + 2048); kf[3] = *(const __attribute__((address_space(3))) bf16x8*)(kp + 2560);
  kf[4] = *(const __attribute__((address_space(3))) bf16x8*)(kp + 4096); kf[5] = *(const __attribute__((address_space(3))) bf16x8*)(kp + 4608);
  kf[6] = *(const __attribute__((address_space(3))) bf16x8*)(kp + 6144); kf[7] = *(const __attribute__((address_space(3))) bf16x8*)(kp + 6656);
}
__device__ __forceinline__ void kload2(bf16x8* kf, lds_cptr kp, int j) { kf[2 * j] = *(const __attribute__((address_space(3))) bf16x8*)(kp + j * 2048); kf[2 * j + 1] = *(const __attribute__((address_space(3))) bf16x8*)(kp + j * 2048 + 512); }
__device__ __forceinline__ s16x4 vtr(lds_cptr p) { return __builtin_bit_cast(s16x4, __builtin_amdgcn_ds_read_tr16_b64_v4i16((__attribute__((address_space(3))) v4i16_t*)p)); }
__device__ __forceinline__ float rowmax(const f32x16& p0, const f32x16& p1) {
  float a = max3f(p0[0], p0[1], p1[0]), b = max3f(p0[2], p0[3], p1[1]); a = max3f(a, p1[2], p1[3]);
#pragma unroll
  for (int r = 4; r < 16; r += 4) { a = max3f(a, p0[r], p0[r + 1]); b = max3f(b, p0[r + 2], p0[r + 3]); a = max3f(a, p1[r], p1[r + 1]); b = max3f(b, p1[r + 2], p1[r + 3]); }
  const float m = max2f(a, b);
  auto rr = __builtin_amdgcn_permlane32_swap(__float_as_uint(m), __float_as_uint(m), false, false);
  return max2f(__uint_as_float(rr[0]), __uint_as_float(rr[1]));
}
__device__ __forceinline__ void pv(f32x16* o, int vb, bf16x8 pa0, bf16x8 pa1, bf16x8 pa2, bf16x8 pa3) {
#pragma unroll
  for (int d0 = 0; d0 < 2; ++d0) { s16x4 lo[4], hi[4];
#pragma unroll
    for (int ks = 0; ks < 4; ++ks) {
      asm volatile("ds_read_b64_tr_b16 %0,%1 offset:%c2" : "=&v"(lo[ks]) : "v"(vb), "i"(d0 * 4096 + ks * 1024) : "memory");
      asm volatile("ds_read_b64_tr_b16 %0,%1 offset:%c2" : "=&v"(hi[ks]) : "v"(vb), "i"(d0 * 4096 + ks * 1024 + 512) : "memory"); }
    asm volatile("s_waitcnt lgkmcnt(0)" ::: "memory"); SBAR();
#define PK(k) (bf16x8){lo[k][0], lo[k][1], lo[k][2], lo[k][3], hi[k][0], hi[k][1], hi[k][2], hi[k][3]}
    o[d0] = __builtin_amdgcn_mfma_f32_32x32x16_bf16(pa0, PK(0), o[d0], 0, 0, 0);
    o[d0] = __builtin_amdgcn_mfma_f32_32x32x16_bf16(pa1, PK(1), o[d0], 0, 0, 0);
    o[d0] = __builtin_amdgcn_mfma_f32_32x32x16_bf16(pa2, PK(2), o[d0], 0, 0, 0);
    o[d0] = __builtin_amdgcn_mfma_f32_32x32x16_bf16(pa3, PK(3), o[d0], 0, 0, 0);
#undef PK
  }
}
__device__ __forceinline__ void maskb(f32x16& p0, f32x16& p1, lds_cptr mp, int t, int hi, float mh) {
  const u32x2 mw = *(const __attribute__((address_space(3))) u32x2*)(mp + t * 256);
  const unsigned m0 = mw.x >> (4 * hi), m1 = mw.y >> (4 * hi);
#pragma unroll
  for (int r = 0; r < 16; ++r) {
    const int bp = (r & 3) + 8 * (r >> 2);
    p0[r] = ((m0 >> bp) & 1u) ? p0[r] - mh : -INFINITY;
    p1[r] = ((m1 >> bp) & 1u) ? p1[r] - mh : -INFINITY;
  }
}

template <int THRL>
__device__ __forceinline__ void attn_unit(int b, int head, int qb, const bf16_t* PJ, const unsigned* MASK, const float* onw, bf16_t* MIX, char* shm) {
  const int tid = threadIdx.x, lane = tid & 63, r32 = lane & 31, hi = lane >> 5; const int wid = __builtin_amdgcn_readfirstlane(tid >> 6);
  const long rowbase = (long)b * SEQ; const int q0 = qb * QB; const int g = head >> 2;
  constexpr int DM = NP;
  const bf16_t* Qw = PJ + (rowbase + q0 + wid * QBLK) * DM + D_QA + head * 64;
  const bf16_t* Kh = PJ + rowbase * DM + D_KA + g * 64; const bf16_t* Vh = PJ + rowbase * DM + D_VA + g * 64;
  const unsigned lds0 = (unsigned)(uintptr_t)shm;
  float* wsf = (float*)(shm + LDS_WS) + wid * 64;
  const bf16_t* ksrc = Kh + (long)lane * DM + wid * 8;
  const bf16_t* vsrc = Vh + (long)(16 * (wid & 3) + (lane >> 2)) * DM + (wid >> 2) * 32 + (lane & 3) * 8;
  const unsigned kdst = lds0 + LDS_K + wid * 1024, vdst = lds0 + LDS_V + wid * 1024;
#define DMA_K(t, slot) glds16(ksrc + (long)(t) * KVBLK * DM, (unsigned)__builtin_amdgcn_readfirstlane(kdst + (slot)))
#define DMA_V(t, slot) glds16(vsrc + (long)(t) * KVBLK * DM, (unsigned)__builtin_amdgcn_readfirstlane(vdst + (slot)))
  const int vb0 = (int)(lds0 + LDS_V) + ((lane >> 4) & 1) * 32 + (lane & 3) * 8 + (4 * hi + ((lane & 15) >> 2)) * 64;
  const char* Kbase = shm + LDS_K; bf16x8 kf[8];
  const lds_cptr shm3 = (lds_cptr)shm; const lds_cptr kp0 = shm3 + LDS_K + hi * 1024 + r32 * 16; const lds_cptr vp0 = shm3 + LDS_V + ((lane >> 4) & 1) * 32 + (lane & 3) * 8 + (4 * hi + ((lane & 15) >> 2)) * 64;
  const lds_cptr mp0 = shm3 + LDS_MASK + wid * 8192 + r32 * 8;
  const int NT = (q0 + QB) / KVBLK;
  {
    const unsigned* mg = MASK + (size_t)(rowbase + q0 + wid * QBLK + r32) * 64;
    __attribute__((address_space(3))) char* mw = (__attribute__((address_space(3))) char*)shm + LDS_MASK + wid * 8192 + r32 * 8;
#pragma unroll 4
    for (int it = 0; it < 16; ++it) {
      const int wp = it * 2 + hi;
      if (wp < NT) { const u32x2 m = *(const u32x2*)(mg + wp * 2); *(__attribute__((address_space(3))) u32x2*)(mw + wp * 256) = m; }
    }
    asm volatile("s_waitcnt vmcnt(0) lgkmcnt(0)" ::: "memory");
  }
  DMA_K(0, 0); DMA_V(0, 0); DMA_K(1, SLOTB);
  bf16x8 qr[4];
#pragma unroll
  for (int d0 = 0; d0 < 4; ++d0) qr[d0] = *reinterpret_cast<const bf16x8*>(&Qw[(long)r32 * DM + d0 * 16 + hi * 8]);
  float mhat = 0.f, l_reg = 0.f; f32x16 o[2]; o[0] = f32x16{}; o[1] = f32x16{}; const f32x16 zc = f32x16{};
#define CMASK(P0, P1, t) maskb(P0, P1, mp0, (t), hi, mhat)
  bool resc = false;
#define START(P0, P1) do { const float rm = max2f(rowmax(P0, P1), -30.f); resc = false; \
    { const float dl = rm; mhat = fadd_s(mhat, dl); \
      _Pragma("unroll") for (int r = 0; r < 16; ++r) { P0[r] = fsub_s(P0[r], dl); P1[r] = fsub_s(P1[r], dl); } } \
    _Pragma("unroll") for (int r = 0; r < 16; ++r) P0[r] = __builtin_amdgcn_exp2f(P0[r]); } while (0)
#define RESC() do { if (resc) { asm volatile("s_waitcnt lgkmcnt(0)" ::: "memory"); \
      _Pragma("unroll") for (int d_ = 0; d_ < 2; ++d_) _Pragma("unroll") for (int r = 0; r < 16; ++r) o[d_][r] *= wsf[crow(r, hi)]; } } while (0)
  f32x16 pA0, pA1, pB0, pB1;
  int sl_prev = 0, sl_cur = 0, sl_next = SLOTB;
#define ROT() do { sl_prev = sl_cur; sl_cur = sl_next; sl_next = (sl_next == (NSLOT - 1) * SLOTB) ? 0 : sl_next + SLOTB; } while (0)
  DMA_K(2, 2 * SLOTB);
  WAIT_BAR(3);
  qkt(pA0, pA1, Kbase, qr, r32, hi); asm volatile("s_nop 15\n\ts_nop 7" : "+v"(pA0), "+v"(pA1)); CMASK(pA0, pA1, 0);
  asm volatile("s_nop 3" : "+v"(pA0), "+v"(pA1));
  START(pA0, pA1);
  _Pragma("unroll") for (int r = 0; r < 16; ++r) pA1[r] = __builtin_amdgcn_exp2f(pA1[r]);
  WAIT_BAR(0);
  DMA_K(3, 0); DMA_V(1, SLOTB);
  ROT();
  kload8(kf, kp0 + sl_cur);
  WAIT_BAR(2);
  s16x4 vlo[8], vhi[8]; u32x4 pw0, pw1, pw2, pw3;
#define PKW(P, B) cvtpk_s(P[B], P[B + 1])
#define PAF(k) __builtin_bit_cast(bf16x8, pw##k)
#define VFR(i) (bf16x8){vlo[i][0], vlo[i][1], vlo[i][2], vlo[i][3], vhi[i][0], vhi[i][1], vhi[i][2], vhi[i][3]}
#define PIN(x) asm volatile("" : "+v"(x))
#define MX3(a, b, c) __builtin_fmaxf(__builtin_fmaxf((a), (b)), (c))
#define GAPA(MF, A0, A1, A2, A3, W0, W1, PW) do { MF; sacc += A0; sacc += A1; sacc += A2; sacc += A3; PIN(sacc); W0; W1; PIN(PW); SBAR(); } while (0)
#define EX(v) __builtin_amdgcn_exp2f(v)
#define GAPB(MF, X, B) do { MF; X[B] = EX(X[B]); X[B + 1] = EX(X[B + 1]); X[B + 2] = EX(X[B + 2]); X[B + 3] = EX(X[B + 3]); PIN(X); SBAR(); } while (0)
#define VRD(i) do { vlo[i] = vtr(vp_ + (((i) >> 2) * 4096 + ((i) & 3) * 1024)); vhi[i] = vtr(vp_ + (((i) >> 2) * 4096 + ((i) & 3) * 1024 + 512)); } while (0)
#define KRD(G, j) do { if (G) { kload2(kf, kp0 + sl_next, j); SBAR(); } } while (0)
#define STEP(C0, C1, P0, P1, t, GK, GV, GL) do { SBAR(); \
    const lds_cptr vp_ = vp0 + sl_prev; \
    VRD(0); SBAR(); float sacc = (P0[0] + P0[1]); \
    GAPA(C0 = __builtin_amdgcn_mfma_f32_32x32x16_bf16(kf[0], qr[0], zc, 0, 0, 0), P0[2], P0[3], P0[4], P0[5],     pw0[0] = PKW(P0, 0), pw0[1] = PKW(P0, 2), pw0); \
    VRD(4); SBAR(); GAPA(C1 = __builtin_amdgcn_mfma_f32_32x32x16_bf16(kf[1], qr[0], zc, 0, 0, 0), P0[6], P0[7], P0[8], P0[9],     pw0[2] = PKW(P0, 4), pw0[3] = PKW(P0, 6), pw0); \
    VRD(1); SBAR(); GAPA(C0 = __builtin_amdgcn_mfma_f32_32x32x16_bf16(kf[2], qr[1], C0, 0, 0, 0),   P0[10], P0[11], P0[12], P0[13], pw1[0] = PKW(P0, 8), pw1[1] = PKW(P0, 10), pw1); \
    VRD(5); SBAR(); GAPA(C1 = __builtin_amdgcn_mfma_f32_32x32x16_bf16(kf[3], qr[1], C1, 0, 0, 0),   P0[14], P0[15], P1[0], P1[1],   pw1[2] = PKW(P0, 12), pw1[3] = PKW(P0, 14), pw1); \
    VRD(2); SBAR(); GAPA(C0 = __builtin_amdgcn_mfma_f32_32x32x16_bf16(kf[4], qr[2], C0, 0, 0, 0),   P1[2], P1[3], P1[4], P1[5],     pw2[0] = PKW(P1, 0), pw2[1] = PKW(P1, 2), pw2); \
    VRD(6); SBAR(); GAPA(C1 = __builtin_amdgcn_mfma_f32_32x32x16_bf16(kf[5], qr[2], C1, 0, 0, 0),   P1[6], P1[7], P1[8], P1[9],     pw2[2] = PKW(P1, 4), pw2[3] = PKW(P1, 6), pw2); \
    VRD(3); SBAR(); GAPA(C0 = __builtin_amdgcn_mfma_f32_32x32x16_bf16(kf[6], qr[3], C0, 0, 0, 0),   P1[10], P1[11], P1[12], P1[13], pw3[0] = PKW(P1, 8), pw3[1] = PKW(P1, 10), pw3); \
    VRD(7); SBAR(); GAPA(C1 = __builtin_amdgcn_mfma_f32_32x32x16_bf16(kf[7], qr[3], C1, 0, 0, 0),   P1[14], P1[15], 0.f, 0.f,       pw3[2] = PKW(P1, 12), pw3[3] = PKW(P1, 14), pw3); \
    l_reg += sacc; \
    if (GK) { DMA_K((t) + 3, sl_cur); } if (GV) { DMA_V((t) + 1, sl_next); } \
    CMASK(C0, C1, t); \
    { float a = MX3(C0[0], C0[1], C1[0]), b_ = MX3(C0[2], C0[3], C1[1]); a = MX3(a, C1[2], C1[3]); \
      _Pragma("unroll") for (int r = 4; r < 16; r += 4) { a = MX3(a, C0[r], C0[r + 1]); b_ = MX3(b_, C0[r + 2], C0[r + 3]); a = MX3(a, C1[r], C1[r + 1]); b_ = MX3(b_, C1[r + 2], C1[r + 3]); } \
      float rm = __builtin_fmaxf(a, b_); { auto rr = __builtin_amdgcn_permlane32_swap(__float_as_uint(rm), __float_as_uint(rm), false, false); rm = __builtin_fmaxf(__uint_as_float(rr[0]), __uint_as_float(rr[1])); } \
      resc = false; \
      if (__builtin_expect(__any(rm > (float)THRL), 0)) { const float dl = __builtin_fmaxf(rm, 0.f); mhat += dl; \
        _Pragma("unroll") for (int r = 0; r < 16; ++r) { C0[r] -= dl; C1[r] -= dl; } \
        const float f = __builtin_amdgcn_exp2f(-dl); l_reg *= f; if (hi == 0) wsf[r32] = f; resc = true; } } \
    SBAR(); \
    GAPB(o[0] = __builtin_amdgcn_mfma_f32_32x32x16_bf16(PAF(0), VFR(0), o[0], 0, 0, 0), C0, 0); \
    GAPB(o[1] = __builtin_amdgcn_mfma_f32_32x32x16_bf16(PAF(0), VFR(4), o[1], 0, 0, 0), C0, 4); \
    KRD(GL, 0); GAPB(o[0] = __builtin_amdgcn_mfma_f32_32x32x16_bf16(PAF(1), VFR(1), o[0], 0, 0, 0), C0, 8); \
    KRD(GL, 1); GAPB(o[1] = __builtin_amdgcn_mfma_f32_32x32x16_bf16(PAF(1), VFR(5), o[1], 0, 0, 0), C0, 12); \
    KRD(GL, 2); GAPB(o[0] = __builtin_amdgcn_mfma_f32_32x32x16_bf16(PAF(2), VFR(2), o[0], 0, 0, 0), C1, 0); \
    KRD(GL, 3); GAPB(o[1] = __builtin_amdgcn_mfma_f32_32x32x16_bf16(PAF(2), VFR(6), o[1], 0, 0, 0), C1, 4); \
    GAPB(o[0] = __builtin_amdgcn_mfma_f32_32x32x16_bf16(PAF(3), VFR(3), o[0], 0, 0, 0), C1, 8); \
    GAPB(o[1] = __builtin_amdgcn_mfma_f32_32x32x16_bf16(PAF(3), VFR(7), o[1], 0, 0, 0), C1, 12); \
    } while (0)
  int t = 1;
  for (; t + 5 < NT; t += 2) {
    STEP(pB0, pB1, pA0, pA1, t, true, true, true);     WAIT_BAR(2); RESC(); ROT();
    STEP(pA0, pA1, pB0, pB1, t + 1, true, true, true); WAIT_BAR(2); RESC(); ROT();
  }
#define ENDW(tt) do { if ((tt) + 3 < NT) { WAIT_BAR(2); } else if ((tt) + 2 < NT) { WAIT_BAR(1); } else { WAIT_BAR(0); } } while (0)
  for (; t + 1 < NT; t += 2) {
    STEP(pB0, pB1, pA0, pA1, t, (t + 3 < NT), (t + 1 < NT), (t + 1 < NT));         ENDW(t);     RESC(); ROT();
    STEP(pA0, pA1, pB0, pB1, t + 1, (t + 4 < NT), (t + 2 < NT), (t + 2 < NT));     ENDW(t + 1); RESC(); ROT();
  }
  STEP(pB0, pB1, pA0, pA1, NT - 1, false, false, false); RESC();
  { float sacc = pB0[0] + pB0[1]; _Pragma("unroll") for (int r = 2; r < 16; ++r) sacc += pB0[r]; _Pragma("unroll") for (int r = 0; r < 16; ++r) sacc += pB1[r]; l_reg += sacc;
    pw0 = (u32x4){PKW(pB0, 0), PKW(pB0, 2), PKW(pB0, 4), PKW(pB0, 6)}; pw1 = (u32x4){PKW(pB0, 8), PKW(pB0, 10), PKW(pB0, 12), PKW(pB0, 14)}; pw2 = (u32x4){PKW(pB1, 0), PKW(pB1, 2), PKW(pB1, 4), PKW(pB1, 6)}; pw3 = (u32x4){PKW(pB1, 8), PKW(pB1, 10), PKW(pB1, 12), PKW(pB1, 14)};
    SBAR(); pv(o, vb0 + sl_cur, PAF(0), PAF(1), PAF(2), PAF(3)); }
#undef PKW
#undef PAF
#undef VFR
#undef PIN
#undef MX3
#undef GAPA
#undef GAPB
#undef EX
#undef VRD
#undef KRD
#undef STEP
#undef ENDW
  { auto rr = __builtin_amdgcn_permlane32_swap(__float_as_uint(l_reg), __float_as_uint(l_reg), false, false); l_reg = __uint_as_float(rr[0]) + __uint_as_float(rr[1]); }
  if (hi == 0) wsf[32 + r32] = l_reg; asm volatile("s_waitcnt lgkmcnt(0)" ::: "memory");
  float rli[16];
#pragma unroll
  for (int r = 0; r < 16; ++r) rli[r] = __builtin_amdgcn_rcpf(wsf[32 + crow(r, hi)]);
  bf16_t* Ow = MIX + (rowbase + q0 + wid * QBLK) * 1024 + head * 64;
  { __hip_bfloat16* stg = (__hip_bfloat16*)(shm + LDS_OST) + wid * 2048;
#pragma unroll
    for (int r = 0; r < 16; ++r) { const int orow = crow(r, hi);
#pragma unroll
      for (int d0 = 0; d0 < 2; ++d0) stg[orow * 64 + d0 * 32 + r32] = __float2bfloat16(o[d0][r] * rli[r]); }
    asm volatile("s_waitcnt lgkmcnt(0)" ::: "memory");
    const int ch = lane & 7;
    const float4 nw0 = *(const float4*)(onw + head * 64 + ch * 8), nw1 = *(const float4*)(onw + head * 64 + ch * 8 + 4);
#pragma unroll
    for (int i = 0; i < 4; ++i) { const int row = i * 8 + (lane >> 3);
      const u32x4 v = *(const u32x4*)(stg + row * 64 + ch * 8);
      float f[8] = {bf_lo(v.x), bf_hi(v.x), bf_lo(v.y), bf_hi(v.y), bf_lo(v.z), bf_hi(v.z), bf_lo(v.w), bf_hi(v.w)};
      float ss = 0.f;
#pragma unroll
      for (int j = 0; j < 8; ++j) ss += f[j] * f[j];
      ss += __shfl_xor(ss, 1); ss += __shfl_xor(ss, 2); ss += __shfl_xor(ss, 4);
      const float rs = rsqrtf(ss * (1.f / 64.f) + 1e-6f);
      u32x4 w; w.x = pk_bf16(f[0] * rs * nw0.x, f[1] * rs * nw0.y); w.y = pk_bf16(f[2] * rs * nw0.z, f[3] * rs * nw0.w);
      w.z = pk_bf16(f[4] * rs * nw1.x, f[5] * rs * nw1.y); w.w = pk_bf16(f[6] * rs * nw1.z, f[7] * rs * nw1.w);
      *(u32x4*)(Ow + (long)row * 1024 + ch * 8) = w; } }
  asm volatile("s_waitcnt lgkmcnt(0)\n\ts_barrier" ::: "memory");
#undef DMA_K
#undef DMA_V
#undef CMASK
#undef START
#undef RESC
#undef ROT
}
#undef SBAR
#undef WAIT_BAR
}


__device__ __forceinline__ void phase6(CQ& q, LDSP char* lds, int tid) {
  CP& p = q.p;
  const int lane = tid & 63, wid = tid >> 6, l31 = lane & 31, hh = lane >> 5;
  const int G = gridDim.x, bid = blockIdx.x;
  const int xcd = bid & 7, lix = bid >> 3, per = G >> 3;
  const int wr = wid >> 2, wc = wid & 3;
  bool pre = false;
  const unsigned lo1024 = Core256::lane_off(tid, 2048u);
  for (int it = lix; it < 16 * 4; it += per) {
    const int tt = xcd + 8 * (it / 4), ct = it % 4;
    const int m0 = tt * 256, n0 = ct * 256;
    Desc2 d;
    d.rbase = (const char*)(q.mixer + (size_t)m0 * 1024); d.rlo = lo1024; d.rstride = 128u * 2048u;
    d.cbase = (const char*)(q.wt_out + (size_t)n0 * 1024); d.clo = lo1024; d.cstride = 128u * 2048u;
    d.nk = 32;
    f32x16 acc[4][2];
#pragma unroll
    for (int a = 0; a < 4; ++a)
#pragma unroll
      for (int b2 = 0; b2 < 2; ++b2)
#pragma unroll
        for (int r = 0; r < 16; ++r) acc[a][b2][r] = 0.f;
    Core256::run(acc, d, lds, tid, pre);
    pre = false;
    if (it + per < 16 * 4) {
      const int it2 = it + per; const int tt2 = xcd + 8 * (it2 / 4), ct2 = it2 % 4;
      Desc2 d2 = d;
      d2.rbase = (const char*)(q.mixer + (size_t)tt2 * 256 * 1024); d2.cbase = (const char*)(q.wt_out + (size_t)ct2 * 256 * 1024);
      Core256::prefetch0(d2, lds, tid);
      pre = true;
    }
    LDSP char* wl = lds + 32768 + wid * 13312;
    const int bb = m0 / SEQ;
#pragma unroll
    for (int ri = 0; ri < 4; ++ri) {
#pragma unroll
      for (int ci = 0; ci < 2; ++ci)
#pragma unroll
        for (int r = 0; r < 16; ++r) {
          const int trow = (r & 3) + 8 * (r >> 2) + 4 * hh;
          *(LDSP float*)(wl + trow * 272 + (ci * 32 + l31) * 4) = acc[ri][ci][r];
        }
      const int erow = lane >> 4, ech = lane & 15;
      const int n = n0 + wc * 64 + ech * 4;
      const float4 g1 = *(const float4*)(p.mod + bb * 6144 + 2048 + n);
#pragma unroll
      for (int i = 0; i < 8; ++i) {
        const int row = erow + 4 * i;
        const f32x4v a4 = *(LDSP const f32x4v*)(wl + row * 272 + ech * 16);
        const size_t tok = (size_t)m0 + wr * 128 + ri * 32 + row;
        const float4 xv = *(const float4*)(p.x + tok * D_MODEL + n);
        *(float4*)(p.out + tok * D_MODEL + n) = make_float4(xv.x + g1.x * a4[0], xv.y + g1.y * a4[1], xv.z + g1.z * a4[2], xv.w + g1.w * a4[3]);
      }
      asm volatile("s_waitcnt lgkmcnt(0)" ::: "memory");
    }
  }
}

__device__ __forceinline__ void phase7(CQ& q, int tid) {
  CP& p = q.p;
  const int lane = tid & 63, wv = tid >> 6;
  const int nwv = gridDim.x * 8;
  for (int t0 = (blockIdx.x * 8 + wv) * 2; t0 < NTOK; t0 += nwv * 2) {
    float4 v[2][4];
#pragma unroll
    for (int u = 0; u < 2; ++u)
#pragma unroll
      for (int i = 0; i < 4; ++i) v[u][i] = *(const float4*)(p.out + (size_t)(t0 + u) * D_MODEL + i * 256 + lane * 4);
#pragma unroll
    for (int u = 0; u < 2; ++u) {
      const int t = t0 + u;
      const int b = t / SEQ;
      float ss = 0.f;
#pragma unroll
      for (int i = 0; i < 4; ++i) ss += v[u][i].x * v[u][i].x + v[u][i].y * v[u][i].y + v[u][i].z * v[u][i].z + v[u][i].w * v[u][i].w;
      ss = wave_sum(ss);
      const float r = rsqrtf(ss / D_MODEL + 1e-6f);
      const float* md = p.mod + b * 6144;
#pragma unroll
      for (int i = 0; i < 4; ++i) {
        const int d = i * 256 + lane * 4;
        const float4 w = *(const float4*)(p.norm2_w + d);
        const float4 sh = *(const float4*)(md + 3072 + d);
        const float4 sc = *(const float4*)(md + 4096 + d);
        u32x2 w2; w2.x = pk_bf16(v[u][i].x * r * w.x * (1.f + sc.x) + sh.x, v[u][i].y * r * w.y * (1.f + sc.y) + sh.y);
        w2.y = pk_bf16(v[u][i].z * r * w.z * (1.f + sc.z) + sh.z, v[u][i].w * r * w.w * (1.f + sc.w) + sh.w);
        *(u32x2*)(q.h2 + (size_t)t * D_MODEL + d) = w2;
        *(unsigned*)(q.h2f8 + (size_t)t * D_MODEL + d) = pk4_fp8(bf_lo(w2.x) * 16.f, bf_hi(w2.x) * 16.f, bf_lo(w2.y) * 16.f, bf_hi(w2.y) * 16.f);
      }

    }
  }
}

#define LROW 260
__device__ __forceinline__ void phase8(CQ& q, LDSP char* lds, int tid) {
  CP& p = q.p;
  const int lane = tid & 63, wid = tid >> 6, l31 = lane & 31, hh = lane >> 5;
  typedef GemmCoreD<4, 2, 3, true> GC;
  const int wr = wid / 2, wc = wid % 2;
  for (int it = blockIdx.x; it < NTOK / 128; it += gridDim.x) {
    const int m0 = it * 128;
    for (int rr = 0; rr < 16; rr += 2) {
      const int t0 = m0 + wid * 16 + rr;
      float4 v[2][4];
#pragma unroll
      for (int u = 0; u < 2; ++u)
#pragma unroll
        for (int i = 0; i < 4; ++i) v[u][i] = *(const float4*)(p.out + (size_t)(t0 + u) * D_MODEL + i * 256 + lane * 4);
#pragma unroll
      for (int u = 0; u < 2; ++u) {
        const int t = t0 + u;
        const int b = t / SEQ;
        float ss = 0.f;
#pragma unroll
        for (int i = 0; i < 4; ++i) ss += v[u][i].x * v[u][i].x + v[u][i].y * v[u][i].y + v[u][i].z * v[u][i].z + v[u][i].w * v[u][i].w;
        ss = wave_sum(ss);
        const float r = rsqrtf(ss / D_MODEL + 1e-6f);
        const float* md = p.mod + b * 6144;
#pragma unroll
        for (int i = 0; i < 4; ++i) {
          const int d = i * 256 + lane * 4;
          const float4 w = *(const float4*)(p.norm2_w + d);
          const float4 sh = *(const float4*)(md + 3072 + d);
          const float4 sc = *(const float4*)(md + 4096 + d);
          u32x2 w2; w2.x = pk_bf16(v[u][i].x * r * w.x * (1.f + sc.x) + sh.x, v[u][i].y * r * w.y * (1.f + sc.y) + sh.y);
          w2.y = pk_bf16(v[u][i].z * r * w.z * (1.f + sc.z) + sh.z, v[u][i].w * r * w.w * (1.f + sc.w) + sh.w);
          *(u32x2*)(q.h2 + (size_t)t * D_MODEL + d) = w2;
          *(unsigned*)(q.h2f8 + (size_t)t * D_MODEL + d) = pk4_fp8(bf_lo(w2.x) * 16.f, bf_hi(w2.x) * 16.f, bf_lo(w2.y) * 16.f, bf_hi(w2.y) * 16.f);
        }
      }
    }
    asm volatile("s_waitcnt vmcnt(0)" ::: "memory");
    __syncthreads();
    const int crow = tid >> 3, cch = tid & 7;
    const bf16_t* rp[4]; const bf16_t* cp[2];
#pragma unroll
    for (int i = 0; i < 4; ++i) rp[i] = q.wt_router + (size_t)(crow + 64 * i) * 1024;
#pragma unroll
    for (int i = 0; i < 2; ++i) cp[i] = q.h2 + (size_t)(m0 + crow + 64 * i) * 1024;
    f32x16 acc[2][2];
#pragma unroll
    for (int a = 0; a < 2; ++a)
#pragma unroll
      for (int b2 = 0; b2 < 2; ++b2)
#pragma unroll
        for (int r = 0; r < 16; ++r) acc[a][b2][r] = 0.f;
    GC::run(acc, rp, cp, 1024, lds, tid);
    LDSP float* L = (LDSP float*)lds;
    LDSP int* REC = (LDSP int*)(lds + 139264);
#pragma unroll
    for (int ci = 0; ci < 2; ++ci) {
      const int tl = wc * 64 + ci * 32 + l31;
#pragma unroll
      for (int ri = 0; ri < 2; ++ri)
#pragma unroll
        for (int g = 0; g < 4; ++g) {
          const int e0 = wr * 64 + ri * 32 + 8 * g + 4 * hh;
          *(LDSP f32x4v*)(L + tl * LROW + e0) = (f32x4v){acc[ri][ci][4 * g], acc[ri][ci][4 * g + 1], acc[ri][ci][4 * g + 2], acc[ri][ci][4 * g + 3]};
        }
    }
    __syncthreads();
    const float4 br = *(const float4*)(p.b_router + lane * 4);
    const unsigned long long ltmask = (1ull << lane) - 1ull;
    for (int k = 0; k < 16; ++k) {
      const int tl = wid * 16 + k;
      const int t = m0 + tl;
      const f32x4v lg = *(LDSP const f32x4v*)(L + tl * LROW + lane * 4);
      float sg[4] = {1.f / (1.f + __expf(-lg[0])), 1.f / (1.f + __expf(-lg[1])), 1.f / (1.f + __expf(-lg[2])), 1.f / (1.f + __expf(-lg[3]))};
      const float bsc[4] = {sg[0] + br.x, sg[1] + br.y, sg[2] + br.z, sg[3] + br.w};
      float m1 = -INFINITY, m2 = -INFINITY;
#pragma unroll
      for (int i = 0; i < 4; ++i) { const float v = bsc[i]; if (v > m1) { m2 = m1; m1 = v; } else if (v > m2) m2 = v; }
#pragma unroll
      for (int o = 1; o < 8; o <<= 1) {
        const float o1 = __shfl_xor(m1, o), o2 = __shfl_xor(m2, o);
        const float n1 = fmaxf(m1, o1), n2 = fmaxf(fminf(m1, o1), fmaxf(m2, o2));
        m1 = n1; m2 = n2;
      }
      const float gs = m1 + m2;
      const int gi = lane >> 3;
      int rank = 0;
#pragma unroll
      for (int j = 0; j < 8; ++j) { const float gj = __uint_as_float(__builtin_amdgcn_readlane(__float_as_uint(gs), j * 8)); rank += (gj > gs || (gj == gs && j < gi)) ? 1 : 0; }
      unsigned u[4];
#pragma unroll
      for (int i = 0; i < 4; ++i) {
        const unsigned bits = __float_as_uint(bsc[i] + 0.0f);
        const unsigned enc = (bits & 0x80000000u) ? ~bits : (bits | 0x80000000u);
        u[i] = (rank < 4) ? enc : 0u;
      }
      unsigned tau = 0u; bool exact = false;
      for (int bit = 31; bit >= 0; --bit) {
        const unsigned cand = tau | (1u << bit);
        int cnt = 0;
#pragma unroll
        for (int i = 0; i < 4; ++i) cnt += __builtin_popcountll(__ballot(u[i] >= cand));
        if (cnt >= 8) { tau = cand; if (cnt == 8) { exact = true; break; } }
      }
      int need = 8;
      if (!exact) { int cgt = 0;
#pragma unroll
        for (int i = 0; i < 4; ++i) cgt += __builtin_popcountll(__ballot(u[i] > tau));
        need = 8 - cgt; }
      bool selb[4]; unsigned long long sb[4];
      {
        unsigned long long tb[4];
#pragma unroll
        for (int i = 0; i < 4; ++i) tb[i] = __ballot(u[i] == tau);
        int tpre = 0;
#pragma unroll
        for (int i = 0; i < 4; ++i) tpre += __builtin_popcountll(tb[i] & ltmask);
#pragma unroll
        for (int i = 0; i < 4; ++i) {
          const bool tie = (u[i] == tau);
          selb[i] = exact ? (u[i] >= tau) : ((u[i] > tau) || (tie && tpre < need));
          tpre += tie ? 1 : 0;
        }
#pragma unroll
        for (int i = 0; i < 4; ++i) sb[i] = __ballot(selb[i]);
      }
      float wsum = 0.f;
#pragma unroll
      for (int i = 0; i < 4; ++i) {
        unsigned long long m = sb[i];
        while (m) { const int l = __builtin_ctzll(m); m &= m - 1ull; wsum += __uint_as_float(__builtin_amdgcn_readlane(__float_as_uint(sg[i]), l)); }
      }
      int kpre = 0;
#pragma unroll
      for (int i = 0; i < 4; ++i) kpre += __builtin_popcountll(sb[i] & ltmask);
      const float wscale = 2.5f / wsum;
#pragma unroll
      for (int i = 0; i < 4; ++i) {
        if (selb[i]) {
          const int e = lane * 4 + i;
          const int tk = t * 8 + kpre;
          p.selw[tk] = sg[i] * wscale;
          REC[tl * 8 + kpre] = e;
          ++kpre;
        }
      }
    }
    __syncthreads();
#pragma unroll
    for (int a2 = 0; a2 < 2; ++a2) {
      const int ai = tid + a2 * NTHR;
      const int e = REC[ai];
      const int slot = atomicAdd(&p.counts[e * 64], 1);
      q.list[(size_t)e * LCAP + slot] = (m0 + (ai >> 3)) * 8 + (ai & 7);
    }
    __syncthreads();
  }
}

template <class F>
__device__ __forceinline__ void conv_tile4(const F& f, int k0, bf16_t* dst, int ldd, int nd0, LDSP float* T, int tid) {
  LDSP char* Tb = (LDSP char*)(T + 64 * 260);
  {
    const int j4 = (tid & 63) * 4;
    int ld; const float* pcol = f(j4, ld);
    float4 v[8];
#pragma unroll
    for (int hh = 0; hh < 8; ++hh) v[hh] = *(const float4*)(pcol + (size_t)(k0 + (tid >> 6) + 8 * hh) * ld);
#pragma unroll
    for (int hh = 0; hh < 8; ++hh) { const int kr = (tid >> 6) + 8 * hh; *(LDSP f32x4v*)(T + kr * 260 + j4) = (f32x4v){v[hh].x, v[hh].y, v[hh].z, v[hh].w}; }
  }
  __syncthreads();
  {
    const int kc = tid >> 6;
#pragma unroll
    for (int pp = 0; pp < 4; ++pp) {
      const int n = (tid & 63) + 64 * pp;
      float v[8];
#pragma unroll
      for (int i = 0; i < 8; ++i) v[i] = T[(kc * 8 + i) * 260 + n];
      u32x4 w; w.x = pk_bf16(v[0], v[1]); w.y = pk_bf16(v[2], v[3]); w.z = pk_bf16(v[4], v[5]); w.w = pk_bf16(v[6], v[7]);
      *(LDSP u32x4*)(Tb + n * 128 + ((kc ^ (n & 7)) << 4)) = w;
    }
  }
  __syncthreads();
  {
    const int ch = tid & 7;
#pragma unroll
    for (int pp = 0; pp < 4; ++pp) {
      const int n = (tid >> 3) + 64 * pp;
      const u32x4 w = *(LDSP const u32x4*)(Tb + n * 128 + ((ch ^ (n & 7)) << 4));
      *(u32x4*)(dst + (size_t)(nd0 + n) * ldd + k0 + ch * 8) = w;
    }
  }
  __syncthreads();
}

template <class F>
__device__ __forceinline__ void conv_tile4_fp8(const F& f, int k0, unsigned char* dst, int ldd, int nd0, float scale, LDSP float* T, int tid) {
  LDSP char* Tb = (LDSP char*)(T + 64 * 260);
  {
    const int j4 = (tid & 63) * 4;
    int ld; const float* pcol = f(j4, ld);
    float4 v[8];
#pragma unroll
    for (int hh = 0; hh < 8; ++hh) v[hh] = *(const float4*)(pcol + (size_t)(k0 + (tid >> 6) + 8 * hh) * ld);
#pragma unroll
    for (int hh = 0; hh < 8; ++hh) { const int kr = (tid >> 6) + 8 * hh; *(LDSP f32x4v*)(T + kr * 260 + j4) = (f32x4v){v[hh].x, v[hh].y, v[hh].z, v[hh].w}; }
  }
  __syncthreads();
  {
    const int kc = tid >> 6;
#pragma unroll
    for (int pp = 0; pp < 4; ++pp) {
      const int n = (tid & 63) + 64 * pp;
      float v[8];
#pragma unroll
      for (int i = 0; i < 8; ++i) v[i] = T[(kc * 8 + i) * 260 + n] * scale;
      *(LDSP u32x2*)(Tb + n * 64 + kc * 8) = (u32x2){pk4_fp8(v[0], v[1], v[2], v[3]), pk4_fp8(v[4], v[5], v[6], v[7])};
    }
  }
  __syncthreads();
  {
    const int ch = tid & 3;
#pragma unroll
    for (int pp = 0; pp < 2; ++pp) {
      const int n = (tid >> 2) + 128 * pp;
      const u32x4 w = *(LDSP const u32x4*)(Tb + n * 64 + ch * 16);
      *(u32x4*)(dst + (size_t)(nd0 + n) * ldd + k0 + ch * 16) = w;
    }
  }
  __syncthreads();
}
struct ConvSrc { const float* p0; const float* p1; int ld; };
__device__ __forceinline__ const float* conv_addr(CP& p, int it, int tid, int& ld, int& k0) {
  const int e = it / 48, r = it % 48;
  const int j4 = (tid & 63) * 4;
  if (r < 32) {
    const int kt = r >> 1, hq = r & 1;
    const float* wg = (e < 256) ? p.we_gate + (size_t)e * 1024 * 256 : p.ws_gate;
    const float* wu = (e < 256) ? p.we_up + (size_t)e * 1024 * 256 : p.ws_up;
    ld = 256; k0 = kt * 64;
    const int hb = hq * 4 + (j4 >> 6), w64 = j4 & 63;
    return (w64 < 32) ? wg + hb * 32 + w64 : wu + hb * 32 + (w64 - 32);
  } else {
    const int r2 = r - 32, kt = r2 >> 2, nq = r2 & 3;
    const float* wdn = (e < 256) ? p.we_down + (size_t)e * 256 * 1024 : p.ws_down;
    ld = 1024; k0 = kt * 64;
    return wdn + nq * 256 + j4;
  }
}
__device__ __forceinline__ void phase0_experts(CQ& q, LDSP char* lds, int tid, int first, int G) {
  CP& p = q.p;
  LDSP float* T = (LDSP float*)lds;
  LDSP char* Tb = (LDSP char*)(T + 64 * 260);
  const int total = 257 * 48;
  int it = first;
  float4 v[8];
  if (it < total) {
    int ld, k0; const float* pc = conv_addr(p, it, tid, ld, k0);
#pragma unroll
    for (int hh = 0; hh < 8; ++hh) v[hh] = *(const float4*)(pc + (size_t)(k0 + (tid >> 6) + 8 * hh) * ld);
  }
  for (; it < total; it += G) {
    const int e = it / 48, r = it % 48;
    {
      const int j4 = (tid & 63) * 4;
#pragma unroll
      for (int hh = 0; hh < 8; ++hh) { const int kr = (tid >> 6) + 8 * hh; *(LDSP f32x4v*)(T + kr * 260 + j4) = (f32x4v){v[hh].x, v[hh].y, v[hh].z, v[hh].w}; }
    }
    if (it + G < total) {
      int ld, k0; const float* pc = conv_addr(p, it + G, tid, ld, k0);
#pragma unroll
      for (int hh = 0; hh < 8; ++hh) v[hh] = *(const float4*)(pc + (size_t)(k0 + (tid >> 6) + 8 * hh) * ld);
    }
    __syncthreads();
    if (r < 32) {
      const int kt = r >> 1, hq = r & 1;
      unsigned char* dst = q.wgu8 + (size_t)e * 512 * 1024;
      {
        const int kc = tid >> 6;
#pragma unroll
        for (int pp = 0; pp < 4; ++pp) {
          const int n = (tid & 63) + 64 * pp;
          float x[8];
#pragma unroll
          for (int i = 0; i < 8; ++i) x[i] = T[(kc * 8 + i) * 260 + n] * 256.f;
          *(LDSP u32x2*)(Tb + n * 64 + kc * 8) = (u32x2){pk4_fp8(x[0], x[1], x[2], x[3]), pk4_fp8(x[4], x[5], x[6], x[7])};
        }
      }
      __syncthreads();
      {
        const int ch = tid & 3;
#pragma unroll
        for (int pp = 0; pp < 2; ++pp) {
          const int n = (tid >> 2) + 128 * pp;
          const u32x4 w = *(LDSP const u32x4*)(Tb + n * 64 + ch * 16);
          *(u32x4*)(dst + (size_t)(hq * 256 + n) * 1024 + kt * 64 + ch * 16) = w;
        }
      }
    } else {
      const int r2 = r - 32, kt = r2 >> 2, nq = r2 & 3;
      unsigned char* dst = q.wd8 + (size_t)e * 1024 * 256;
      {
        const int kc = tid >> 6;
#pragma unroll
        for (int pp = 0; pp < 4; ++pp) {
          const int n = (tid & 63) + 64 * pp;
          float x[8];
#pragma unroll
          for (int i = 0; i < 8; ++i) x[i] = T[(kc * 8 + i) * 260 + n] * 256.f;
          *(LDSP u32x2*)(Tb + n * 64 + kc * 8) = (u32x2){pk4_fp8(x[0], x[1], x[2], x[3]), pk4_fp8(x[4], x[5], x[6], x[7])};
        }
      }
      __syncthreads();
      {
        const int ch = tid & 3;
#pragma unroll
        for (int pp = 0; pp < 2; ++pp) {
          const int n = (tid >> 2) + 128 * pp;
          const u32x4 w = *(LDSP const u32x4*)(Tb + n * 64 + ch * 16);
          *(u32x4*)(dst + (size_t)(nq * 256 + n) * 256 + kt * 64 + ch * 16) = w;
        }
      }
    }
    __syncthreads();
  }
}

struct ExpItem { int e, base, nrows; };
template <bool SHARED>
__device__ __forceinline__ void exp_desc(CQ& q, const ExpItem& u, int sub, int tid, RunDesc& d) {
  const int crow = tid >> 3, cch = tid & 7;
  const unsigned sc16 = (unsigned)((cch ^ ((crow >> 1) & 7)) << 4);
  if (sub < 2) {
    d.rbase = (const char*)(q.wgu8 + ((size_t)u.e * 512 + sub * 256) * 1024); d.rstride = 64u * 1024u;
    d.rlo = (unsigned)crow * 1024u + sc16;
    d.cbase = (const char*)q.h2f8;
    unsigned lo[2];
#pragma unroll
    for (int i = 0; i < 2; ++i) {
      const int row = crow + 64 * i;
      int tokr;
      if (SHARED) tokr = u.base + row;
      else { const int rr = row < u.nrows ? row : 0; tokr = q.list[(size_t)u.e * LCAP + u.base + rr] >> 3; }
      lo[i] = (unsigned)tokr * 1024u + sc16;
    }
    d.clo0 = lo[0]; d.clo1 = lo[1];
    d.nk = 8; d.sc1 = false; d.fp8 = true; d.bscale = 0x7B7B7B7B;
  } else {
    d.rbase = (const char*)(q.wd8 + ((size_t)u.e * 1024 + (sub - 2) * 256) * 256); d.rstride = 64u * 256u;
    d.rlo = (unsigned)crow * 256u + sc16;
    d.cbase = (const char*)(q.actg + (size_t)blockIdx.x * 128 * 256);
    d.clo0 = (unsigned)crow * 256u + sc16; d.clo1 = d.clo0 + 64u * 256u;
    d.nk = 2; d.sc1 = true; d.fp8 = true; d.bscale = 0x7D7D7D7D;
  }
}

template <bool SHARED, class GetItem>
__device__ __forceinline__ void expert_phase(CQ& q, LDSP char* lds, int tid, const GetItem& get_item) {
  CP& p = q.p;
  const int lane = tid & 63, wid = tid >> 6, l31 = lane & 31, hh = lane >> 5;
  const int wr = wid / 2, wc = wid % 2;
  const int crow = tid >> 3;
  ExpItem cur, nxt;
  int r = 0;
  if (!get_item(0, cur)) return;
  int st = 0, pre = 0;
  const int erow = lane >> 3, ech = lane & 7;
  for (;;) {
    const bool has_next = get_item(r + 1, nxt);
    int ent_l = -1; float w_l = 0.f;
    if (!SHARED) {
      const int rowl = wc * 64 + lane;
      if (rowl < cur.nrows) { ent_l = q.list[(size_t)cur.e * LCAP + cur.base + rowl]; w_l = p.selw[ent_l]; }
    }

#pragma unroll 1
    for (int sub = 0; sub < 6; ++sub) {
      RunDesc d;
      exp_desc<SHARED>(q, cur, sub, tid, d);
      f32x16 acc[2][2];
#pragma unroll
      for (int a = 0; a < 2; ++a)
#pragma unroll
        for (int b2 = 0; b2 < 2; ++b2)
#pragma unroll
          for (int rr = 0; rr < 16; ++rr) acc[a][b2][rr] = 0.f;
      auto next = [&](RunDesc& dn) -> bool {
        if (sub == 1) return false;
        if (sub < 5) { exp_desc<SHARED>(q, cur, sub + 1, tid, dn); return true; }
        if (has_next) { exp_desc<SHARED>(q, nxt, 0, tid, dn); return true; }
        return false;
      };
      StreamCore::run_stream<true>(acc, d, next, sub == 2, lds, tid, st, pre);
      LDSP char* wl = StreamCore::free_stage(lds, st) + wid * 6144;
      if (sub < 2) {
        const int hb = sub * 4 + wr;
#pragma unroll
        for (int ci = 0; ci < 2; ++ci) {
          const int row = ci * 32 + l31;
#pragma unroll
          for (int g = 0; g < 4; ++g) {
            float a4[4];
#pragma unroll
            for (int j = 0; j < 4; ++j) { const float gt = acc[0][ci][4 * g + j], up = acc[1][ci][4 * g + j]; a4[j] = silu_fast(gt) * up * 4.f; }
            *(LDSP unsigned*)(wl + row * 32 + ((((g >> 1) ^ (row >> 1)) & 1) << 4) + (g & 1) * 8 + 4 * hh) = pk4_fp8(a4[0], a4[1], a4[2], a4[3]);
          }
        }
        const int srow = lane >> 1, sch = lane & 1;
#pragma unroll
        for (int i = 0; i < 2; ++i) {
          const int row = srow + 32 * i;
          const u32x4 v = *(LDSP const u32x4*)(wl + row * 32 + (((sch ^ (row >> 1)) & 1) << 4));
          *(u32x4*)(q.actg + ((size_t)blockIdx.x * 128 + wc * 64 + row) * 256 + hb * 32 + sch * 16) = v;
        }
      } else {
        const int np = sub - 2;
        float wlw[2] = {1.f, 1.f};
        if (!SHARED) { wlw[0] = __shfl(w_l, l31); wlw[1] = __shfl(w_l, 32 + l31); }

        const int n0 = np * 256 + wr * 64 + ech * 8;
        if (!SHARED) {
#pragma unroll
          for (int ci = 0; ci < 2; ++ci) {
            const int row = ci * 32 + l31; const int sw2 = (row >> 1) & 3;
            const float ws = wlw[ci] * 64.f;
#pragma unroll
            for (int ri = 0; ri < 2; ++ri)
#pragma unroll
              for (int g = 0; g < 4; ++g) {
                const f32x16& a = acc[ri][ci];
                *(LDSP unsigned*)(wl + row * 64 + (((ri * 2 + (g >> 1)) ^ sw2) << 4) + (g & 1) * 8 + 4 * hh) = pk4_fp8(a[4 * g + 0] * ws, a[4 * g + 1] * ws, a[4 * g + 2] * ws, a[4 * g + 3] * ws);
              }
          }
          const int srow = lane >> 2, sch = lane & 3;
          const int nb = np * 256 + wr * 64 + sch * 16;
#pragma unroll
          for (int i = 0; i < 4; ++i) {
            const int row = srow + 16 * i;
            const u32x4 sv = *(LDSP const u32x4*)(wl + row * 64 + ((sch ^ ((row >> 1) & 3)) << 4));
            const int ent = __shfl(ent_l, row);
            if (ent >= 0) *(u32x4*)(q.ybuf + (size_t)ent * 1024 + nb) = sv;
          }
          asm volatile("s_waitcnt lgkmcnt(0)" ::: "memory");
        } else {
#pragma unroll 1
          for (int ci = 0; ci < 2; ++ci) {
            {
              const int row = l31; const int sw2 = (row >> 1) & 7;
#pragma unroll
              for (int ri = 0; ri < 2; ++ri)
#pragma unroll
                for (int g = 0; g < 4; ++g) {
                  const f32x16& a = (ci == 0) ? acc[ri][0] : acc[ri][1];
                  u32x2 w; w.x = pk_bf16(a[4 * g + 0], a[4 * g + 1]); w.y = pk_bf16(a[4 * g + 2], a[4 * g + 3]);
                  *(LDSP u32x2*)(wl + row * 128 + (((ri * 4 + g) ^ sw2) << 4) + 8 * hh) = w;
                }
            }
#pragma unroll 2
            for (int i = 0; i < 4; ++i) {
              const int row = erow + 8 * i;
              const int rowl = wc * 64 + ci * 32 + row;
              const u32x4 sv = *(LDSP const u32x4*)(wl + row * 128 + ((ech ^ ((row >> 1) & 7)) << 4));
              const int tok = cur.base + rowl;
              const int bb = tok / SEQ;
              const float* g2 = p.mod + bb * 6144 + 5120 + n0;
              float* orow = p.out + (size_t)tok * D_MODEL + n0;
              float a8[8] = {bf_lo(sv.x), bf_hi(sv.x), bf_lo(sv.y), bf_hi(sv.y), bf_lo(sv.z), bf_hi(sv.z), bf_lo(sv.w), bf_hi(sv.w)};
              u32x2 yv[8];
#pragma unroll
              for (int k = 0; k < 8; ++k) yv[k] = *(const u32x2*)(q.ybuf + ((size_t)tok * 8 + k) * 1024 + n0);
              const float4 x0 = *(const float4*)(orow), x1 = *(const float4*)(orow + 4);
              const float4 ga = *(const float4*)(g2), gb = *(const float4*)(g2 + 4);
              float r8[8] = {0.f, 0.f, 0.f, 0.f, 0.f, 0.f, 0.f, 0.f};
#pragma unroll
              for (int k = 0; k < 8; ++k) {
                const f32x2v p0 = __builtin_amdgcn_cvt_pk_f32_fp8((int)yv[k].x, false), p1 = __builtin_amdgcn_cvt_pk_f32_fp8((int)yv[k].x, true);
                const f32x2v p2 = __builtin_amdgcn_cvt_pk_f32_fp8((int)yv[k].y, false), p3 = __builtin_amdgcn_cvt_pk_f32_fp8((int)yv[k].y, true);
                r8[0] += p0[0]; r8[1] += p0[1]; r8[2] += p1[0]; r8[3] += p1[1]; r8[4] += p2[0]; r8[5] += p2[1]; r8[6] += p3[0]; r8[7] += p3[1];
              }
#pragma unroll
              for (int j = 0; j < 8; ++j) a8[j] += r8[j] * (1.f / 64.f);
              *(float4*)(orow) = make_float4(x0.x + ga.x * a8[0], x0.y + ga.y * a8[1], x0.z + ga.z * a8[2], x0.w + ga.w * a8[3]);
              *(float4*)(orow + 4) = make_float4(x1.x + gb.x * a8[4], x1.y + gb.y * a8[5], x1.z + gb.z * a8[6], x1.w + gb.w * a8[7]);
            }
            asm volatile("s_waitcnt lgkmcnt(0)" ::: "memory");
          }
        }
      }
    }
    if (!has_next) break;
    cur = nxt; ++r;
  }
  asm volatile("s_waitcnt vmcnt(0) lgkmcnt(0)\n\ts_barrier" ::: "memory");
}

__device__ __forceinline__ void phase9(CQ& q, LDSP char* lds, int tid) {
  CP& p = q.p;
  const int lane = tid & 63;
  const int G = gridDim.x, bid = blockIdx.x;
  const int xcd = bid & 7, lix = bid >> 3, per = G >> 3;
  const int myexp = xcd + 8 * (lane & 31);
  const int cnt = p.counts[myexp * 64];
  const int nt = (cnt + 127) >> 7;
  int incl = nt;
#pragma unroll
  for (int o = 1; o < 32; o <<= 1) { const int v = __shfl_up(incl, o); if ((lane & 31) >= o) incl += v; }
  const int total = __shfl(incl, 31);
  auto get_item = [&](int r, ExpItem& u) -> bool {
    const int it = lix + r * per;
    if (it >= total) return false;
    const unsigned long long bal = __ballot((lane < 32) && (it < incl));
    const int k = __builtin_ctzll(bal);
    u.e = __builtin_amdgcn_readfirstlane(xcd + 8 * k);
    const int inck = __shfl(incl, k), ntk = __shfl(nt, k), cntk = __shfl(cnt, k);
    u.base = __builtin_amdgcn_readfirstlane((it - (inck - ntk)) * 128);
    u.nrows = __builtin_amdgcn_readfirstlane(min(128, cntk - u.base));
    return true;
  };
  expert_phase<false>(q, lds, tid, get_item);
}
__device__ __forceinline__ void phase10(CQ& q, LDSP char* lds, int tid) {
  const int G = gridDim.x, bid = blockIdx.x;
  auto get_item = [&](int r, ExpItem& u) -> bool {
    const int it = bid + r * G;
    if (it >= NTOK / 128) return false;
    u.e = 256; u.base = it * 128; u.nrows = 128;
    return true;
  };
  expert_phase<true>(q, lds, tid, get_item);
}

__device__ __forceinline__ void phase4(CQ& q, char* shm) {
  const int G = gridDim.x, bx = blockIdx.x;
  const int lix = bx >> 3;
  const int tid = threadIdx.x;
  if (lix & 1) phase0_experts(q, (LDSP char*)shm, tid, (bx & 7) * (G >> 4) + (lix >> 1), G >> 1);
  volatile LDSP int* sit = (volatile LDSP int*)((LDSP char*)shm + LDS_BYTES - 8);
  const int NU = BATCH * 8 * 8;
  int nxt = 0;
  if (tid == 0) nxt = atomicAdd(q.ictr + 16, 1);
  for (;;) {
    if (tid == 0) *sit = nxt;
    __syncthreads();
    const int u = *sit;
    __syncthreads();
    if (u >= NU) break;
    if (tid == 0) nxt = atomicAdd(q.ictr + 16, 1);
    const int qb = 7 - (u >> 7), bh = u & 127;
    att::attn_unit<8>(bh >> 3, bh & 7, qb, q.proj2, q.p.mask, q.p.attn_out_norm_w, q.mixer, shm);
  }
}

#define XB_TMO      128
#define XB_XCNT(j)  (256  + 64 * (j))
#define XB_XSUB(j)  (1280 + 64 * (j))
#define XB_XGEN(j)  (2304 + 64 * (j))
#define XB_TOP      3328
#define XB_TOPGEN   3392
#define XCD_BAR_WORDS 3456
#define XB_SPIN_CAP (1u << 22)
__device__ __forceinline__ unsigned xb_ld(unsigned* p)              { return __hip_atomic_load(p, __ATOMIC_RELAXED, __HIP_MEMORY_SCOPE_AGENT); }
__device__ __forceinline__ unsigned xb_add(unsigned* p, unsigned v) { return __hip_atomic_fetch_add(p, v, __ATOMIC_RELAXED, __HIP_MEMORY_SCOPE_AGENT); }
__device__ __forceinline__ unsigned xb_xcc_id() { return (unsigned)__builtin_amdgcn_s_getreg((3 << 11) | 20) & 0xFu; }
#define XB_SPIN(cond, bar) do { unsigned _sp = 0; while (cond) { __builtin_amdgcn_s_sleep(1); \
    if ((++_sp & 255u) == 0u) { if (xb_ld(&(bar)[XB_TMO])) break; if (_sp > XB_SPIN_CAP) { atomicAdd(&(bar)[XB_TMO], 1u); break; } } } } while (0)
struct XcdBarrier { unsigned* bar; unsigned x; volatile LDSP unsigned* st; };
__device__ __forceinline__ XcdBarrier xcd_barrier_post(unsigned* bar, volatile LDSP unsigned* st) {
  XcdBarrier b; b.bar = bar; b.x = xb_xcc_id(); b.st = st;
  if (threadIdx.x == 0) (void)xb_add(&bar[XB_XCNT(b.x)], 1u);
  return b;
}
__device__ __forceinline__ void xcd_barrier_complete(unsigned* bar, unsigned x, unsigned& nloc, unsigned& nx) {
  const unsigned G = gridDim.x * gridDim.y * gridDim.z;
  unsigned sum, cnt, mine, sp = 0u;
  for (;;) {
    sum = 0u; cnt = 0u; mine = 0u;
#pragma unroll
    for (unsigned j = 0; j < 16; ++j) { const unsigned c = xb_ld(&bar[XB_XCNT(j)]); sum += c; cnt += (c > 0u) ? 1u : 0u; mine = (j == x) ? c : mine; }
    if (sum == G) break;
    __builtin_amdgcn_s_sleep(1);
    if ((++sp & 255u) == 0u) { if (xb_ld(&bar[XB_TMO])) break; if (sp > XB_SPIN_CAP) { atomicAdd(&bar[XB_TMO], 1u); break; } }
  }
  nloc = mine > 0u ? mine : 1u; nx = cnt > 0u ? cnt : 1u;
}
__device__ __forceinline__ void xcd_barrier(const XcdBarrier& b) {
  asm volatile("s_waitcnt vmcnt(0)" ::: "memory");
  __syncthreads();
  if (threadIdx.x == 0) {
    unsigned* bar = b.bar;
    __builtin_amdgcn_s_waitcnt(0);
    unsigned nloc = b.st[0], nx = b.st[1];
    if (nloc == 0u) { xcd_barrier_complete(bar, b.x, nloc, nx); b.st[0] = nloc; b.st[1] = nx; }
    const unsigned old = xb_add(&bar[XB_XSUB(b.x)], 1u);
    const unsigned gen = old / nloc;
    if (old + 1u == (gen + 1u) * nloc) {
      __builtin_amdgcn_fence(__ATOMIC_RELEASE, "agent");
      asm volatile("s_waitcnt vmcnt(0)" ::: "memory");
      const unsigned og = xb_add(&bar[XB_TOP], 1u);
      const unsigned tg = og / nx;
      if (og + 1u == (tg + 1u) * nx) xb_add(&bar[XB_TOPGEN], 1u);
      else XB_SPIN(xb_ld(&bar[XB_TOPGEN]) == tg, bar);
      __builtin_amdgcn_fence(__ATOMIC_ACQUIRE, "agent");
      xb_add(&bar[XB_XGEN(b.x)], 1u);
      asm volatile("s_waitcnt vmcnt(0)" ::: "memory");
    } else {
      XB_SPIN(xb_ld(&bar[XB_XGEN(b.x)]) == gen, bar);
      __builtin_amdgcn_fence(__ATOMIC_ACQUIRE, "agent");
      asm volatile("s_waitcnt vmcnt(0)" ::: "memory");
    }
  }
  __syncthreads();
}

__global__ void __launch_bounds__(NTHR, 2) mk(Q qarg) {
  extern __shared__ __attribute__((aligned(16))) char smem[];
  LDSP char* lds = (LDSP char*)smem;
  const int tid = threadIdx.x;
  CQ* qp0 = (CQ*)__builtin_amdgcn_kernarg_segment_ptr();
  const int ph_lo = qp0->ph_lo, ph_hi = qp0->ph_hi;
  const bool multi = (ph_hi - ph_lo) > 1;
  volatile LDSP unsigned* bst = (volatile LDSP unsigned*)(lds + LDS_BYTES - 16);
  XcdBarrier bar; bar.bar = qp0->barw; bar.x = 0; bar.st = bst;
  if (multi) {
    if (tid < 4) bst[tid] = 0u;
    __syncthreads();
    bar = xcd_barrier_post(qp0->barw, bst);
  }
#define QPH(name) CQ* name = qp0; asm volatile("" : "+s"(name));
#define IN(k) (ph_lo <= (k) && (k) < ph_hi)
#define GB(k) do { if (multi && IN(k) && IN((k) + 1)) xcd_barrier(bar); } while (0)
  if (IN(0)) { QPH(qa) phase0(*qa, lds, tid); }
  GB(0);
  if (IN(1)) { QPH(qa) phase1(*qa, tid); }
  GB(1);
  if (IN(2)) { QPH(qa) phase2(*qa, lds, tid); }
  GB(2);
  if (IN(3)) { QPH(qa) phase3b(*qa, lds, tid); QPH(qb) phase3(*qb, lds, tid); }
  GB(3);
  if (IN(4)) { QPH(qa) phase4(*qa, smem); }
  GB(4);
  if (IN(5)) { QPH(qa) phase6(*qa, lds, tid); }
  GB(5);
  if (IN(6)) { QPH(qa) phase8(*qa, lds, tid); }
  GB(6);
  if (IN(7)) { QPH(qa) phase9(*qa, lds, tid); }
  GB(7);
  if (IN(8)) { QPH(qa) phase10(*qa, lds, tid); }
}


extern "C" void kernel_launch(void* const* d_in, const int* in_sizes, int n_in, void* d_out, int out_size,
                              void* d_ws, size_t ws_size, hipStream_t stream) {
  P p{};
  p.x = (const float*)d_in[0]; p.c = (const float*)d_in[1]; p.pos = (const int*)d_in[2];
  p.norm1_w = (const float*)d_in[3]; p.norm2_w = (const float*)d_in[4];
  p.w_ada = (const float*)d_in[5]; p.b_ada = (const float*)d_in[6]; p.w_in = (const float*)d_in[7];
  p.q_norm_w = (const float*)d_in[8]; p.k_norm_w = (const float*)d_in[9]; p.attn_out_norm_w = (const float*)d_in[10];
  p.w_gk2 = (const float*)d_in[11]; p.b_gk = (const float*)d_in[12]; p.gla_norm_w = (const float*)d_in[13];
  p.w_out = (const float*)d_in[14]; p.w_router = (const float*)d_in[15]; p.b_router = (const float*)d_in[16];
  p.we_gate = (const float*)d_in[17]; p.we_up = (const float*)d_in[18]; p.we_down = (const float*)d_in[19];
  p.ws_gate = (const float*)d_in[20]; p.ws_up = (const float*)d_in[21]; p.ws_down = (const float*)d_in[22];
  p.out = (float*)d_out;
  char* ws = (char*)d_ws;
  size_t off = 0;
  auto take = [&](size_t bytes) { char* r = ws + off; off += (bytes + 255) & ~(size_t)255; return r; };
  char* ctl = take(131072);
  p.counts = (int*)ctl;
  p.mod = (float*)take((size_t)16 * 6144 * 4);
  Q q{};
  q.barw = (unsigned*)(ctl + 65536 + 4096);
  q.ictr = (int*)(ctl + 65536 + 2048);
  q.wt_in = (bf16_t*)take((size_t)NP * 1024 * 2);
  q.wt_out = (bf16_t*)take((size_t)1024 * 1024 * 2);
  q.rope = (float*)take((size_t)NTOK * 16 * 4);
  q.misc = (float*)take((size_t)NTOK * 32 * 4);
  { const size_t have = (size_t)((char*)q.misc - (char*)q.wt_in) + (size_t)NTOK * 32 * 4; const size_t need = (size_t)256 * 128 * 256 * 2; if (need > have) (void)take(need - have); }
  q.actg = (unsigned char*)q.wt_in;
  q.wt_router = (bf16_t*)take((size_t)256 * 1024 * 2);
  p.selw = (float*)take((size_t)NASSIGN * 4);
  q.list = (int*)take((size_t)256 * LCAP * 4);
  q.wgu8 = (unsigned char*)take((size_t)257 * 512 * 1024);
  q.h2f8 = (unsigned char*)take((size_t)NTOK * 1024);
  q.wd8 = (unsigned char*)take((size_t)257 * 1024 * 256);
  q.h1 = (bf16_t*)take((size_t)NTOK * 1024 * 2);
  q.h2 = q.h1;
  char* big = take((size_t)NASSIGN * 1024 * 2);
  q.ybuf = (unsigned char*)big;
  q.proj2 = (bf16_t*)big;
  p.mask = (unsigned*)(big + (size_t)NTOK * NP * 2);
  q.mixer = (bf16_t*)(big + (size_t)NTOK * NP * 2 + (size_t)NTOK * 64 * 4);
  if (off > ws_size) { fprintf(stderr, "workspace too small: need %zu have %zu\n", off, ws_size); return; }
  q.p = p;
  static bool attr_set = false;
  if (!attr_set) { (void)hipFuncSetAttribute((const void*)mk, hipFuncAttributeMaxDynamicSharedMemorySize, LDS_BYTES); attr_set = true; }
  (void)hipMemsetAsync(ctl, 0, 131072, stream);
  static int n_cu = 0;
  if (!n_cu) { int dev = 0; (void)hipGetDevice(&dev); (void)hipDeviceGetAttribute(&n_cu, hipDeviceAttributeMultiprocessorCount, dev); if (n_cu <= 0) n_cu = 1; }
  if (n_cu >= 256) {
    q.ph_lo = 0; q.ph_hi = 9;
    mk<<<256, NTHR, LDS_BYTES, stream>>>(q);
  } else {
    for (int ph = 0; ph < 9; ++ph) { q.ph_lo = ph; q.ph_hi = ph + 1; mk<<<256, NTHR, LDS_BYTES, stream>>>(q); }
  }
}
```

```cpp
#include <hip/hip_runtime.h>
#include <hip/hip_bf16.h>
#include <cstdio>
#include <cstdint>

#define D_MODEL 1024
#define BATCH 16
#define SEQ 2048
#define NTOK (BATCH * SEQ)
#define IN_WIDTH 2644
#define NEXP 256
#define EDIM 256
#define TOPK 8
#define NASSIGN (NTOK * TOPK)

#define C_QA 0
#define C_KA 512
#define C_VA 640
#define C_QI 768
#define C_KI 1024
#define C_WI 1088
#define C_QG 1092
#define C_KG 1348
#define C_VG 1604
#define C_GK 2116
#define C_GO 2132

struct P {
  const float* x; const float* c; const int* pos; const float* norm1_w; const float* norm2_w;
  const float* w_ada; const float* b_ada; const float* w_in; const float* q_norm_w; const float* k_norm_w;
  const float* attn_out_norm_w; const float* w_gk2; const float* b_gk; const float* gla_norm_w;
  const float* w_out; const float* w_router; const float* b_router;
  const float* we_gate; const float* we_up; const float* we_down;
  const float* ws_gate; const float* ws_up; const float* ws_down;
  float* out;
  float* mod;
  float* bufA;
  float* proj;
  float* h2;
  float* act_s;
  float* rscore;
  float* qa; float* ka; float* qi; float* ki; float* wi; float* log_a;
  float* scores;
  float* act;
  unsigned* mask;
  int* sel; float* selw; int* counts; int* offsets; int* cursor; int* list;
};

__device__ __forceinline__ float silu_f(float v) { return v / (1.f + expf(-v)); }
__device__ __forceinline__ float wave_sum(float v) {
#pragma unroll
  for (int o = 32; o > 0; o >>= 1) v += __shfl_xor(v, o);
  return v;
}
__device__ __forceinline__ float wave_max(float v) {
#pragma unroll
  for (int o = 32; o > 0; o >>= 1) v = fmaxf(v, __shfl_xor(v, o));
  return v;
}

typedef unsigned short bf16_t;
typedef short bf16x8 __attribute__((ext_vector_type(8)));
typedef float f32x16 __attribute__((ext_vector_type(16)));
typedef float f32x4v __attribute__((ext_vector_type(4)));
typedef float f32x2v __attribute__((ext_vector_type(2)));
typedef __bf16 bf16x2v __attribute__((ext_vector_type(2)));
typedef unsigned u32x4 __attribute__((ext_vector_type(4)));
typedef unsigned u32x2 __attribute__((ext_vector_type(2)));
#define LDSP __attribute__((address_space(3)))
#define NTHR 512
#define LCAP 32768
#define LDS_BYTES 163840
#define ATT_C2 (0.125f * 1.4426950408889634f)

#define D_QA 0
#define D_KA 512
#define D_VA 640
#define D_QI 768
#define D_KI 1024
#define D_MISC 1088
#define D_QG 1152
#define D_KG 1408
#define D_VG 1664
#define D_GO 2176
#define NP 2688

__device__ __forceinline__ unsigned pk_bf16(float lo, float hi) { f32x2v v = {lo, hi}; bf16x2v b = __builtin_convertvector(v, bf16x2v); return __builtin_bit_cast(unsigned, b); }
typedef int v8i_t __attribute__((ext_vector_type(8)));
typedef int v4i_t __attribute__((ext_vector_type(4)));
__device__ __forceinline__ unsigned pk4_fp8(float a, float b, float c, float d) {
  a = __builtin_amdgcn_fmed3f(a, -448.f, 448.f); b = __builtin_amdgcn_fmed3f(b, -448.f, 448.f);
  c = __builtin_amdgcn_fmed3f(c, -448.f, 448.f); d = __builtin_amdgcn_fmed3f(d, -448.f, 448.f);
  int w = __builtin_amdgcn_cvt_pk_fp8_f32(a, b, 0, false);
  w = __builtin_amdgcn_cvt_pk_fp8_f32(c, d, w, true);
  return (unsigned)w;
}
__device__ __forceinline__ float bf_lo(unsigned w) { return __uint_as_float(w << 16); }
__device__ __forceinline__ float bf_hi(unsigned w) { return __uint_as_float(w & 0xffff0000u); }

struct Q;
struct Q {
  P p;
  bf16_t* wt_in;
  bf16_t* wt_out;
  bf16_t* wt_router;
  bf16_t* h1;
  float* rope;
  bf16_t* proj2;
  float* misc;
  bf16_t* mixer;
  bf16_t* h2;
  unsigned char* wgu8;
  unsigned char* h2f8;
  unsigned char* wd8;
  unsigned char* ybuf;
  int* list;
  unsigned char* actg;
  unsigned* barw;
  int* ictr;
  int ph_lo, ph_hi;
};
typedef const __attribute__((address_space(4))) Q CQ;
typedef const __attribute__((address_space(4))) P CP;


__device__ __forceinline__ int win_src(int n) {
  if (n < D_MISC) return n;
  if (n < D_MISC + 4) return C_WI + (n - D_MISC);
  if (n < D_MISC + 20) return C_GK + (n - D_MISC - 4);
  if (n < D_QG) return -1;
  if (n < D_VG + 512) return C_QG + (n - D_QG);
  return C_GO + (n - D_GO);
}

template <class F>
__device__ __forceinline__ void conv_tile(const F& f, int k0, bf16_t* dst, int ldd, int nd0, LDSP float* T, int tid) {
  {
    const int j4 = (tid & 15) * 4;
    int ld; const float* pcol = f(j4, ld);
#pragma unroll
    for (int hh = 0; hh < 2; ++hh) {
      const int kr = (tid >> 4) + hh * 32;
      float4 v = make_float4(0.f, 0.f, 0.f, 0.f);
      if (pcol) v = *(const float4*)(pcol + (size_t)(k0 + kr) * ld);
      T[kr * 65 + j4 + 0] = v.x; T[kr * 65 + j4 + 1] = v.y; T[kr * 65 + j4 + 2] = v.z; T[kr * 65 + j4 + 3] = v.w;
    }
  }
  __syncthreads();
  {
    const int n = tid >> 3, kc = tid & 7;
    float v[8];
#pragma unroll
    for (int i = 0; i < 8; ++i) v[i] = T[(kc * 8 + i) * 65 + n];
    u32x4 w; w.x = pk_bf16(v[0], v[1]); w.y = pk_bf16(v[2], v[3]); w.z = pk_bf16(v[4], v[5]); w.w = pk_bf16(v[6], v[7]);
    *(u32x4*)(dst + (size_t)(nd0 + n) * ldd + k0 + kc * 8) = w;
  }
  __syncthreads();
}

struct SrcWin { const float* w; __device__ __forceinline__ const float* operator()(int j4, int& ld) const { ld = IN_WIDTH; return nullptr; } };

__device__ __forceinline__ void phase0(CQ& q, LDSP char* lds, int tid) {
  CP& p = q.p;
  const int G = gridDim.x, bid = blockIdx.x;
  for (int item = bid; item < 96; item += G) {
    LDSP float* cond = (LDSP float*)lds;
    LDSP float* red = (LDSP float*)(lds + 65536);
    for (int i = tid; i < 16 * 1024; i += NTHR) { const int b = i >> 10, k = i & 1023; cond[k * 16 + b] = silu_f(p.c[i]); }
    __syncthreads();
    const int kg = tid >> 6, cl = tid & 63, col = item * 64 + cl;
    float acc[16];
#pragma unroll
    for (int b = 0; b < 16; ++b) acc[b] = 0.f;
    for (int k = kg * 128; k < kg * 128 + 128; ++k) {
      const float w = p.w_ada[(size_t)k * 6144 + col];
#pragma unroll
      for (int b4 = 0; b4 < 4; ++b4) {
        const f32x4v cv = *(LDSP const f32x4v*)(cond + k * 16 + b4 * 4);
        acc[b4 * 4 + 0] += cv[0] * w; acc[b4 * 4 + 1] += cv[1] * w; acc[b4 * 4 + 2] += cv[2] * w; acc[b4 * 4 + 3] += cv[3] * w;
      }
    }
#pragma unroll
    for (int b = 0; b < 16; ++b) red[(kg * 16 + b) * 64 + cl] = acc[b];
    __syncthreads();
    for (int o = tid; o < 1024; o += NTHR) {
      const int b = o >> 6, c2 = o & 63;
      float s = 0.f;
#pragma unroll
      for (int g = 0; g < 8; ++g) s += red[(g * 16 + b) * 64 + c2];
      p.mod[b * 6144 + item * 64 + c2] = s + p.b_ada[item * 64 + c2];
    }
    __syncthreads();
  }
  LDSP float* T = (LDSP float*)lds;
  const int n_in = 16 * 42, n_out = 16 * 16, n_rt = 16 * 4;
  const int total = n_in + n_out + n_rt;
  for (int it = (bid + G - 96 % G) % G; it < total; it += G) {
    if (it < n_in) {
      const int kt = it / 42, nt = it % 42;
      const float* w = p.w_in;
      auto f = [w, nt](int j4, int& ld) -> const float* { ld = IN_WIDTH; const int s = win_src(nt * 64 + j4); return s < 0 ? nullptr : w + s; };
      conv_tile(f, kt * 64, q.wt_in, 1024, nt * 64, T, tid);
    } else if (it < n_in + n_out) {
      const int i2 = it - n_in; const int kt = i2 / 16, nt = i2 % 16;
      const float* w = p.w_out;
      auto f = [w, nt](int j4, int& ld) -> const float* { ld = 1024; return w + nt * 64 + j4; };
      conv_tile(f, kt * 64, q.wt_out, 1024, nt * 64, T, tid);
    } else {
      const int i2 = it - n_in - n_out; const int kt = i2 / 4, nt = i2 % 4;
      const float* w = p.w_router;
      auto f = [w, nt](int j4, int& ld) -> const float* { ld = 256; return w + nt * 64 + j4; };
      conv_tile(f, kt * 64, q.wt_router, 1024, nt * 64, T, tid);
    }
  }
}

__device__ __forceinline__ void phase1(CQ& q, int tid) {
  CP& p = q.p;
  const int lane = tid & 63, wv = tid >> 6;
  const int nwv = gridDim.x * 8;
  for (int t0 = (blockIdx.x * 8 + wv) * 2; t0 < NTOK; t0 += nwv * 2) {
    float4 v[2][4];
#pragma unroll
    for (int u = 0; u < 2; ++u)
#pragma unroll
      for (int i = 0; i < 4; ++i) v[u][i] = *(const float4*)(p.x + (size_t)(t0 + u) * D_MODEL + i * 256 + lane * 4);
#pragma unroll
    for (int u = 0; u < 2; ++u) {
      const int t = t0 + u;
      const int b = t / SEQ;
      float ss = 0.f;
#pragma unroll
      for (int i = 0; i < 4; ++i) ss += v[u][i].x * v[u][i].x + v[u][i].y * v[u][i].y + v[u][i].z * v[u][i].z + v[u][i].w * v[u][i].w;
      ss = wave_sum(ss);
      const float r = rsqrtf(ss / D_MODEL + 1e-6f);
      const float* md = p.mod + b * 6144;
#pragma unroll
      for (int i = 0; i < 4; ++i) {
        const int d = i * 256 + lane * 4;
        const float4 w = *(const float4*)(p.norm1_w + d);
        const float4 sh = *(const float4*)(md + 0 + d);
        const float4 sc = *(const float4*)(md + 1024 + d);
        u32x2 w2; w2.x = pk_bf16(v[u][i].x * r * w.x * (1.f + sc.x) + sh.x, v[u][i].y * r * w.y * (1.f + sc.y) + sh.y);
        w2.y = pk_bf16(v[u][i].z * r * w.z * (1.f + sc.z) + sh.z, v[u][i].w * r * w.w * (1.f + sc.w) + sh.w);
        *(u32x2*)(q.h1 + (size_t)t * D_MODEL + d) = w2;
      }
      if (lane < 8) {
        const float inv_freq = powf(500000.0f, -(float)lane / 8.0f);
        const float ang = (float)p.pos[t] * inv_freq;
        q.rope[(size_t)t * 16 + lane] = cosf(ang);
        q.rope[(size_t)t * 16 + 8 + lane] = sinf(ang);
      }
    }
  }
}

template <int WR, int WC>
struct GemmCore {
  static constexpr int BR = 64 * WR, BC = 64 * WC;
  static constexpr int STAGE = (BR + BC) * 128;
  static __device__ __forceinline__ void run(f32x16 (&acc)[2][2], const bf16_t* const (&rp)[WR], const bf16_t* const (&cp)[WC],
                                             int K, LDSP char* lds, int tid) {
    static_assert(WR * WC == 8, "8 waves");
    const int lane = tid & 63, wid = tid >> 6;
    const int wr = wid / WC, wc = wid % WC;
    const int crow = tid >> 3, cch = tid & 7;
    const int l31 = lane & 31, h = lane >> 5, sw = (lane >> 1) & 7;
    int wo_r[WR], wo_c[WC];
#pragma unroll
    for (int i = 0; i < WR; ++i) { const int row = crow + 64 * i; wo_r[i] = row * 128 + ((cch ^ ((row >> 1) & 7)) << 4); }
#pragma unroll
    for (int i = 0; i < WC; ++i) { const int row = crow + 64 * i; wo_c[i] = BR * 128 + row * 128 + ((cch ^ ((row >> 1) & 7)) << 4); }
    const int fr_base = (wr * 64 + l31) * 128;
    const int fc_base = BR * 128 + (wc * 64 + l31) * 128;
    u32x4 rreg[WR], creg[WC];
#pragma unroll
    for (int i = 0; i < WR; ++i) rreg[i] = *(const u32x4*)(rp[i]);
#pragma unroll
    for (int i = 0; i < WC; ++i) creg[i] = *(const u32x4*)(cp[i]);
    __syncthreads();
#pragma unroll
    for (int i = 0; i < WR; ++i) *(LDSP u32x4*)(lds + wo_r[i]) = rreg[i];
#pragma unroll
    for (int i = 0; i < WC; ++i) *(LDSP u32x4*)(lds + wo_c[i]) = creg[i];
    __syncthreads();
    const int nk = K >> 6;
    for (int kt = 0; kt < nk; ++kt) {
      const int cur = kt & 1;
      if (kt + 1 < nk) {
#pragma unroll
        for (int i = 0; i < WR; ++i) rreg[i] = *(const u32x4*)(rp[i] + (kt + 1) * 64);
#pragma unroll
        for (int i = 0; i < WC; ++i) creg[i] = *(const u32x4*)(cp[i] + (kt + 1) * 64);
      }
      LDSP char* st = lds + cur * STAGE;
#pragma unroll
      for (int kk = 0; kk < 4; ++kk) {
        const int co = (((kk * 2 + h) ^ sw) << 4);
        bf16x8 fr[2], fc[2];
#pragma unroll
        for (int ri = 0; ri < 2; ++ri) fr[ri] = *(LDSP const bf16x8*)(st + fr_base + ri * 4096 + co);
#pragma unroll
        for (int ci = 0; ci < 2; ++ci) fc[ci] = *(LDSP const bf16x8*)(st + fc_base + ci * 4096 + co);
#pragma unroll
        for (int ri = 0; ri < 2; ++ri)
#pragma unroll
          for (int ci = 0; ci < 2; ++ci) acc[ri][ci] = __builtin_amdgcn_mfma_f32_32x32x16_bf16(fr[ri], fc[ci], acc[ri][ci], 0, 0, 0);
      }
      if (kt + 1 < nk) {
        LDSP char* sn = lds + (cur ^ 1) * STAGE;
#pragma unroll
        for (int i = 0; i < WR; ++i) *(LDSP u32x4*)(sn + wo_r[i]) = rreg[i];
#pragma unroll
        for (int i = 0; i < WC; ++i) *(LDSP u32x4*)(sn + wo_c[i]) = creg[i];
      }
      __syncthreads();
    }
  }
};


__device__ __forceinline__ void glds16g(const void* gsrc, unsigned lds_dst) { unsigned keep;
  asm volatile("s_mov_b32 %0, m0\n\ts_mov_b32 m0, %2\n\ts_nop 0\n\tglobal_load_lds_dwordx4 %1, off\n\ts_mov_b32 m0, %0" : "=&s"(keep) : "v"(gsrc), "s"(lds_dst) : "memory"); }
__device__ __forceinline__ void glds16g_sc1(const void* gsrc, unsigned lds_dst) { unsigned keep;
  asm volatile("s_mov_b32 %0, m0\n\ts_mov_b32 m0, %2\n\ts_nop 0\n\tglobal_load_lds_dwordx4 %1, off sc1\n\ts_mov_b32 m0, %0" : "=&s"(keep) : "v"(gsrc), "s"(lds_dst) : "memory"); }
#define VMW(N) asm volatile("s_waitcnt vmcnt(" #N ")" ::: "memory")
template <int WR, int WC, int NST, bool CSC1 = false>
struct GemmCoreD {
  static constexpr int BR = 64 * WR, BC = 64 * WC;
  static constexpr int STAGE = (BR + BC) * 128;
  static __device__ __forceinline__ void prefetch0(const bf16_t* const (&rrow)[WR], const bf16_t* const (&crw)[WC], LDSP char* lds, int tid) {
    const int wid = __builtin_amdgcn_readfirstlane(tid >> 6);
    const int crow = tid >> 3, cch = tid & 7;
    const int sc8 = (cch ^ ((crow >> 1) & 7)) << 3;
    const unsigned l0 = (unsigned)(uintptr_t)lds + (unsigned)wid * 1024u;
#pragma unroll
    for (int i = 0; i < WR; ++i) glds16g(rrow[i] + sc8, (unsigned)__builtin_amdgcn_readfirstlane(l0 + (unsigned)(i * 8192)));
#pragma unroll
    for (int i = 0; i < WC; ++i) { if (CSC1) glds16g_sc1(crw[i] + sc8, (unsigned)__builtin_amdgcn_readfirstlane(l0 + (unsigned)(BR * 128 + i * 8192))); else glds16g(crw[i] + sc8, (unsigned)__builtin_amdgcn_readfirstlane(l0 + (unsigned)(BR * 128 + i * 8192))); }
  }
  static __device__ __forceinline__ void run(f32x16 (&acc)[2][2], const bf16_t* const (&rrow)[WR], const bf16_t* const (&crw)[WC],
                                             int K, LDSP char* lds, int tid, bool pre = false) {
    static_assert(WR * WC == 8 && WR + WC == 6 && NST == 3, "8 waves, 6 DMA pieces per wave and tile, 3-stage ring");
    const int lane = tid & 63; const int wid = __builtin_amdgcn_readfirstlane(tid >> 6);
    const int wr = wid / WC, wc = wid % WC;
    const int crow = tid >> 3, cch = tid & 7;
    const int l31 = lane & 31, h = lane >> 5, sw = (lane >> 1) & 7;
    const int sc8 = (cch ^ ((crow >> 1) & 7)) << 3;
    const bf16_t* rs[WR]; const bf16_t* cs[WC];
#pragma unroll
    for (int i = 0; i < WR; ++i) rs[i] = rrow[i] + sc8;
#pragma unroll
    for (int i = 0; i < WC; ++i) cs[i] = crw[i] + sc8;
    const unsigned l0 = (unsigned)(uintptr_t)lds + (unsigned)wid * 1024u;
    const int fr_base = (wr * 64 + l31) * 128;
    const int fc_base = BR * 128 + (wc * 64 + l31) * 128;
    const int nk = K >> 6;
    const bool grp1 = wid >= 4;
#define GD_ISSUE(t, st) do { \
      _Pragma("unroll") for (int i = 0; i < WR; ++i) glds16g(rs[i] + (t) * 64, (unsigned)__builtin_amdgcn_readfirstlane(l0 + (unsigned)((st) * STAGE + i * 8192))); \
      _Pragma("unroll") for (int i = 0; i < WC; ++i) { if (CSC1) glds16g_sc1(cs[i] + (t) * 64, (unsigned)__builtin_amdgcn_readfirstlane(l0 + (unsigned)((st) * STAGE + BR * 128 + i * 8192))); else glds16g(cs[i] + (t) * 64, (unsigned)__builtin_amdgcn_readfirstlane(l0 + (unsigned)((st) * STAGE + BR * 128 + i * 8192))); } } while (0)
    asm volatile("s_waitcnt lgkmcnt(0)\n\ts_barrier" ::: "memory");
    if (!pre) GD_ISSUE(0, 0);
    if (nk > 1) { GD_ISSUE(1, 1); VMW(6); } else VMW(0);
    if (grp1) asm volatile("s_barrier" ::: "memory");
    int st = 0;
    for (int t = 0; t < nk; ++t) {
      asm volatile("s_barrier" ::: "memory");
      __builtin_amdgcn_sched_barrier(0);
      LDSP char* sp = lds + st * STAGE;
      bf16x8 fr[4][2], fc[4][2];
#pragma unroll
      for (int kk = 0; kk < 4; ++kk) {
        const int co = (((kk * 2 + h) ^ sw) << 4);
#pragma unroll
        for (int ri = 0; ri < 2; ++ri) fr[kk][ri] = *(LDSP const bf16x8*)(sp + fr_base + ri * 4096 + co);
#pragma unroll
        for (int ci = 0; ci < 2; ++ci) fc[kk][ci] = *(LDSP const bf16x8*)(sp + fc_base + ci * 4096 + co);
      }
      if (t + 2 < nk) { const int s2 = (st >= 1) ? st - 1 : 2; GD_ISSUE(t + 2, s2); VMW(6); }
      else VMW(0);
      asm volatile("s_waitcnt lgkmcnt(0)\n\ts_barrier" ::: "memory");
      __builtin_amdgcn_sched_barrier(0);
      __builtin_amdgcn_s_setprio(1);
#pragma unroll
      for (int kk = 0; kk < 4; ++kk)
#pragma unroll
        for (int ri = 0; ri < 2; ++ri)
#pragma unroll
          for (int ci = 0; ci < 2; ++ci) acc[ri][ci] = __builtin_amdgcn_mfma_f32_32x32x16_bf16(fr[kk][ri], fc[kk][ci], acc[ri][ci], 0, 0, 0);
      __builtin_amdgcn_s_setprio(0);
      __builtin_amdgcn_sched_barrier(0);
      st = (st == 2) ? 0 : st + 1;
    }
    if (!grp1) asm volatile("s_barrier" ::: "memory");
    asm volatile("s_barrier" ::: "memory");
#undef GD_ISSUE
  }

  static __device__ __forceinline__ LDSP char* free_stage(LDSP char* lds, int st) { return lds + ((st >= 1) ? st - 1 : 2) * STAGE; }
};

struct RunDesc {
  const char* rbase; unsigned rstride;
  const char* cbase; unsigned clo0, clo1;
  unsigned rlo; int nk; bool sc1; bool fp8;
  int bscale;
};
__device__ __forceinline__ const char* uni64(const char* p) {
  const unsigned lo = __builtin_amdgcn_readfirstlane((unsigned)(uintptr_t)p), hi = __builtin_amdgcn_readfirstlane((unsigned)((uintptr_t)p >> 32));
  return (const char*)(((uintptr_t)hi << 32) | (uintptr_t)lo);
}
__device__ __forceinline__ void glds16s(const char* sbase, unsigned voff, unsigned lds_dst) { unsigned keep; sbase = uni64(sbase);
  asm volatile("s_mov_b32 %0, m0\n\ts_mov_b32 m0, %3\n\ts_nop 0\n\tglobal_load_lds_dwordx4 %1, %2\n\ts_mov_b32 m0, %0" : "=&s"(keep) : "v"(voff), "s"(sbase), "s"(lds_dst) : "memory"); }
__device__ __forceinline__ void glds16s_sc1(const char* sbase, unsigned voff, unsigned lds_dst) { unsigned keep; sbase = uni64(sbase);
  asm volatile("s_mov_b32 %0, m0\n\ts_mov_b32 m0, %3\n\ts_nop 0\n\tglobal_load_lds_dwordx4 %1, %2 sc1\n\ts_mov_b32 m0, %0" : "=&s"(keep) : "v"(voff), "s"(sbase), "s"(lds_dst) : "memory"); }

struct StreamCore {
  static constexpr int BR = 256, BC = 128, STAGE = (BR + BC) * 128, WC = 2;
  static __device__ __forceinline__ LDSP char* free_stage(LDSP char* lds, int st) { return lds + ((st >= 1) ? st - 1 : 2) * STAGE; }
  static __device__ __forceinline__ void issue_tile(const RunDesc& d, int tile, unsigned dst) {
    const unsigned t128 = (unsigned)tile * 128u;
#pragma unroll
    for (int i = 0; i < 4; ++i) glds16s(d.rbase, d.rlo + (unsigned)i * d.rstride + t128, (unsigned)__builtin_amdgcn_readfirstlane(dst + (unsigned)(i * 8192)));
    if (d.sc1) {
      glds16s_sc1(d.cbase, d.clo0 + t128, (unsigned)__builtin_amdgcn_readfirstlane(dst + (unsigned)(BR * 128)));
      glds16s_sc1(d.cbase, d.clo1 + t128, (unsigned)__builtin_amdgcn_readfirstlane(dst + (unsigned)(BR * 128 + 8192)));
    } else {
      glds16s(d.cbase, d.clo0 + t128, (unsigned)__builtin_amdgcn_readfirstlane(dst + (unsigned)(BR * 128)));
      glds16s(d.cbase, d.clo1 + t128, (unsigned)__builtin_amdgcn_readfirstlane(dst + (unsigned)(BR * 128 + 8192)));
    }
  }
  template <bool F8, class NextF>
  static __device__ __forceinline__ void run_stream(f32x16 (&acc)[2][2], const RunDesc& d, const NextF& next, bool drain_first,
                                                    LDSP char* lds, int tid, int& st, int& pre) {
    const int lane = tid & 63; const int wid = __builtin_amdgcn_readfirstlane(tid >> 6);
    const int wr = wid / WC, wc = wid % WC;
    const int l31 = lane & 31, h = lane >> 5, sw = (lane >> 1) & 7;
    const unsigned l0 = (unsigned)(uintptr_t)lds + (unsigned)wid * 1024u;
    const int fr_base = (wr * 64 + l31) * 128;
    const int fc_base = BR * 128 + (wc * 64 + l31) * 128;
    const int nk = d.nk;
    const bool grp1 = wid >= 4;
    if (pre == 0) {
      if (drain_first) asm volatile("s_waitcnt vmcnt(0) lgkmcnt(0)\n\ts_barrier" ::: "memory");
      else asm volatile("s_waitcnt lgkmcnt(0)\n\ts_barrier" ::: "memory");
      issue_tile(d, 0, l0 + (unsigned)(st * STAGE));
      issue_tile(d, 1, l0 + (unsigned)(((st == 2) ? 0 : st + 1) * STAGE));
      VMW(6);
    } else {
      if (drain_first) asm volatile("s_waitcnt vmcnt(0) lgkmcnt(0)" ::: "memory");
      else asm volatile("s_waitcnt lgkmcnt(0)" ::: "memory");
    }
    if (grp1) asm volatile("s_barrier" ::: "memory");
    bool nvalid = false;
    for (int t = 0; t < nk; ++t) {
      asm volatile("s_barrier" ::: "memory");
      __builtin_amdgcn_sched_barrier(0);
      LDSP char* sp = lds + st * STAGE;
      bf16x8 fr[4][2], fc[4][2];
      v8i_t fa[2][2], fb[2][2];
      if (F8) {
#pragma unroll
        for (int s2 = 0; s2 < 2; ++s2) {
          const int co0 = (((s2 * 4 + 2 * h) ^ sw) << 4), co1 = (((s2 * 4 + 2 * h + 1) ^ sw) << 4);
#pragma unroll
          for (int ri = 0; ri < 2; ++ri) {
            const v4i_t lo = *(LDSP const v4i_t*)(sp + fr_base + ri * 4096 + co0), hi = *(LDSP const v4i_t*)(sp + fr_base + ri * 4096 + co1);
            fa[s2][ri] = __builtin_shufflevector(lo, hi, 0, 1, 2, 3, 4, 5, 6, 7);
          }
#pragma unroll
          for (int ci = 0; ci < 2; ++ci) {
            const v4i_t lo = *(LDSP const v4i_t*)(sp + fc_base + ci * 4096 + co0), hi = *(LDSP const v4i_t*)(sp + fc_base + ci * 4096 + co1);
            fb[s2][ci] = __builtin_shufflevector(lo, hi, 0, 1, 2, 3, 4, 5, 6, 7);
          }
        }
      } else {
#pragma unroll
        for (int kk = 0; kk < 4; ++kk) {
          const int co = (((kk * 2 + h) ^ sw) << 4);
#pragma unroll
          for (int ri = 0; ri < 2; ++ri) fr[kk][ri] = *(LDSP const bf16x8*)(sp + fr_base + ri * 4096 + co);
#pragma unroll
          for (int ci = 0; ci < 2; ++ci) fc[kk][ci] = *(LDSP const bf16x8*)(sp + fc_base + ci * 4096 + co);
        }
      }
      const unsigned d2 = l0 + (unsigned)(((st >= 1) ? st - 1 : 2) * STAGE);
      bool issued = false;
      if (t + 2 < nk) { issue_tile(d, t + 2, d2); issued = true; }
      else {
        RunDesc dn;
        if (next(dn)) { issue_tile(dn, t + 2 - nk, d2); issued = true; nvalid = true; }
      }
      if (issued) VMW(6); else VMW(0);
      asm volatile("s_waitcnt lgkmcnt(0)\n\ts_barrier" ::: "memory");
      __builtin_amdgcn_sched_barrier(0);
      __builtin_amdgcn_s_setprio(1);
      if (F8) {
#pragma unroll
        for (int s2 = 0; s2 < 2; ++s2)
#pragma unroll
          for (int ri = 0; ri < 2; ++ri)
#pragma unroll
            for (int ci = 0; ci < 2; ++ci)
              acc[ri][ci] = __builtin_amdgcn_mfma_scale_f32_32x32x64_f8f6f4(fa[s2][ri], fb[s2][ci], acc[ri][ci], 0, 0, 0, 0x77777777, 0, d.bscale);
      } else {
#pragma unroll
        for (int kk = 0; kk < 4; ++kk)
#pragma unroll
          for (int ri = 0; ri < 2; ++ri)
#pragma unroll
            for (int ci = 0; ci < 2; ++ci) acc[ri][ci] = __builtin_amdgcn_mfma_f32_32x32x16_bf16(fr[kk][ri], fc[kk][ci], acc[ri][ci], 0, 0, 0);
      }
      __builtin_amdgcn_s_setprio(0);
      __builtin_amdgcn_sched_barrier(0);
      st = (st == 2) ? 0 : st + 1;
    }
    if (!grp1) asm volatile("s_barrier" ::: "memory");
    pre = nvalid ? 2 : 0;
  }
};


struct Desc2 { const char* rbase; unsigned rlo, rstride; const char* cbase; unsigned clo, cstride; int nk; };
struct Core256 {
  static constexpr int STAGE = 32768;
  static __device__ __forceinline__ unsigned lane_off(int tid, unsigned pitch) { const int row = tid >> 2, pos = tid & 3; return (unsigned)row * pitch + (unsigned)((pos ^ ((row >> 2) & 3)) << 4); }
  static __device__ __forceinline__ void issue_tile(const Desc2& d, int tile, unsigned dst) {
    const unsigned t64 = (unsigned)tile * 64u;
#pragma unroll
    for (int i = 0; i < 2; ++i) glds16s(d.rbase, d.rlo + (unsigned)i * d.rstride + t64, (unsigned)__builtin_amdgcn_readfirstlane(dst + (unsigned)(i * 8192)));
#pragma unroll
    for (int i = 0; i < 2; ++i) glds16s(d.cbase, d.clo + (unsigned)i * d.cstride + t64, (unsigned)__builtin_amdgcn_readfirstlane(dst + (unsigned)(16384 + i * 8192)));
  }
  static __device__ __forceinline__ void prefetch0(const Desc2& d, LDSP char* lds, int tid) {
    const int wid = __builtin_amdgcn_readfirstlane(tid >> 6);
    issue_tile(d, 0, (unsigned)(uintptr_t)lds + (unsigned)wid * 1024u);
  }
  static __device__ __forceinline__ void run(f32x16 (&acc)[4][2], const Desc2& d, LDSP char* lds, int tid, bool pre) {
    const int lane = tid & 63; const int wid = __builtin_amdgcn_readfirstlane(tid >> 6);
    const int wr = wid >> 2, wc = wid & 3;
    const int l31 = lane & 31, h = lane >> 5, sw2 = (lane >> 2) & 3;
    const unsigned l0 = (unsigned)(uintptr_t)lds + (unsigned)wid * 1024u;
    const int fr_base = (wr * 128 + l31) * 64;
    const int fc_base = 16384 + (wc * 64 + l31) * 64;
    const int nk = d.nk;
    const bool grp1 = wid >= 4;
    asm volatile("s_waitcnt lgkmcnt(0)\n\ts_barrier" ::: "memory");
    if (!pre) issue_tile(d, 0, l0);
    issue_tile(d, 1, l0 + STAGE); VMW(4);
    if (grp1) asm volatile("s_barrier" ::: "memory");
    int st = 0;
    for (int t = 0; t < nk; ++t) {
      asm volatile("s_barrier" ::: "memory");
      __builtin_amdgcn_sched_barrier(0);
      LDSP char* sp = lds + st * STAGE;
      bf16x8 fr[2][4], fc[2][2];
#pragma unroll
      for (int kk = 0; kk < 2; ++kk) {
        const int co = (((kk * 2 + h) ^ sw2) << 4);
#pragma unroll
        for (int ri = 0; ri < 4; ++ri) fr[kk][ri] = *(LDSP const bf16x8*)(sp + fr_base + ri * 2048 + co);
#pragma unroll
        for (int ci = 0; ci < 2; ++ci) fc[kk][ci] = *(LDSP const bf16x8*)(sp + fc_base + ci * 2048 + co);
      }
      if (t + 2 < nk) { const int s2 = (st >= 1) ? st - 1 : 2; issue_tile(d, t + 2, l0 + (unsigned)(s2 * STAGE)); VMW(4); }
      else VMW(0);
      asm volatile("s_waitcnt lgkmcnt(0)\n\ts_barrier" ::: "memory");
      __builtin_amdgcn_sched_barrier(0);
      __builtin_amdgcn_s_setprio(1);
#pragma unroll
      for (int kk = 0; kk < 2; ++kk)
#pragma unroll
        for (int ri = 0; ri < 4; ++ri)
#pragma unroll
          for (int ci = 0; ci < 2; ++ci) acc[ri][ci] = __builtin_amdgcn_mfma_f32_32x32x16_bf16(fr[kk][ri], fc[kk][ci], acc[ri][ci], 0, 0, 0);
      __builtin_amdgcn_s_setprio(0);
      __builtin_amdgcn_sched_barrier(0);
      st = (st == 2) ? 0 : st + 1;
    }
    if (!grp1) asm volatile("s_barrier" ::: "memory");
    asm volatile("s_barrier" ::: "memory");
  }
};

__device__ __forceinline__ void stage_tile(const f32x16 (&acc)[2][2], LDSP char* wl, int lane) {
  const int cl = lane & 31, h = lane >> 5;
#pragma unroll
  for (int ci = 0; ci < 2; ++ci) {
    const int row = ci * 32 + cl; const int sw = (row >> 1) & 7;
#pragma unroll
    for (int ri = 0; ri < 2; ++ri)
#pragma unroll
      for (int g = 0; g < 4; ++g) {
        u32x2 w; w.x = pk_bf16(acc[ri][ci][4 * g + 0], acc[ri][ci][4 * g + 1]); w.y = pk_bf16(acc[ri][ci][4 * g + 2], acc[ri][ci][4 * g + 3]);
        *(LDSP u32x2*)(wl + row * 128 + (((ri * 4 + g) ^ sw) << 4) + 8 * h) = w;
      }
  }
}
__device__ __forceinline__ void read_row(float (&v)[64], LDSP const char* wl, int lane) {
  const int sw = (lane >> 1) & 7;
#pragma unroll
  for (int j = 0; j < 8; ++j) {
    const u32x4 w = *(LDSP const u32x4*)(wl + lane * 128 + ((j ^ sw) << 4));
    v[8 * j + 0] = bf_lo(w.x); v[8 * j + 1] = bf_hi(w.x); v[8 * j + 2] = bf_lo(w.y); v[8 * j + 3] = bf_hi(w.y);
    v[8 * j + 4] = bf_lo(w.z); v[8 * j + 5] = bf_hi(w.z); v[8 * j + 6] = bf_lo(w.w); v[8 * j + 7] = bf_hi(w.w);
  }
}

__device__ __forceinline__ void inproj_epilogue(CQ& q, const f32x16 (&acc)[2][2], int chunk, int mt0, LDSP char* wl, int lane) {
  CP& p = q.p;
    if (chunk == 17) {
      const int cl = lane & 31, h = lane >> 5;
#pragma unroll
      for (int ci = 0; ci < 2; ++ci) {
        float* mrow = q.misc + (size_t)(mt0 + ci * 32 + cl) * 32;
        const f32x16& a = acc[0][ci];
        if (h == 0) {
          *(float4*)(mrow + 0) = make_float4(a[0] * 0.0625f, a[1] * 0.0625f, a[2] * 0.0625f, a[3] * 0.0625f);
          *(float4*)(mrow + 8) = make_float4(a[4], a[5], a[6], a[7]);
          *(float4*)(mrow + 16) = make_float4(a[8], a[9], a[10], a[11]);
        } else {
          *(float4*)(mrow + 4) = make_float4(a[0], a[1], a[2], a[3]);
          *(float4*)(mrow + 12) = make_float4(a[4], a[5], a[6], a[7]);
        }
      }
    } else {
      stage_tile(acc, wl, lane);
      float v[64];
      read_row(v, wl, lane);
      const int tok = mt0 + lane;
      const bool do_norm = chunk < 10;
      const bool do_rope = chunk < 10 || (chunk >= 12 && chunk < 17);
      if (do_norm) {
        const float* nw = (chunk < 8) ? p.q_norm_w : p.k_norm_w;
        float ss = 0.f;
#pragma unroll
        for (int i = 0; i < 64; ++i) ss += v[i] * v[i];
        const float r = rsqrtf(ss * (1.f / 64.f) + 1e-6f);
#pragma unroll
        for (int i = 0; i < 64; ++i) v[i] = v[i] * r * nw[i];
      }
      if (do_rope) {
        const float* rt_ = q.rope + (size_t)tok * 16;
        const float4 c0 = *(const float4*)(rt_), c1 = *(const float4*)(rt_ + 4), s0 = *(const float4*)(rt_ + 8), s1 = *(const float4*)(rt_ + 12);
        const float cs[8] = {c0.x, c0.y, c0.z, c0.w, c1.x, c1.y, c1.z, c1.w};
        const float sn[8] = {s0.x, s0.y, s0.z, s0.w, s1.x, s1.y, s1.z, s1.w};
#pragma unroll
        for (int i = 0; i < 8; ++i) {
          const float x1 = v[i], x2 = v[i + 8];
          v[i] = x1 * cs[i] - x2 * sn[i];
          v[i + 8] = x2 * cs[i] + x1 * sn[i];
        }
      }
      if (chunk < 8) {
#pragma unroll
        for (int i = 0; i < 64; ++i) v[i] *= ATT_C2;
      }
      {
        const int sw2 = (lane >> 1) & 7;
#pragma unroll
        for (int j = 0; j < 8; ++j) {
          u32x4 w; w.x = pk_bf16(v[8 * j], v[8 * j + 1]); w.y = pk_bf16(v[8 * j + 2], v[8 * j + 3]);
          w.z = pk_bf16(v[8 * j + 4], v[8 * j + 5]); w.w = pk_bf16(v[8 * j + 6], v[8 * j + 7]);
          *(LDSP u32x4*)(wl + lane * 128 + ((j ^ sw2) << 4)) = w;
        }
        const int erow = lane >> 3, ech = lane & 7;
#pragma unroll
        for (int i = 0; i < 8; ++i) {
          const int row = erow + 8 * i;
          const u32x4 w = *(LDSP const u32x4*)(wl + row * 128 + ((ech ^ ((row >> 1) & 7)) << 4));
          *(u32x4*)(q.proj2 + (size_t)(mt0 + row) * NP + chunk * 64 + ech * 8) = w;
        }
      }
    }
}

__device__ __forceinline__ void phase2(CQ& q, LDSP char* lds, int tid) {
  const int lane = tid & 63, wid = tid >> 6;
  const int G = gridDim.x, bid = blockIdx.x;
  const int xcd = bid & 7, lix = bid >> 3, per = G >> 3;
  {
    const int wr = wid >> 2, wc = wid & 3;
    const unsigned lo = Core256::lane_off(tid, 2048u);
    bool pre = false;
    for (int it = lix; it < 16 * 10; it += per) {
      const int tt = xcd + 8 * (it / 10), ct = it % 10;
      const int m0 = tt * 256;
      Desc2 d;
      d.rbase = (const char*)(q.wt_in + (size_t)ct * 256 * 1024); d.rlo = lo; d.rstride = 128u * 2048u;
      d.cbase = (const char*)(q.h1 + (size_t)m0 * 1024); d.clo = lo; d.cstride = 128u * 2048u;
      d.nk = 32;
      f32x16 acc[4][2];
#pragma unroll
      for (int a = 0; a < 4; ++a)
#pragma unroll
        for (int b = 0; b < 2; ++b)
#pragma unroll
          for (int r = 0; r < 16; ++r) acc[a][b][r] = 0.f;
      Core256::run(acc, d, lds, tid, pre);
      pre = false;
      if (it + per < 16 * 10) {
        const int it2 = it + per; const int tt2 = xcd + 8 * (it2 / 10), ct2 = it2 % 10;
        Desc2 d2 = d;
        d2.rbase = (const char*)(q.wt_in + (size_t)ct2 * 256 * 1024); d2.cbase = (const char*)(q.h1 + (size_t)tt2 * 256 * 1024);
        Core256::prefetch0(d2, lds, tid);
        pre = true;
      }
      LDSP char* wl = lds + 32768 + wid * 8192;
      const int mt0 = m0 + wc * 64;
      inproj_epilogue(q, *(const f32x16 (*)[2][2])&acc[0], ct * 4 + wr * 2, mt0, wl, lane);
      asm volatile("s_waitcnt lgkmcnt(0)" ::: "memory");
      inproj_epilogue(q, *(const f32x16 (*)[2][2])&acc[2], ct * 4 + wr * 2 + 1, mt0, wl, lane);
    }
  }
  {
    typedef GemmCoreD<2, 4, 3> GC;
    const int wr = wid / 4, wc = wid % 4;
    const int crow = tid >> 3;
    for (int it = lix; it < 16; it += per) {
      const int tt = xcd + 8 * it, rt = 20;
      const int m0 = tt * 256, n0 = rt * 128;
      const bf16_t* rp[2]; const bf16_t* cp[4];
#pragma unroll
      for (int i = 0; i < 2; ++i) rp[i] = q.wt_in + (size_t)(n0 + crow + 64 * i) * 1024;
#pragma unroll
      for (int i = 0; i < 4; ++i) cp[i] = q.h1 + (size_t)(m0 + crow + 64 * i) * 1024;
      f32x16 acc[2][2];
#pragma unroll
      for (int a = 0; a < 2; ++a)
#pragma unroll
        for (int b = 0; b < 2; ++b)
#pragma unroll
          for (int r = 0; r < 16; ++r) acc[a][b][r] = 0.f;
      GC::run(acc, rp, cp, 1024, lds, tid, false);
      inproj_epilogue(q, acc, rt * 2 + wr, m0 + wc * 64, lds + wid * 8192, lane);
    }
  }
}


typedef float f32x4a __attribute__((ext_vector_type(4)));
#define SROW 2052
__device__ __forceinline__ void idx_item(CQ& q, LDSP char* lds, int tid, int b, int qt) {
  CP& p = q.p;
  const int lane = tid & 63, wid = tid >> 6;
  LDSP float* sbuf = (LDSP float*)lds;
  const int q0 = qt * 16;
  const size_t tok0 = (size_t)b * SEQ + q0;
  const int ql = lane & 15, kg = lane >> 4;
  bf16x8 qf[4][2]; float wq[4];
  {
    const bf16_t* qp = q.proj2 + (tok0 + ql) * NP + D_QI + kg * 8;
#pragma unroll
    for (int hd = 0; hd < 4; ++hd)
#pragma unroll
      for (int s2 = 0; s2 < 2; ++s2) qf[hd][s2] = *(const bf16x8*)(qp + hd * 64 + s2 * 32);
    const float4 w4 = *(const float4*)(q.misc + (tok0 + ql) * 32);
    wq[0] = w4.x; wq[1] = w4.y; wq[2] = w4.z; wq[3] = w4.w;
  }
  const int nkt = qt + 1;
  const bf16_t* kbase = q.proj2 + ((size_t)b * SEQ + ql) * NP + D_KI + kg * 8;
  bf16x8 kr0[4], kr1[4];
#pragma unroll
  for (int j = 0; j < 4; ++j) {
    const int kt0 = wid + 8 * j;
    const bf16_t* kp = kbase + (size_t)(kt0 < nkt ? kt0 : 0) * 16 * NP;
    kr0[j] = *(const bf16x8*)(kp); kr1[j] = *(const bf16x8*)(kp + 32);
  }
  for (int kt4 = wid; kt4 < nkt; kt4 += 32) {
#pragma unroll
    for (int j = 0; j < 4; ++j) {
      const int kt = kt4 + 8 * j;
      if (kt < nkt) {
        const bf16x8 k0 = kr0[j], k1 = kr1[j];
        { const int k2t = kt + 32; const bf16_t* kp = kbase + (size_t)(k2t < nkt ? k2t : 0) * 16 * NP; kr0[j] = *(const bf16x8*)(kp); kr1[j] = *(const bf16x8*)(kp + 32); }
        f32x4a sc = {0.f, 0.f, 0.f, 0.f};
#pragma unroll
        for (int hd = 0; hd < 4; ++hd) {
          f32x4a d = {0.f, 0.f, 0.f, 0.f};
          d = __builtin_amdgcn_mfma_f32_16x16x32_bf16(k0, qf[hd][0], d, 0, 0, 0);
          d = __builtin_amdgcn_mfma_f32_16x16x32_bf16(k1, qf[hd][1], d, 0, 0, 0);
#pragma unroll
          for (int jj = 0; jj < 4; ++jj) sc[jj] += wq[hd] * fmaxf(d[jj], 0.f);
        }
        *(LDSP f32x4a*)(sbuf + ql * SROW + kt * 16 + kg * 4) = sc;
      }
    }
  }
  __syncthreads();
  const int qa_ = wid * 2, qb_ = wid * 2 + 1;
  const int ta = q0 + qa_, tb_ = q0 + qb_;
  if (tb_ < 256) {
#pragma unroll
    for (int qq = 0; qq < 2; ++qq) {
      const int t = q0 + wid * 2 + qq;
      const int lo = lane * 32;
      const unsigned w = (t >= lo + 31) ? 0xffffffffu : (t < lo ? 0u : ((2u << (t - lo)) - 1u));
      p.mask[(tok0 + wid * 2 + qq) * 64 + lane] = w;
    }
  } else {
    unsigned ua[32], ub[32];
    const int ngr = (tb_ >> 9) + 1;
#pragma unroll
    for (int i = 0; i < 32; ++i) { ua[i] = 0u; ub[i] = 0u; }
#pragma unroll
    for (int gq = 0; gq < 4; ++gq) {
      if (gq < ngr) {
#pragma unroll
        for (int i = gq * 8; i < gq * 8 + 8; ++i) {
          const int key = lane + 64 * i;
          const float fa = sbuf[qa_ * SROW + key] + 0.0f, fb = sbuf[qb_ * SROW + key] + 0.0f;
          const unsigned ba = __float_as_uint(fa), bb = __float_as_uint(fb);
          const unsigned ea = (ba & 0x80000000u) ? ~ba : (ba | 0x80000000u), eb = (bb & 0x80000000u) ? ~bb : (bb | 0x80000000u);
          ua[i] = (key <= ta) ? ea : 0u; ub[i] = (key <= tb_) ? eb : 0u;
        }
      }
    }
    unsigned taua = 0u, taub = 0u; bool exa = false, exb = false;
    for (int bit = 31; bit >= 0; --bit) {
      if (exa && exb) break;
      const unsigned ca = taua | (1u << bit), cb = taub | (1u << bit);
      unsigned la = 0u, lb = 0u;
#pragma unroll
      for (int gq = 0; gq < 4; ++gq) {
        if (gq < ngr) {
#pragma unroll
          for (int i = gq * 8; i < gq * 8 + 8; ++i) { la += (ua[i] >= ca) ? 1u : 0u; lb += (ub[i] >= cb) ? 1u : 0u; }
        }
      }
      int na = 0, nb = 0;
#pragma unroll
      for (int bt = 0; bt < 6; ++bt) { na += __builtin_popcountll(__ballot((la >> bt) & 1u)) << bt; nb += __builtin_popcountll(__ballot((lb >> bt) & 1u)) << bt; }
      if (!exa && na >= 256) { taua = ca; exa = (na == 256); }
      if (!exb && nb >= 256) { taub = cb; exb = (nb == 256); }
    }
    const unsigned long long ltmask = (1ull << lane) - 1ull;
#pragma unroll
    for (int qq = 0; qq < 2; ++qq) {
      const unsigned tau = qq ? taub : taua; const bool exact = qq ? exb : exa;
      int need = 0;
      if (!exact) {
        unsigned lc = 0u;
#pragma unroll
        for (int i = 0; i < 32; ++i) { const unsigned uv = qq ? ub[i] : ua[i]; lc += (uv > tau) ? 1u : 0u; }
        int cgt = 0;
#pragma unroll
        for (int bt = 0; bt < 6; ++bt) cgt += __builtin_popcountll(__ballot((lc >> bt) & 1u)) << bt;
        need = 256 - cgt;
      }
      int running = 0; unsigned wout = 0u;
#pragma unroll
      for (int gq = 0; gq < 4; ++gq) {
        if (gq < ngr) {
#pragma unroll
          for (int i = gq * 8; i < gq * 8 + 8; ++i) {
            const unsigned uv = qq ? ub[i] : ua[i];
            bool selb;
            if (exact) selb = uv >= tau;
            else {
              const bool tie = (uv == tau);
              const unsigned long long tb2 = __ballot(tie);
              const int pre = running + __builtin_popcountll(tb2 & ltmask);
              running += __builtin_popcountll(tb2);
              selb = (uv > tau) || (tie && pre < need);
            }
            const unsigned long long sb = __ballot(selb);
            if (lane == 2 * i) wout = (unsigned)(sb & 0xffffffffull);
            if (lane == 2 * i + 1) wout = (unsigned)(sb >> 32);
          }
        }
      }
      p.mask[(tok0 + wid * 2 + qq) * 64 + lane] = wout;
    }
  }
  __syncthreads();
}
__device__ __forceinline__ void phase3(CQ& q, LDSP char* lds, int tid) {
  volatile LDSP int* sit = (volatile LDSP int*)(lds + LDS_BYTES - 8);
  int nxt = 0;
  if (tid == 0) nxt = atomicAdd(q.ictr, 1);
  for (;;) {
    if (tid == 0) *sit = nxt;
    __syncthreads();
    const int it = *sit;
    __syncthreads();
    if (it >= BATCH * 128) break;
    if (tid == 0) nxt = atomicAdd(q.ictr, 1);
    const int qt = 127 - (it >> 4), b = it & 15;
    idx_item(q, lds, tid, b, qt);
  }
}

__device__ __forceinline__ int toff(int row, int chunk) { return row * 128 + ((chunk ^ ((row >> 1) & 7)) << 4); }
__device__ __forceinline__ bf16x8 frag(LDSP const char* base, int row0, int kk, int l31, int h) {
  const int row = row0 + l31;
  return *(LDSP const bf16x8*)(base + row * 128 + ((((kk * 2 + h)) ^ ((row >> 1) & 7)) << 4));
}
__device__ __forceinline__ float bfu(unsigned short v) { return __uint_as_float((unsigned)v << 16); }

__device__ __forceinline__ float silu_fast(float v) { return v * __builtin_amdgcn_rcpf(1.f + __expf(-v)); }
__device__ __forceinline__ void gla_unit(CQ& q, LDSP char* lds, int tid, int b, int h) {
  CP& p = q.p;
  const int lane = tid & 63, wid = tid >> 6, l31 = lane & 31, hh = lane >> 5;
  LDSP float* W2S = (LDSP float*)(lds);
  LDSP float* BG = W2S + 1024;
  LDSP float* GB = (LDSP float*)(lds + 4352);
  LDSP float* SEG = (LDSP float*)(lds + 20736);
  LDSP float* DEC = (LDSP float*)(lds + 22784);
  LDSP float* SSQ = (LDSP float*)(lds + 23040);
  LDSP char* QT = lds + 24064;
  LDSP char* KT = lds + 32256;
  LDSP char* KRAW = lds + 40448;
  LDSP char* KH = lds + 48640;
  LDSP char* VRAW = lds + 56832;
  LDSP char* VT = lds + 73216;
  LDSP char* AM = lds + 89600;
  LDSP char* ST = lds + 97792;
  LDSP char* OST = lds + 114176;
  const int t = tid >> 3, c8 = tid & 7;
  __syncthreads();
  for (int i = tid; i < 1024; i += NTHR) W2S[i] = p.w_gk2[(i >> 6) * 256 + h * 64 + (i & 63)];
  if (tid < 64) BG[tid] = p.b_gk[h * 64 + tid];
  for (int i = tid; i < 4096; i += NTHR) ((LDSP unsigned*)ST)[i] = 0u;
  f32x16 Sacc[2];
#pragma unroll
  for (int r = 0; r < 16; ++r) { Sacc[0][r] = 0.f; Sacc[1][r] = 0.f; }
  const size_t tokb = (size_t)b * SEQ;
  u32x4 rq, rk, rv[2], rgo[2]; float4 rgk[4];
  {
    const size_t tok = tokb + t;
    const bf16_t* pr = q.proj2 + tok * NP;
    rq = *(const u32x4*)(pr + D_QG + h * 64 + c8 * 8);
    rk = *(const u32x4*)(pr + D_KG + h * 64 + c8 * 8);
    rv[0] = *(const u32x4*)(pr + D_VG + h * 128 + c8 * 8);
    rv[1] = *(const u32x4*)(pr + D_VG + h * 128 + 64 + c8 * 8);
    rgo[0] = *(const u32x4*)(pr + D_GO + h * 128 + c8 * 8);
    rgo[1] = *(const u32x4*)(pr + D_GO + h * 128 + 64 + c8 * 8);
#pragma unroll
    for (int i = 0; i < 4; ++i) rgk[i] = *(const float4*)(q.misc + tok * 32 + 4 + 4 * i);
  }
  __syncthreads();
  for (int c = 0; c < SEQ / 64; ++c) {
    const size_t tok = tokb + c * 64 + t;
    {
      const float gk[16] = {rgk[0].x, rgk[0].y, rgk[0].z, rgk[0].w, rgk[1].x, rgk[1].y, rgk[1].z, rgk[1].w,
                            rgk[2].x, rgk[2].y, rgk[2].z, rgk[2].w, rgk[3].x, rgk[3].y, rgk[3].z, rgk[3].w};
      float z[8];
#pragma unroll
      for (int j = 0; j < 8; ++j) z[j] = BG[c8 * 8 + j];
#pragma unroll
      for (int r = 0; r < 16; ++r) {
        const f32x4v w0 = *(LDSP const f32x4v*)(W2S + r * 64 + c8 * 8), w1 = *(LDSP const f32x4v*)(W2S + r * 64 + c8 * 8 + 4);
        z[0] += gk[r] * w0[0]; z[1] += gk[r] * w0[1]; z[2] += gk[r] * w0[2]; z[3] += gk[r] * w0[3];
        z[4] += gk[r] * w1[0]; z[5] += gk[r] * w1[1]; z[6] += gk[r] * w1[2]; z[7] += gk[r] * w1[3];
      }
      f32x4v g0, g1;
#pragma unroll
      for (int j = 0; j < 8; ++j) {
        const float ls = (fminf(z[j], 0.f) - __logf(1.f + __expf(-fabsf(z[j])))) * (1.f / 16.f);
        if (j < 4) g0[j] = ls; else g1[j - 4] = ls;
      }
      *(LDSP f32x4v*)(GB + t * 64 + c8 * 8) = g0;
      *(LDSP f32x4v*)(GB + t * 64 + c8 * 8 + 4) = g1;
      *(LDSP u32x4*)(KRAW + t * 128 + c8 * 16) = rk;
      *(LDSP u32x4*)(VRAW + t * 256 + c8 * 16) = rv[0];
      *(LDSP u32x4*)(VRAW + t * 256 + 128 + c8 * 16) = rv[1];
    }
    __syncthreads();
    {
      const int d = lane, seg = wid;
      float run = 0.f;
#pragma unroll
      for (int i = 0; i < 8; ++i) { run += GB[(seg * 8 + i) * 64 + d]; GB[(seg * 8 + i) * 64 + d] = run; }
      SEG[seg * 64 + d] = run;
      __syncthreads();
      float base = 0.f;
      for (int s2 = 0; s2 < seg; ++s2) base += SEG[s2 * 64 + d];
#pragma unroll
      for (int i = 0; i < 8; ++i) GB[(seg * 8 + i) * 64 + d] += base;
      if (seg == 7) DEC[d] = __expf(run + base);
    }
    __syncthreads();
    {
      const f32x4v b0 = *(LDSP const f32x4v*)(GB + t * 64 + c8 * 8), b1 = *(LDSP const f32x4v*)(GB + t * 64 + c8 * 8 + 4);
      const float bv[8] = {b0[0], b0[1], b0[2], b0[3], b1[0], b1[1], b1[2], b1[3]};
      const unsigned qw[4] = {rq.x, rq.y, rq.z, rq.w}, kw[4] = {rk.x, rk.y, rk.z, rk.w};
      unsigned qo[4], ko[4];
#pragma unroll
      for (int j = 0; j < 4; ++j) {
        const float e0 = __expf(bv[2 * j]), e1 = __expf(bv[2 * j + 1]);
        qo[j] = pk_bf16(bf_lo(qw[j]) * 0.125f * e0, bf_hi(qw[j]) * 0.125f * e1);
        ko[j] = pk_bf16(bf_lo(kw[j]) * __builtin_amdgcn_rcpf(e0), bf_hi(kw[j]) * __builtin_amdgcn_rcpf(e1));
      }
      *(LDSP u32x4*)(QT + toff(t, c8)) = (u32x4){qo[0], qo[1], qo[2], qo[3]};
      *(LDSP u32x4*)(KT + toff(t, c8)) = (u32x4){ko[0], ko[1], ko[2], ko[3]};
      {
        const int d = lane, seg = wid;
        const float bend = GB[63 * 64 + d];
        float kh[8];
#pragma unroll
        for (int i = 0; i < 8; ++i) {
          const int s2 = seg * 8 + i;
          kh[i] = bfu(*(LDSP const unsigned short*)(KRAW + (s2 * 64 + d) * 2)) * __expf(bend - GB[s2 * 64 + d]);
        }
        *(LDSP u32x4*)(KH + toff(d, seg)) = (u32x4){pk_bf16(kh[0], kh[1]), pk_bf16(kh[2], kh[3]), pk_bf16(kh[4], kh[5]), pk_bf16(kh[6], kh[7])};
      }
      {
        const int vcol = tid & 127, sg4 = tid >> 7;
#pragma unroll
        for (int half = 0; half < 2; ++half) {
          unsigned short e[8];
#pragma unroll
          for (int i = 0; i < 8; ++i) e[i] = *(LDSP const unsigned short*)(VRAW + ((sg4 * 16 + half * 8 + i) * 128 + vcol) * 2);
          *(LDSP u32x4*)(VT + toff(vcol, sg4 * 2 + half)) = (u32x4){(unsigned)e[0] | ((unsigned)e[1] << 16), (unsigned)e[2] | ((unsigned)e[3] << 16),
                                                                   (unsigned)e[4] | ((unsigned)e[5] << 16), (unsigned)e[6] | ((unsigned)e[7] << 16)};
        }
      }
    }
    __syncthreads();
    if (c + 1 < SEQ / 64) {
      const bf16_t* pr = q.proj2 + (tok + 64) * NP;
      rq = *(const u32x4*)(pr + D_QG + h * 64 + c8 * 8);
      rk = *(const u32x4*)(pr + D_KG + h * 64 + c8 * 8);
      rv[0] = *(const u32x4*)(pr + D_VG + h * 128 + c8 * 8);
      rv[1] = *(const u32x4*)(pr + D_VG + h * 128 + 64 + c8 * 8);
#pragma unroll
      for (int i = 0; i < 4; ++i) rgk[i] = *(const float4*)(q.misc + (tok + 64) * 32 + 4 + 4 * i);
    }
    f32x16 oacc[2];
    if (wid < 4) {
      const int sblk = wid & 1, tblk = wid >> 1;
      f32x16 a;
#pragma unroll
      for (int r = 0; r < 16; ++r) a[r] = 0.f;
      if (!(sblk == 1 && tblk == 0)) {
#pragma unroll
        for (int kk = 0; kk < 4; ++kk) a = __builtin_amdgcn_mfma_f32_32x32x16_bf16(frag(KT, sblk * 32, kk, l31, hh), frag(QT, tblk * 32, kk, l31, hh), a, 0, 0, 0);
      }
      const int tt = tblk * 32 + l31;
#pragma unroll
      for (int r = 0; r < 16; ++r) { const int s2 = sblk * 32 + (r & 3) + 8 * (r >> 2) + 4 * hh; if (s2 > tt) a[r] = 0.f; }
#pragma unroll
      for (int g = 0; g < 4; ++g)
        *(LDSP u32x2*)(AM + toff(tt, sblk * 4 + g) + 8 * hh) = (u32x2){pk_bf16(a[4 * g], a[4 * g + 1]), pk_bf16(a[4 * g + 2], a[4 * g + 3])};
    } else {
      const int j = wid - 4;
#pragma unroll
      for (int tb = 0; tb < 2; ++tb) {
#pragma unroll
        for (int r = 0; r < 16; ++r) oacc[tb][r] = 0.f;
#pragma unroll
        for (int kk = 0; kk < 4; ++kk) oacc[tb] = __builtin_amdgcn_mfma_f32_32x32x16_bf16(frag(ST, j * 32, kk, l31, hh), frag(QT, tb * 32, kk, l31, hh), oacc[tb], 0, 0, 0);
      }
    }
    __syncthreads();
    if (wid >= 4) {
      const int j = wid - 4;
#pragma unroll
      for (int tb = 0; tb < 2; ++tb) {
#pragma unroll
        for (int kk = 0; kk < 4; ++kk) oacc[tb] = __builtin_amdgcn_mfma_f32_32x32x16_bf16(frag(VT, j * 32, kk, l31, hh), frag(AM, tb * 32, kk, l31, hh), oacc[tb], 0, 0, 0);
        float ss = 0.f;
#pragma unroll
        for (int r = 0; r < 16; ++r) ss += oacc[tb][r] * oacc[tb][r];
        ss += __shfl_xor(ss, 32);
        const int tt = tb * 32 + l31;
        if (hh == 0) SSQ[j * 64 + tt] = ss;
#pragma unroll
        for (int g = 0; g < 4; ++g)
          *(LDSP u32x2*)(OST + tt * 256 + (((j * 4 + g) ^ (tt & 15)) << 4) + 8 * hh) = (u32x2){pk_bf16(oacc[tb][4 * g], oacc[tb][4 * g + 1]), pk_bf16(oacc[tb][4 * g + 2], oacc[tb][4 * g + 3])};
      }
    } else {
      const int db = wid & 1;
      float dec[16];
#pragma unroll
      for (int r = 0; r < 16; ++r) dec[r] = DEC[db * 32 + (r & 3) + 8 * (r >> 2) + 4 * hh];
#pragma unroll
      for (int i = 0; i < 2; ++i) {
        const int vb = (wid >> 1) * 2 + i;
#pragma unroll
        for (int r = 0; r < 16; ++r) Sacc[i][r] *= dec[r];
#pragma unroll
        for (int kk = 0; kk < 4; ++kk) Sacc[i] = __builtin_amdgcn_mfma_f32_32x32x16_bf16(frag(KH, db * 32, kk, l31, hh), frag(VT, vb * 32, kk, l31, hh), Sacc[i], 0, 0, 0);
        const int vv = vb * 32 + l31;
#pragma unroll
        for (int g = 0; g < 4; ++g)
          *(LDSP u32x2*)(ST + toff(vv, db * 4 + g) + 8 * hh) = (u32x2){pk_bf16(Sacc[i][4 * g], Sacc[i][4 * g + 1]), pk_bf16(Sacc[i][4 * g + 2], Sacc[i][4 * g + 3])};
      }
    }
    __syncthreads();
    {
      const float ssq = SSQ[t] + SSQ[64 + t] + SSQ[128 + t] + SSQ[192 + t];
      const float rs = rsqrtf(ssq * (1.f / 128.f) + 1e-6f);
#pragma unroll
      for (int k2 = 0; k2 < 2; ++k2) {
        const int c16 = c8 + 8 * k2;
        const u32x4 ov = *(LDSP const u32x4*)(OST + t * 256 + ((c16 ^ (t & 15)) << 4));
        const u32x4 gv = rgo[k2];
        const float4 n0 = *(const float4*)(p.gla_norm_w + h * 128 + c16 * 8), n1 = *(const float4*)(p.gla_norm_w + h * 128 + c16 * 8 + 4);
        const float nw[8] = {n0.x, n0.y, n0.z, n0.w, n1.x, n1.y, n1.z, n1.w};
        const unsigned ow[4] = {ov.x, ov.y, ov.z, ov.w}, gw[4] = {gv.x, gv.y, gv.z, gv.w};
        unsigned yo[4];
#pragma unroll
        for (int j = 0; j < 4; ++j) {
          const float y0 = bf_lo(ow[j]) * rs * nw[2 * j] * silu_fast(bf_lo(gw[j]));
          const float y1 = bf_hi(ow[j]) * rs * nw[2 * j + 1] * silu_fast(bf_hi(gw[j]));
          yo[j] = pk_bf16(y0, y1);
        }
        *(u32x4*)(q.mixer + tok * 1024 + 512 + h * 128 + c16 * 8) = (u32x4){yo[0], yo[1], yo[2], yo[3]};
      }
      if (c + 1 < SEQ / 64) {
        const bf16_t* pr = q.proj2 + (tok + 64) * NP;
        rgo[0] = *(const u32x4*)(pr + D_GO + h * 128 + c8 * 8);
        rgo[1] = *(const u32x4*)(pr + D_GO + h * 128 + 64 + c8 * 8);
      }
    }
  }
  __syncthreads();
}
__device__ __forceinline__ void phase3b(CQ& q, LDSP char* lds, int tid) {
  for (int u = blockIdx.x; u < BATCH * 4; u += gridDim.x) gla_unit(q, lds, tid, u >> 2, u & 3);
}

namespace att {
typedef short s16x4 __attribute__((ext_vector_type(4)));
typedef short v4i16_t __attribute__((ext_vector_type(4)));
typedef __attribute__((address_space(3))) const char* lds_cptr;
constexpr int NW = 8, QBLK = 32, QB = 256, KVBLK = 64;
constexpr int NSLOT = 3, SLOTB = 8192;
constexpr int LDS_K = 0, LDS_V = NSLOT * SLOTB, LDS_WS = 2 * NSLOT * SLOTB, LDS_OST = LDS_WS + NW * 64 * 4, LDS_MASK = LDS_OST + NW * 4096, LDS_END = LDS_MASK + NW * 8192;
static_assert(LDS_END <= LDS_BYTES, "attention LDS");
__device__ __forceinline__ int crow(int r, int hi) { return (r & 3) + 8 * (r >> 2) + 4 * hi; }
#define SBAR() __builtin_amdgcn_sched_barrier(0)
__device__ __forceinline__ void glds16(const void* gsrc, unsigned lds_dst) { unsigned keep;
  asm volatile("s_mov_b32 %0, m0\n\ts_mov_b32 m0, %2\n\ts_nop 0\n\tglobal_load_lds_dwordx4 %1, off\n\ts_mov_b32 m0, %0" : "=&s"(keep) : "v"(gsrc), "s"(lds_dst) : "memory"); }
__device__ __forceinline__ float max3f(float a, float b, float c) { float r; asm("v_max3_f32 %0, %1, %2, %3" : "=v"(r) : "v"(a), "v"(b), "v"(c)); return r; }
__device__ __forceinline__ float max2f(float a, float b) { float r; asm("v_max_f32_e32 %0, %1, %2" : "=v"(r) : "v"(a), "v"(b)); return r; }
__device__ __forceinline__ float fadd_s(float a, float b) { float r; asm("v_add_f32_e32 %0, %1, %2" : "=v"(r) : "v"(a), "v"(b)); return r; }
__device__ __forceinline__ float fsub_s(float a, float b) { float r; asm("v_sub_f32_e32 %0, %1, %2" : "=v"(r) : "v"(a), "v"(b)); return r; }
__device__ __forceinline__ unsigned cvtpk_s(float lo, float hi) { return pk_bf16(lo, hi); }
#define WAIT_BAR(N) asm volatile("s_waitcnt vmcnt(" #N ") lgkmcnt(0)\n\ts_barrier" ::: "memory")

__device__ __forceinline__ void qkt(f32x16& p0, f32x16& p1, const char* Kslot, const bf16x8* qr, int r32, int hi) {
  const f32x16 negm = {};
  const char* kb = Kslot + hi * 1024 + r32 * 16;
#pragma unroll
  for (int d0 = 0; d0 < 4; ++d0) {
    const bf16x8 b0 = *reinterpret_cast<const bf16x8*>(kb + d0 * 2048);
    const bf16x8 b1 = *reinterpret_cast<const bf16x8*>(kb + d0 * 2048 + 512);
    if (d0 == 0) { p0 = __builtin_amdgcn_mfma_f32_32x32x16_bf16(b0, qr[0], negm, 0, 0, 0); p1 = __builtin_amdgcn_mfma_f32_32x32x16_bf16(b1, qr[0], negm, 0, 0, 0); }
    else { p0 = __builtin_amdgcn_mfma_f32_32x32x16_bf16(b0, qr[d0], p0, 0, 0, 0); p1 = __builtin_amdgcn_mfma_f32_32x32x16_bf16(b1, qr[d0], p1, 0, 0, 0); } }
}
__device__ __forceinline__ void kload8(bf16x8* kf, lds_cptr kp) {
  kf[0] = *(const __attribute__((address_space(3))) bf16x8*)(kp);        kf[1] = *(const __attribute__((address_space(3))) bf16x8*)(kp + 512);
  kf[2] = *(const __attribute__((address_space(3))) bf16x8*)(kp + 2048); kf[3] = *(const __attribute__((address_space(3))) bf16x8*)(kp + 2560);
  kf[4] = *(const __attribute__((address_space(3))) bf16x8*)(kp + 4096); kf[5] = *(const __attribute__((address_space(3))) bf16x8*)(kp + 4608);
  kf[6] = *(const __attribute__((address_space(3))) bf16x8*)(kp + 6144); kf[7] = *(const __attribute__((address_space(3))) bf16x8*)(kp + 6656);
}
__device__ __forceinline__ void kload2(bf16x8* kf, lds_cptr kp, int j) { kf[2 * j] = *(const __attribute__((address_space(3))) bf16x8*)(kp + j * 2048); kf[2 * j + 1] = *(const __attribute__((address_space(3))) bf16x8*)(kp + j * 2048 + 512); }
__device__ __forceinline__ s16x4 vtr(lds_cptr p) { return __builtin_bit_cast(s16x4, __builtin_amdgcn_ds_read_tr16_b64_v4i16((__attribute__((address_space(3))) v4i16_t*)p)); }
__device__ __forceinline__ float rowmax(const f32x16& p0, const f32x16& p1) {
  float a = max3f(p0[0], p0[1], p1[0]), b = max3f(p0[2], p0[3], p1[1]); a = max3f(a, p1[2], p1[3]);
#pragma unroll
  for (int r = 4; r < 16; r += 4) { a = max3f(a, p0[r], p0[r + 1]); b = max3f(b, p0[r + 2], p0[r + 3]); a = max3f(a, p1[r], p1[r + 1]); b = max3f(b, p1[r + 2], p1[r + 3]); }
  const float m = max2f(a, b);
  auto rr = __builtin_amdgcn_permlane32_swap(__float_as_uint(m), __float_as_uint(m), false, false);
  return max2f(__uint_as_float(rr[0]), __uint_as_float(rr[1]));
}
__device__ __forceinline__ void pv(f32x16* o, int vb, bf16x8 pa0, bf16x8 pa1, bf16x8 pa2, bf16x8 pa3) {
#pragma unroll
  for (int d0 = 0; d0 < 2; ++d0) { s16x4 lo[4], hi[4];
#pragma unroll
    for (int ks = 0; ks < 4; ++ks) {
      asm volatile("ds_read_b64_tr_b16 %0,%1 offset:%c2" : "=&v"(lo[ks]) : "v"(vb), "i"(d0 * 4096 + ks * 1024) : "memory");
      asm volatile("ds_read_b64_tr_b16 %0,%1 offset:%c2" : "=&v"(hi[ks]) : "v"(vb), "i"(d0 * 4096 + ks * 1024 + 512) : "memory"); }
    asm volatile("s_waitcnt lgkmcnt(0)" ::: "memory"); SBAR();
#define PK(k) (bf16x8){lo[k][0], lo[k][1], lo[k][2], lo[k][3], hi[k][0], hi[k][1], hi[k][2], hi[k][3]}
    o[d0] = __builtin_amdgcn_mfma_f32_32x32x16_bf16(pa0, PK(0), o[d0], 0, 0, 0);
    o[d0] = __builtin_amdgcn_mfma_f32_32x32x16_bf16(pa1, PK(1), o[d0], 0, 0, 0);
    o[d0] = __builtin_amdgcn_mfma_f32_32x32x16_bf16(pa2, PK(2), o[d0], 0, 0, 0);
    o[d0] = __builtin_amdgcn_mfma_f32_32x32x16_bf16(pa3, PK(3), o[d0], 0, 0, 0);
#undef PK
  }
}
__device__ __forceinline__ void maskb(f32x16& p0, f32x16& p1, lds_cptr mp, int t, int hi, float mh) {
  const u32x2 mw = *(const __attribute__((address_space(3))) u32x2*)(mp + t * 256);
  const unsigned m0 = mw.x >> (4 * hi), m1 = mw.y >> (4 * hi);
#pragma unroll
  for (int r = 0; r < 16; ++r) {
    const int bp = (r & 3) + 8 * (r >> 2);
    p0[r] = ((m0 >> bp) & 1u) ? p0[r] - mh : -INFINITY;
    p1[r] = ((m1 >> bp) & 1u) ? p1[r] - mh : -INFINITY;
  }
}

template <int THRL>
__device__ __forceinline__ void attn_unit(int b, int head, int qb, const bf16_t* PJ, const unsigned* MASK, const float* onw, bf16_t* MIX, char* shm) {
  const int tid = threadIdx.x, lane = tid & 63, r32 = lane & 31, hi = lane >> 5; const int wid = __builtin_amdgcn_readfirstlane(tid >> 6);
  const long rowbase = (long)b * SEQ; const int q0 = qb * QB; const int g = head >> 2;
  constexpr int DM = NP;
  const bf16_t* Qw = PJ + (rowbase + q0 + wid * QBLK) * DM + D_QA + head * 64;
  const bf16_t* Kh = PJ + rowbase * DM + D_KA + g * 64; const bf16_t* Vh = PJ + rowbase * DM + D_VA + g * 64;
  const unsigned lds0 = (unsigned)(uintptr_t)shm;
  float* wsf = (float*)(shm + LDS_WS) + wid * 64;
  const bf16_t* ksrc = Kh + (long)lane * DM + wid * 8;
  const bf16_t* vsrc = Vh + (long)(16 * (wid & 3) + (lane >> 2)) * DM + (wid >> 2) * 32 + (lane & 3) * 8;
  const unsigned kdst = lds0 + LDS_K + wid * 1024, vdst = lds0 + LDS_V + wid * 1024;
#define DMA_K(t, slot) glds16(ksrc + (long)(t) * KVBLK * DM, (unsigned)__builtin_amdgcn_readfirstlane(kdst + (slot)))
#define DMA_V(t, slot) glds16(vsrc + (long)(t) * KVBLK * DM, (unsigned)__builtin_amdgcn_readfirstlane(vdst + (slot)))
  const int vb0 = (int)(lds0 + LDS_V) + ((lane >> 4) & 1) * 32 + (lane & 3) * 8 + (4 * hi + ((lane & 15) >> 2)) * 64;
  const char* Kbase = shm + LDS_K; bf16x8 kf[8];
  const lds_cptr shm3 = (lds_cptr)shm; const lds_cptr kp0 = shm3 + LDS_K + hi * 1024 + r32 * 16; const lds_cptr vp0 = shm3 + LDS_V + ((lane >> 4) & 1) * 32 + (lane & 3) * 8 + (4 * hi + ((lane & 15) >> 2)) * 64;
  const lds_cptr mp0 = shm3 + LDS_MASK + wid * 8192 + r32 * 8;
  const int NT = (q0 + QB) / KVBLK;
  {
    const unsigned* mg = MASK + (size_t)(rowbase + q0 + wid * QBLK + r32) * 64;
    __attribute__((address_space(3))) char* mw = (__attribute__((address_space(3))) char*)shm + LDS_MASK + wid * 8192 + r32 * 8;
#pragma unroll 4
    for (int it = 0; it < 16; ++it) {
      const int wp = it * 2 + hi;
      if (wp < NT) { const u32x2 m = *(const u32x2*)(mg + wp * 2); *(__attribute__((address_space(3))) u32x2*)(mw + wp * 256) = m; }
    }
    asm volatile("s_waitcnt vmcnt(0) lgkmcnt(0)" ::: "memory");
  }
  DMA_K(0, 0); DMA_V(0, 0); DMA_K(1, SLOTB);
  bf16x8 qr[4];
#pragma unroll
  for (int d0 = 0; d0 < 4; ++d0) qr[d0] = *reinterpret_cast<const bf16x8*>(&Qw[(long)r32 * DM + d0 * 16 + hi * 8]);
  float mhat = 0.f, l_reg = 0.f; f32x16 o[2]; o[0] = f32x16{}; o[1] = f32x16{}; const f32x16 zc = f32x16{};
#define CMASK(P0, P1, t) maskb(P0, P1, mp0, (t), hi, mhat)
  bool resc = false;
#define START(P0, P1) do { const float rm = max2f(rowmax(P0, P1), -30.f); resc = false; \
    { const float dl = rm; mhat = fadd_s(mhat, dl); \
      _Pragma("unroll") for (int r = 0; r < 16; ++r) { P0[r] = fsub_s(P0[r], dl); P1[r] = fsub_s(P1[r], dl); } } \
    _Pragma("unroll") for (int r = 0; r < 16; ++r) P0[r] = __builtin_amdgcn_exp2f(P0[r]); } while (0)
#define RESC() do { if (resc) { asm volatile("s_waitcnt lgkmcnt(0)" ::: "memory"); \
      _Pragma("unroll") for (int d_ = 0; d_ < 2; ++d_) _Pragma("unroll") for (int r = 0; r < 16; ++r) o[d_][r] *= wsf[crow(r, hi)]; } } while (0)
  f32x16 pA0, pA1, pB0, pB1;
  int sl_prev = 0, sl_cur = 0, sl_next = SLOTB;
#define ROT() do { sl_prev = sl_cur; sl_cur = sl_next; sl_next = (sl_next == (NSLOT - 1) * SLOTB) ? 0 : sl_next + SLOTB; } while (0)
  DMA_K(2, 2 * SLOTB);
  WAIT_BAR(3);
  qkt(pA0, pA1, Kbase, qr, r32, hi); asm volatile("s_nop 15\n\ts_nop 7" : "+v"(pA0), "+v"(pA1)); CMASK(pA0, pA1, 0);
  asm volatile("s_nop 3" : "+v"(pA0), "+v"(pA1));
  START(pA0, pA1);
  _Pragma("unroll") for (int r = 0; r < 16; ++r) pA1[r] = __builtin_amdgcn_exp2f(pA1[r]);
  WAIT_BAR(0);
  DMA_K(3, 0); DMA_V(1, SLOTB);
  ROT();
  kload8(kf, kp0 + sl_cur);
  WAIT_BAR(2);
  s16x4 vlo[8], vhi[8]; u32x4 pw0, pw1, pw2, pw3;
#define PKW(P, B) cvtpk_s(P[B], P[B + 1])
#define PAF(k) __builtin_bit_cast(bf16x8, pw##k)
#define VFR(i) (bf16x8){vlo[i][0], vlo[i][1], vlo[i][2], vlo[i][3], vhi[i][0], vhi[i][1], vhi[i][2], vhi[i][3]}
#define PIN(x) asm volatile("" : "+v"(x))
#define MX3(a, b, c) __builtin_fmaxf(__builtin_fmaxf((a), (b)), (c))
#define GAPA(MF, A0, A1, A2, A3, W0, W1, PW) do { MF; sacc += A0; sacc += A1; sacc += A2; sacc += A3; PIN(sacc); W0; W1; PIN(PW); SBAR(); } while (0)
#define EX(v) __builtin_amdgcn_exp2f(v)
#define GAPB(MF, X, B) do { MF; X[B] = EX(X[B]); X[B + 1] = EX(X[B + 1]); X[B + 2] = EX(X[B + 2]); X[B + 3] = EX(X[B + 3]); PIN(X); SBAR(); } while (0)
#define VRD(i) do { vlo[i] = vtr(vp_ + (((i) >> 2) * 4096 + ((i) & 3) * 1024)); vhi[i] = vtr(vp_ + (((i) >> 2) * 4096 + ((i) & 3) * 1024 + 512)); } while (0)
#define KRD(G, j) do { if (G) { kload2(kf, kp0 + sl_next, j); SBAR(); } } while (0)
#define STEP(C0, C1, P0, P1, t, GK, GV, GL) do { SBAR(); \
    const lds_cptr vp_ = vp0 + sl_prev; \
    VRD(0); SBAR(); float sacc = (P0[0] + P0[1]); \
    GAPA(C0 = __builtin_amdgcn_mfma_f32_32x32x16_bf16(kf[0], qr[0], zc, 0, 0, 0), P0[2], P0[3], P0[4], P0[5],     pw0[0] = PKW(P0, 0), pw0[1] = PKW(P0, 2), pw0); \
    VRD(4); SBAR(); GAPA(C1 = __builtin_amdgcn_mfma_f32_32x32x16_bf16(kf[1], qr[0], zc, 0, 0, 0), P0[6], P0[7], P0[8], P0[9],     pw0[2] = PKW(P0, 4), pw0[3] = PKW(P0, 6), pw0); \
    VRD(1); SBAR(); GAPA(C0 = __builtin_amdgcn_mfma_f32_32x32x16_bf16(kf[2], qr[1], C0, 0, 0, 0),   P0[10], P0[11], P0[12], P0[13], pw1[0] = PKW(P0, 8), pw1[1] = PKW(P0, 10), pw1); \
    VRD(5); SBAR(); GAPA(C1 = __builtin_amdgcn_mfma_f32_32x32x16_bf16(kf[3], qr[1], C1, 0, 0, 0),   P0[14], P0[15], P1[0], P1[1],   pw1[2] = PKW(P0, 12), pw1[3] = PKW(P0, 14), pw1); \
    VRD(2); SBAR(); GAPA(C0 = __builtin_amdgcn_mfma_f32_32x32x16_bf16(kf[4], qr[2], C0, 0, 0, 0),   P1[2], P1[3], P1[4], P1[5],     pw2[0] = PKW(P1, 0), pw2[1] = PKW(P1, 2), pw2); \
    VRD(6); SBAR(); GAPA(C1 = __builtin_amdgcn_mfma_f32_32x32x16_bf16(kf[5], qr[2], C1, 0, 0, 0),   P1[6], P1[7], P1[8], P1[9],     pw2[2] = PKW(P1, 4), pw2[3] = PKW(P1, 6), pw2); \
    VRD(3); SBAR(); GAPA(C0 = __builtin_amdgcn_mfma_f32_32x32x16_bf16(kf[6], qr[3], C0, 0, 0, 0),   P1[10], P1[11], P1[12], P1[13], pw3[0] = PKW(P1, 8), pw3[1] = PKW(P1, 10), pw3); \
    VRD(7); SBAR(); GAPA(C1 = __builtin_amdgcn_mfma_f32_32x32x16_bf16(kf[7], qr[3], C1, 0, 0, 0),   P1[14], P1[15], 0.f, 0.f,       pw3[2] = PKW(P1, 12), pw3[3] = PKW(P1, 14), pw3); \
    l_reg += sacc; \
    if (GK) { DMA_K((t) + 3, sl_cur); } if (GV) { DMA_V((t) + 1, sl_next); } \
    CMASK(C0, C1, t); \
    { float a = MX3(C0[0], C0[1], C1[0]), b_ = MX3(C0[2], C0[3], C1[1]); a = MX3(a, C1[2], C1[3]); \
      _Pragma("unroll") for (int r = 4; r < 16; r += 4) { a = MX3(a, C0[r], C0[r + 1]); b_ = MX3(b_, C0[r + 2], C0[r + 3]); a = MX3(a, C1[r], C1[r + 1]); b_ = MX3(b_, C1[r + 2], C1[r + 3]); } \
      float rm = __builtin_fmaxf(a, b_); { auto rr = __builtin_amdgcn_permlane32_swap(__float_as_uint(rm), __float_as_uint(rm), false, false); rm = __builtin_fmaxf(__uint_as_float(rr[0]), __uint_as_float(rr[1])); } \
      resc = false; \
      if (__builtin_expect(__any(rm > (float)THRL), 0)) { const float dl = __builtin_fmaxf(rm, 0.f); mhat += dl; \
        _Pragma("unroll") for (int r = 0; r < 16; ++r) { C0[r] -= dl; C1[r] -= dl; } \
        const float f = __builtin_amdgcn_exp2f(-dl); l_reg *= f; if (hi == 0) wsf[r32] = f; resc = true; } } \
    SBAR(); \
    GAPB(o[0] = __builtin_amdgcn_mfma_f32_32x32x16_bf16(PAF(0), VFR(0), o[0], 0, 0, 0), C0, 0); \
    GAPB(o[1] = __builtin_amdgcn_mfma_f32_32x32x16_bf16(PAF(0), VFR(4), o[1], 0, 0, 0), C0, 4); \
    KRD(GL, 0); GAPB(o[0] = __builtin_amdgcn_mfma_f32_32x32x16_bf16(PAF(1), VFR(1), o[0], 0, 0, 0), C0, 8); \
    KRD(GL, 1); GAPB(o[1] = __builtin_amdgcn_mfma_f32_32x32x16_bf16(PAF(1), VFR(5), o[1], 0, 0, 0), C0, 12); \
    KRD(GL, 2); GAPB(o[0] = __builtin_amdgcn_mfma_f32_32x32x16_bf16(PAF(2), VFR(2), o[0], 0, 0, 0), C1, 0); \
    KRD(GL, 3); GAPB(o[1] = __builtin_amdgcn_mfma_f32_32x32x16_bf16(PAF(2), VFR(6), o[1], 0, 0, 0), C1, 4); \
    GAPB(o[0] = __builtin_amdgcn_mfma_f32_32x32x16_bf16(PAF(3), VFR(3), o[0], 0, 0, 0), C1, 8); \
    GAPB(o[1] = __builtin_amdgcn_mfma_f32_32x32x16_bf16(PAF(3), VFR(7), o[1], 0, 0, 0), C1, 12); \
    } while (0)
  int t = 1;
  for (; t + 5 < NT; t += 2) {
    STEP(pB0, pB1, pA0, pA1, t, true, true, true);     WAIT_BAR(2); RESC(); ROT();
    STEP(pA0, pA1, pB0, pB1, t + 1, true, true, true); WAIT_BAR(2); RESC(); ROT();
  }
#define ENDW(tt) do { if ((tt) + 3 < NT) { WAIT_BAR(2); } else if ((tt) + 2 < NT) { WAIT_BAR(1); } else { WAIT_BAR(0); } } while (0)
  for (; t + 1 < NT; t += 2) {
    STEP(pB0, pB1, pA0, pA1, t, (t + 3 < NT), (t + 1 < NT), (t + 1 < NT));         ENDW(t);     RESC(); ROT();
    STEP(pA0, pA1, pB0, pB1, t + 1, (t + 4 < NT), (t + 2 < NT), (t + 2 < NT));     ENDW(t + 1); RESC(); ROT();
  }
  STEP(pB0, pB1, pA0, pA1, NT - 1, false, false, false); RESC();
  { float sacc = pB0[0] + pB0[1]; _Pragma("unroll") for (int r = 2; r < 16; ++r) sacc += pB0[r]; _Pragma("unroll") for (int r = 0; r < 16; ++r) sacc += pB1[r]; l_reg += sacc;
    pw0 = (u32x4){PKW(pB0, 0), PKW(pB0, 2), PKW(pB0, 4), PKW(pB0, 6)}; pw1 = (u32x4){PKW(pB0, 8), PKW(pB0, 10), PKW(pB0, 12), PKW(pB0, 14)}; pw2 = (u32x4){PKW(pB1, 0), PKW(pB1, 2), PKW(pB1, 4), PKW(pB1, 6)}; pw3 = (u32x4){PKW(pB1, 8), PKW(pB1, 10), PKW(pB1, 12), PKW(pB1, 14)};
    SBAR(); pv(o, vb0 + sl_cur, PAF(0), PAF(1), PAF(2), PAF(3)); }
#undef PKW
#undef PAF
#undef VFR
#undef PIN
#undef MX3
#undef GAPA
#undef GAPB
#undef EX
#undef VRD
#undef KRD
#undef STEP
#undef ENDW
  { auto rr = __builtin_amdgcn_permlane32_swap(__float_as_uint(l_reg), __float_as_uint(l_reg), false, false); l_reg = __uint_as_float(rr[0]) + __uint_as_float(rr[1]); }
  if (hi == 0) wsf[32 + r32] = l_reg; asm volatile("s_waitcnt lgkmcnt(0)" ::: "memory");
  float rli[16];
#pragma unroll
  for (int r = 0; r < 16; ++r) rli[r] = __builtin_amdgcn_rcpf(wsf[32 + crow(r, hi)]);
  bf16_t* Ow = MIX + (rowbase + q0 + wid * QBLK) * 1024 + head * 64;
  { __hip_bfloat16* stg = (__hip_bfloat16*)(shm + LDS_OST) + wid * 2048;
#pragma unroll
    for (int r = 0; r < 16; ++r) { const int orow = crow(r, hi);
#pragma unroll
      for (int d0 = 0; d0 < 2; ++d0) stg[orow * 64 + d0 * 32 + r32] = __float2bfloat16(o[d0][r] * rli[r]); }
    asm volatile("s_waitcnt lgkmcnt(0)" ::: "memory");
    const int ch = lane & 7;
    const float4 nw0 = *(const float4*)(onw + head * 64 + ch * 8), nw1 = *(const float4*)(onw + head * 64 + ch * 8 + 4);
#pragma unroll
    for (int i = 0; i < 4; ++i) { const int row = i * 8 + (lane >> 3);
      const u32x4 v = *(const u32x4*)(stg + row * 64 + ch * 8);
      float f[8] = {bf_lo(v.x), bf_hi(v.x), bf_lo(v.y), bf_hi(v.y), bf_lo(v.z), bf_hi(v.z), bf_lo(v.w), bf_hi(v.w)};
      float ss = 0.f;
#pragma unroll
      for (int j = 0; j < 8; ++j) ss += f[j] * f[j];
      ss += __shfl_xor(ss, 1); ss += __shfl_xor(ss, 2); ss += __shfl_xor(ss, 4);
      const float rs = rsqrtf(ss * (1.f / 64.f) + 1e-6f);
      u32x4 w; w.x = pk_bf16(f[0] * rs * nw0.x, f[1] * rs * nw0.y); w.y = pk_bf16(f[2] * rs * nw0.z, f[3] * rs * nw0.w);
      w.z = pk_bf16(f[4] * rs * nw1.x, f[5] * rs * nw1.y); w.w = pk_bf16(f[6] * rs * nw1.z, f[7] * rs * nw1.w);
      *(u32x4*)(Ow + (long)row * 1024 + ch * 8) = w; } }
  asm volatile("s_waitcnt lgkmcnt(0)\n\ts_barrier" ::: "memory");
#undef DMA_K
#undef DMA_V
#undef CMASK
#undef START
#undef RESC
#undef ROT
}
#undef SBAR
#undef WAIT_BAR
}


__device__ __forceinline__ void phase6(CQ& q, LDSP char* lds, int tid) {
  CP& p = q.p;
  const int lane = tid & 63, wid = tid >> 6, l31 = lane & 31, hh = lane >> 5;
  const int G = gridDim.x, bid = blockIdx.x;
  const int xcd = bid & 7, lix = bid >> 3, per = G >> 3;
  const int wr = wid >> 2, wc = wid & 3;
  bool pre = false;
  const unsigned lo1024 = Core256::lane_off(tid, 2048u);
  for (int it = lix; it < 16 * 4; it += per) {
    const int tt = xcd + 8 * (it / 4), ct = it % 4;
    const int m0 = tt * 256, n0 = ct * 256;
    Desc2 d;
    d.rbase = (const char*)(q.mixer + (size_t)m0 * 1024); d.rlo = lo1024; d.rstride = 128u * 2048u;
    d.cbase = (const char*)(q.wt_out + (size_t)n0 * 1024); d.clo = lo1024; d.cstride = 128u * 2048u;
    d.nk = 32;
    f32x16 acc[4][2];
#pragma unroll
    for (int a = 0; a < 4; ++a)
#pragma unroll
      for (int b2 = 0; b2 < 2; ++b2)
#pragma unroll
        for (int r = 0; r < 16; ++r) acc[a][b2][r] = 0.f;
    Core256::run(acc, d, lds, tid, pre);
    pre = false;
    if (it + per < 16 * 4) {
      const int it2 = it + per; const int tt2 = xcd + 8 * (it2 / 4), ct2 = it2 % 4;
      Desc2 d2 = d;
      d2.rbase = (const char*)(q.mixer + (size_t)tt2 * 256 * 1024); d2.cbase = (const char*)(q.wt_out + (size_t)ct2 * 256 * 1024);
      Core256::prefetch0(d2, lds, tid);
      pre = true;
    }
    LDSP char* wl = lds + 32768 + wid * 13312;
    const int bb = m0 / SEQ;
#pragma unroll
    for (int ri = 0; ri < 4; ++ri) {
#pragma unroll
      for (int ci = 0; ci < 2; ++ci)
#pragma unroll
        for (int r = 0; r < 16; ++r) {
          const int trow = (r & 3) + 8 * (r >> 2) + 4 * hh;
          *(LDSP float*)(wl + trow * 272 + (ci * 32 + l31) * 4) = acc[ri][ci][r];
        }
      const int erow = lane >> 4, ech = lane & 15;
      const int n = n0 + wc * 64 + ech * 4;
      const float4 g1 = *(const float4*)(p.mod + bb * 6144 + 2048 + n);
#pragma unroll
      for (int i = 0; i < 8; ++i) {
        const int row = erow + 4 * i;
        const f32x4v a4 = *(LDSP const f32x4v*)(wl + row * 272 + ech * 16);
        const size_t tok = (size_t)m0 + wr * 128 + ri * 32 + row;
        const float4 xv = *(const float4*)(p.x + tok * D_MODEL + n);
        *(float4*)(p.out + tok * D_MODEL + n) = make_float4(xv.x + g1.x * a4[0], xv.y + g1.y * a4[1], xv.z + g1.z * a4[2], xv.w + g1.w * a4[3]);
      }
      asm volatile("s_waitcnt lgkmcnt(0)" ::: "memory");
    }
  }
}

__device__ __forceinline__ void phase7(CQ& q, int tid) {
  CP& p = q.p;
  const int lane = tid & 63, wv = tid >> 6;
  const int nwv = gridDim.x * 8;
  for (int t0 = (blockIdx.x * 8 + wv) * 2; t0 < NTOK; t0 += nwv * 2) {
    float4 v[2][4];
#pragma unroll
    for (int u = 0; u < 2; ++u)
#pragma unroll
      for (int i = 0; i < 4; ++i) v[u][i] = *(const float4*)(p.out + (size_t)(t0 + u) * D_MODEL + i * 256 + lane * 4);
#pragma unroll
    for (int u = 0; u < 2; ++u) {
      const int t = t0 + u;
      const int b = t / SEQ;
      float ss = 0.f;
#pragma unroll
      for (int i = 0; i < 4; ++i) ss += v[u][i].x * v[u][i].x + v[u][i].y * v[u][i].y + v[u][i].z * v[u][i].z + v[u][i].w * v[u][i].w;
      ss = wave_sum(ss);
      const float r = rsqrtf(ss / D_MODEL + 1e-6f);
      const float* md = p.mod + b * 6144;
#pragma unroll
      for (int i = 0; i < 4; ++i) {
        const int d = i * 256 + lane * 4;
        const float4 w = *(const float4*)(p.norm2_w + d);
        const float4 sh = *(const float4*)(md + 3072 + d);
        const float4 sc = *(const float4*)(md + 4096 + d);
        u32x2 w2; w2.x = pk_bf16(v[u][i].x * r * w.x * (1.f + sc.x) + sh.x, v[u][i].y * r * w.y * (1.f + sc.y) + sh.y);
        w2.y = pk_bf16(v[u][i].z * r * w.z * (1.f + sc.z) + sh.z, v[u][i].w * r * w.w * (1.f + sc.w) + sh.w);
        *(u32x2*)(q.h2 + (size_t)t * D_MODEL + d) = w2;
        *(unsigned*)(q.h2f8 + (size_t)t * D_MODEL + d) = pk4_fp8(bf_lo(w2.x) * 16.f, bf_hi(w2.x) * 16.f, bf_lo(w2.y) * 16.f, bf_hi(w2.y) * 16.f);
      }

    }
  }
}

#define LROW 260
__device__ __forceinline__ void phase8(CQ& q, LDSP char* lds, int tid) {
  CP& p = q.p;
  const int lane = tid & 63, wid = tid >> 6, l31 = lane & 31, hh = lane >> 5;
  typedef GemmCoreD<4, 2, 3, true> GC;
  const int wr = wid / 2, wc = wid % 2;
  for (int it = blockIdx.x; it < NTOK / 128; it += gridDim.x) {
    const int m0 = it * 128;
    for (int rr = 0; rr < 16; rr += 2) {
      const int t0 = m0 + wid * 16 + rr;
      float4 v[2][4];
#pragma unroll
      for (int u = 0; u < 2; ++u)
#pragma unroll
        for (int i = 0; i < 4; ++i) v[u][i] = *(const float4*)(p.out + (size_t)(t0 + u) * D_MODEL + i * 256 + lane * 4);
#pragma unroll
      for (int u = 0; u < 2; ++u) {
        const int t = t0 + u;
        const int b = t / SEQ;
        float ss = 0.f;
#pragma unroll
        for (int i = 0; i < 4; ++i) ss += v[u][i].x * v[u][i].x + v[u][i].y * v[u][i].y + v[u][i].z * v[u][i].z + v[u][i].w * v[u][i].w;
        ss = wave_sum(ss);
        const float r = rsqrtf(ss / D_MODEL + 1e-6f);
        const float* md = p.mod + b * 6144;
#pragma unroll
        for (int i = 0; i < 4; ++i) {
          const int d = i * 256 + lane * 4;
          const float4 w = *(const float4*)(p.norm2_w + d);
          const float4 sh = *(const float4*)(md + 3072 + d);
          const float4 sc = *(const float4*)(md + 4096 + d);
          u32x2 w2; w2.x = pk_bf16(v[u][i].x * r * w.x * (1.f + sc.x) + sh.x, v[u][i].y * r * w.y * (1.f + sc.y) + sh.y);
          w2.y = pk_bf16(v[u][i].z * r * w.z * (1.f + sc.z) + sh.z, v[u][i].w * r * w.w * (1.f + sc.w) + sh.w);
          *(u32x2*)(q.h2 + (size_t)t * D_MODEL + d) = w2;
          *(unsigned*)(q.h2f8 + (size_t)t * D_MODEL + d) = pk4_fp8(bf_lo(w2.x) * 16.f, bf_hi(w2.x) * 16.f, bf_lo(w2.y) * 16.f, bf_hi(w2.y) * 16.f);
        }
      }
    }
    asm volatile("s_waitcnt vmcnt(0)" ::: "memory");
    __syncthreads();
    const int crow = tid >> 3, cch = tid & 7;
    const bf16_t* rp[4]; const bf16_t* cp[2];
#pragma unroll
    for (int i = 0; i < 4; ++i) rp[i] = q.wt_router + (size_t)(crow + 64 * i) * 1024;
#pragma unroll
    for (int i = 0; i < 2; ++i) cp[i] = q.h2 + (size_t)(m0 + crow + 64 * i) * 1024;
    f32x16 acc[2][2];
#pragma unroll
    for (int a = 0; a < 2; ++a)
#pragma unroll
      for (int b2 = 0; b2 < 2; ++b2)
#pragma unroll
        for (int r = 0; r < 16; ++r) acc[a][b2][r] = 0.f;
    GC::run(acc, rp, cp, 1024, lds, tid);
    LDSP float* L = (LDSP float*)lds;
    LDSP int* REC = (LDSP int*)(lds + 139264);
#pragma unroll
    for (int ci = 0; ci < 2; ++ci) {
      const int tl = wc * 64 + ci * 32 + l31;
#pragma unroll
      for (int ri = 0; ri < 2; ++ri)
#pragma unroll
        for (int g = 0; g < 4; ++g) {
          const int e0 = wr * 64 + ri * 32 + 8 * g + 4 * hh;
          *(LDSP f32x4v*)(L + tl * LROW + e0) = (f32x4v){acc[ri][ci][4 * g], acc[ri][ci][4 * g + 1], acc[ri][ci][4 * g + 2], acc[ri][ci][4 * g + 3]};
        }
    }
    __syncthreads();
    const float4 br = *(const float4*)(p.b_router + lane * 4);
    const unsigned long long ltmask = (1ull << lane) - 1ull;
    for (int k = 0; k < 16; ++k) {
      const int tl = wid * 16 + k;
      const int t = m0 + tl;
      const f32x4v lg = *(LDSP const f32x4v*)(L + tl * LROW + lane * 4);
      float sg[4] = {1.f / (1.f + __expf(-lg[0])), 1.f / (1.f + __expf(-lg[1])), 1.f / (1.f + __expf(-lg[2])), 1.f / (1.f + __expf(-lg[3]))};
      const float bsc[4] = {sg[0] + br.x, sg[1] + br.y, sg[2] + br.z, sg[3] + br.w};
      float m1 = -INFINITY, m2 = -INFINITY;
#pragma unroll
      for (int i = 0; i < 4; ++i) { const float v = bsc[i]; if (v > m1) { m2 = m1; m1 = v; } else if (v > m2) m2 = v; }
#pragma unroll
      for (int o = 1; o < 8; o <<= 1) {
        const float o1 = __shfl_xor(m1, o), o2 = __shfl_xor(m2, o);
        const float n1 = fmaxf(m1, o1), n2 = fmaxf(fminf(m1, o1), fmaxf(m2, o2));
        m1 = n1; m2 = n2;
      }
      const float gs = m1 + m2;
      const int gi = lane >> 3;
      int rank = 0;
#pragma unroll
      for (int j = 0; j < 8; ++j) { const float gj = __uint_as_float(__builtin_amdgcn_readlane(__float_as_uint(gs), j * 8)); rank += (gj > gs || (gj == gs && j < gi)) ? 1 : 0; }
      unsigned u[4];
#pragma unroll
      for (int i = 0; i < 4; ++i) {
        const unsigned bits = __float_as_uint(bsc[i] + 0.0f);
        const unsigned enc = (bits & 0x80000000u) ? ~bits : (bits | 0x80000000u);
        u[i] = (rank < 4) ? enc : 0u;
      }
      unsigned tau = 0u; bool exact = false;
      for (int bit = 31; bit >= 0; --bit) {
        const unsigned cand = tau | (1u << bit);
        int cnt = 0;
#pragma unroll
        for (int i = 0; i < 4; ++i) cnt += __builtin_popcountll(__ballot(u[i] >= cand));
        if (cnt >= 8) { tau = cand; if (cnt == 8) { exact = true; break; } }
      }
      int need = 8;
      if (!exact) { int cgt = 0;
#pragma unroll
        for (int i = 0; i < 4; ++i) cgt += __builtin_popcountll(__ballot(u[i] > tau));
        need = 8 - cgt; }
      bool selb[4]; unsigned long long sb[4];
      {
        unsigned long long tb[4];
#pragma unroll
        for (int i = 0; i < 4; ++i) tb[i] = __ballot(u[i] == tau);
        int tpre = 0;
#pragma unroll
        for (int i = 0; i < 4; ++i) tpre += __builtin_popcountll(tb[i] & ltmask);
#pragma unroll
        for (int i = 0; i < 4; ++i) {
          const bool tie = (u[i] == tau);
          selb[i] = exact ? (u[i] >= tau) : ((u[i] > tau) || (tie && tpre < need));
          tpre += tie ? 1 : 0;
        }
#pragma unroll
        for (int i = 0; i < 4; ++i) sb[i] = __ballot(selb[i]);
      }
      float wsum = 0.f;
#pragma unroll
      for (int i = 0; i < 4; ++i) {
        unsigned long long m = sb[i];
        while (m) { const int l = __builtin_ctzll(m); m &= m - 1ull; wsum += __uint_as_float(__builtin_amdgcn_readlane(__float_as_uint(sg[i]), l)); }
      }
      int kpre = 0;
#pragma unroll
      for (int i = 0; i < 4; ++i) kpre += __builtin_popcountll(sb[i] & ltmask);
      const float wscale = 2.5f / wsum;
#pragma unroll
      for (int i = 0; i < 4; ++i) {
        if (selb[i]) {
          const int e = lane * 4 + i;
          const int tk = t * 8 + kpre;
          p.selw[tk] = sg[i] * wscale;
          REC[tl * 8 + kpre] = e;
          ++kpre;
        }
      }
    }
    __syncthreads();
#pragma unroll
    for (int a2 = 0; a2 < 2; ++a2) {
      const int ai = tid + a2 * NTHR;
      const int e = REC[ai];
      const int slot = atomicAdd(&p.counts[e * 64], 1);
      q.list[(size_t)e * LCAP + slot] = (m0 + (ai >> 3)) * 8 + (ai & 7);
    }
    __syncthreads();
  }
}

template <class F>
__device__ __forceinline__ void conv_tile4(const F& f, int k0, bf16_t* dst, int ldd, int nd0, LDSP float* T, int tid) {
  LDSP char* Tb = (LDSP char*)(T + 64 * 260);
  {
    const int j4 = (tid & 63) * 4;
    int ld; const float* pcol = f(j4, ld);
    float4 v[8];
#pragma unroll
    for (int hh = 0; hh < 8; ++hh) v[hh] = *(const float4*)(pcol + (size_t)(k0 + (tid >> 6) + 8 * hh) * ld);
#pragma unroll
    for (int hh = 0; hh < 8; ++hh) { const int kr = (tid >> 6) + 8 * hh; *(LDSP f32x4v*)(T + kr * 260 + j4) = (f32x4v){v[hh].x, v[hh].y, v[hh].z, v[hh].w}; }
  }
  __syncthreads();
  {
    const int kc = tid >> 6;
#pragma unroll
    for (int pp = 0; pp < 4; ++pp) {
      const int n = (tid & 63) + 64 * pp;
      float v[8];
#pragma unroll
      for (int i = 0; i < 8; ++i) v[i] = T[(kc * 8 + i) * 260 + n];
      u32x4 w; w.x = pk_bf16(v[0], v[1]); w.y = pk_bf16(v[2], v[3]); w.z = pk_bf16(v[4], v[5]); w.w = pk_bf16(v[6], v[7]);
      *(LDSP u32x4*)(Tb + n * 128 + ((kc ^ (n & 7)) << 4)) = w;
    }
  }
  __syncthreads();
  {
    const int ch = tid & 7;
#pragma unroll
    for (int pp = 0; pp < 4; ++pp) {
      const int n = (tid >> 3) + 64 * pp;
      const u32x4 w = *(LDSP const u32x4*)(Tb + n * 128 + ((ch ^ (n & 7)) << 4));
      *(u32x4*)(dst + (size_t)(nd0 + n) * ldd + k0 + ch * 8) = w;
    }
  }
  __syncthreads();
}

template <class F>
__device__ __forceinline__ void conv_tile4_fp8(const F& f, int k0, unsigned char* dst, int ldd, int nd0, float scale, LDSP float* T, int tid) {
  LDSP char* Tb = (LDSP char*)(T + 64 * 260);
  {
    const int j4 = (tid & 63) * 4;
    int ld; const float* pcol = f(j4, ld);
    float4 v[8];
#pragma unroll
    for (int hh = 0; hh < 8; ++hh) v[hh] = *(const float4*)(pcol + (size_t)(k0 + (tid >> 6) + 8 * hh) * ld);
#pragma unroll
    for (int hh = 0; hh < 8; ++hh) { const int kr = (tid >> 6) + 8 * hh; *(LDSP f32x4v*)(T + kr * 260 + j4) = (f32x4v){v[hh].x, v[hh].y, v[hh].z, v[hh].w}; }
  }
  __syncthreads();
  {
    const int kc = tid >> 6;
#pragma unroll
    for (int pp = 0; pp < 4; ++pp) {
      const int n = (tid & 63) + 64 * pp;
      float v[8];
#pragma unroll
      for (int i = 0; i < 8; ++i) v[i] = T[(kc * 8 + i) * 260 + n] * scale;
      *(LDSP u32x2*)(Tb + n * 64 + kc * 8) = (u32x2){pk4_fp8(v[0], v[1], v[2], v[3]), pk4_fp8(v[4], v[5], v[6], v[7])};
    }
  }
  __syncthreads();
  {
    const int ch = tid & 3;
#pragma unroll
    for (int pp = 0; pp < 2; ++pp) {
      const int n = (tid >> 2) + 128 * pp;
      const u32x4 w = *(LDSP const u32x4*)(Tb + n * 64 + ch * 16);
      *(u32x4*)(dst + (size_t)(nd0 + n) * ldd + k0 + ch * 16) = w;
    }
  }
  __syncthreads();
}
struct ConvSrc { const float* p0; const float* p1; int ld; };
__device__ __forceinline__ const float* conv_addr(CP& p, int it, int tid, int& ld, int& k0) {
  const int e = it / 48, r = it % 48;
  const int j4 = (tid & 63) * 4;
  if (r < 32) {
    const int kt = r >> 1, hq = r & 1;
    const float* wg = (e < 256) ? p.we_gate + (size_t)e * 1024 * 256 : p.ws_gate;
    const float* wu = (e < 256) ? p.we_up + (size_t)e * 1024 * 256 : p.ws_up;
    ld = 256; k0 = kt * 64;
    const int hb = hq * 4 + (j4 >> 6), w64 = j4 & 63;
    return (w64 < 32) ? wg + hb * 32 + w64 : wu + hb * 32 + (w64 - 32);
  } else {
    const int r2 = r - 32, kt = r2 >> 2, nq = r2 & 3;
    const float* wdn = (e < 256) ? p.we_down + (size_t)e * 256 * 1024 : p.ws_down;
    ld = 1024; k0 = kt * 64;
    return wdn + nq * 256 + j4;
  }
}
__device__ __forceinline__ void phase0_experts(CQ& q, LDSP char* lds, int tid, int first, int G) {
  CP& p = q.p;
  LDSP float* T = (LDSP float*)lds;
  LDSP char* Tb = (LDSP char*)(T + 64 * 260);
  const int total = 257 * 48;
  int it = first;
  float4 v[8];
  if (it < total) {
    int ld, k0; const float* pc = conv_addr(p, it, tid, ld, k0);
#pragma unroll
    for (int hh = 0; hh < 8; ++hh) v[hh] = *(const float4*)(pc + (size_t)(k0 + (tid >> 6) + 8 * hh) * ld);
  }
  for (; it < total; it += G) {
    const int e = it / 48, r = it % 48;
    {
      const int j4 = (tid & 63) * 4;
#pragma unroll
      for (int hh = 0; hh < 8; ++hh) { const int kr = (tid >> 6) + 8 * hh; *(LDSP f32x4v*)(T + kr * 260 + j4) = (f32x4v){v[hh].x, v[hh].y, v[hh].z, v[hh].w}; }
    }
    if (it + G < total) {
      int ld, k0; const float* pc = conv_addr(p, it + G, tid, ld, k0);
#pragma unroll
      for (int hh = 0; hh < 8; ++hh) v[hh] = *(const float4*)(pc + (size_t)(k0 + (tid >> 6) + 8 * hh) * ld);
    }
    __syncthreads();
    if (r < 32) {
      const int kt = r >> 1, hq = r & 1;
      unsigned char* dst = q.wgu8 + (size_t)e * 512 * 1024;
      {
        const int kc = tid >> 6;
#pragma unroll
        for (int pp = 0; pp < 4; ++pp) {
          const int n = (tid & 63) + 64 * pp;
          float x[8];
#pragma unroll
          for (int i = 0; i < 8; ++i) x[i] = T[(kc * 8 + i) * 260 + n] * 256.f;
          *(LDSP u32x2*)(Tb + n * 64 + kc * 8) = (u32x2){pk4_fp8(x[0], x[1], x[2], x[3]), pk4_fp8(x[4], x[5], x[6], x[7])};
        }
      }
      __syncthreads();
      {
        const int ch = tid & 3;
#pragma unroll
        for (int pp = 0; pp < 2; ++pp) {
          const int n = (tid >> 2) + 128 * pp;
          const u32x4 w = *(LDSP const u32x4*)(Tb + n * 64 + ch * 16);
          *(u32x4*)(dst + (size_t)(hq * 256 + n) * 1024 + kt * 64 + ch * 16) = w;
        }
      }
    } else {
      const int r2 = r - 32, kt = r2 >> 2, nq = r2 & 3;
      unsigned char* dst = q.wd8 + (size_t)e * 1024 * 256;
      {
        const int kc = tid >> 6;
#pragma unroll
        for (int pp = 0; pp < 4; ++pp) {
          const int n = (tid & 63) + 64 * pp;
          float x[8];
#pragma unroll
          for (int i = 0; i < 8; ++i) x[i] = T[(kc * 8 + i) * 260 + n] * 256.f;
          *(LDSP u32x2*)(Tb + n * 64 + kc * 8) = (u32x2){pk4_fp8(x[0], x[1], x[2], x[3]), pk4_fp8(x[4], x[5], x[6], x[7])};
        }
      }
      __syncthreads();
      {
        const int ch = tid & 3;
#pragma unroll
        for (int pp = 0; pp < 2; ++pp) {
          const int n = (tid >> 2) + 128 * pp;
          const u32x4 w = *(LDSP const u32x4*)(Tb + n * 64 + ch * 16);
          *(u32x4*)(dst + (size_t)(nq * 256 + n) * 256 + kt * 64 + ch * 16) = w;
        }
      }
    }
    __syncthreads();
  }
}

struct ExpItem { int e, base, nrows; };
template <bool SHARED>
__device__ __forceinline__ void exp_desc(CQ& q, const ExpItem& u, int sub, int tid, RunDesc& d) {
  const int crow = tid >> 3, cch = tid & 7;
  const unsigned sc16 = (unsigned)((cch ^ ((crow >> 1) & 7)) << 4);
  if (sub < 2) {
    d.rbase = (const char*)(q.wgu8 + ((size_t)u.e * 512 + sub * 256) * 1024); d.rstride = 64u * 1024u;
    d.rlo = (unsigned)crow * 1024u + sc16;
    d.cbase = (const char*)q.h2f8;
    unsigned lo[2];
#pragma unroll
    for (int i = 0; i < 2; ++i) {
      const int row = crow + 64 * i;
      int tokr;
      if (SHARED) tokr = u.base + row;
      else { const int rr = row < u.nrows ? row : 0; tokr = q.list[(size_t)u.e * LCAP + u.base + rr] >> 3; }
      lo[i] = (unsigned)tokr * 1024u + sc16;
    }
    d.clo0 = lo[0]; d.clo1 = lo[1];
    d.nk = 8; d.sc1 = false; d.fp8 = true; d.bscale = 0x7B7B7B7B;
  } else {
    d.rbase = (const char*)(q.wd8 + ((size_t)u.e * 1024 + (sub - 2) * 256) * 256); d.rstride = 64u * 256u;
    d.rlo = (unsigned)crow * 256u + sc16;
    d.cbase = (const char*)(q.actg + (size_t)blockIdx.x * 128 * 256);
    d.clo0 = (unsigned)crow * 256u + sc16; d.clo1 = d.clo0 + 64u * 256u;
    d.nk = 2; d.sc1 = true; d.fp8 = true; d.bscale = 0x7D7D7D7D;
  }
}

template <bool SHARED, class GetItem>
__device__ __forceinline__ void expert_phase(CQ& q, LDSP char* lds, int tid, const GetItem& get_item) {
  CP& p = q.p;
  const int lane = tid & 63, wid = tid >> 6, l31 = lane & 31, hh = lane >> 5;
  const int wr = wid / 2, wc = wid % 2;
  const int crow = tid >> 3;
  ExpItem cur, nxt;
  int r = 0;
  if (!get_item(0, cur)) return;
  int st = 0, pre = 0;
  const int erow = lane >> 3, ech = lane & 7;
  for (;;) {
    const bool has_next = get_item(r + 1, nxt);
    int ent_l = -1; float w_l = 0.f;
    if (!SHARED) {
      const int rowl = wc * 64 + lane;
      if (rowl < cur.nrows) { ent_l = q.list[(size_t)cur.e * LCAP + cur.base + rowl]; w_l = p.selw[ent_l]; }
    }

#pragma unroll 1
    for (int sub = 0; sub < 6; ++sub) {
      RunDesc d;
      exp_desc<SHARED>(q, cur, sub, tid, d);
      f32x16 acc[2][2];
#pragma unroll
      for (int a = 0; a < 2; ++a)
#pragma unroll
        for (int b2 = 0; b2 < 2; ++b2)
#pragma unroll
          for (int rr = 0; rr < 16; ++rr) acc[a][b2][rr] = 0.f;
      auto next = [&](RunDesc& dn) -> bool {
        if (sub == 1) return false;
        if (sub < 5) { exp_desc<SHARED>(q, cur, sub + 1, tid, dn); return true; }
        if (has_next) { exp_desc<SHARED>(q, nxt, 0, tid, dn); return true; }
        return false;
      };
      StreamCore::run_stream<true>(acc, d, next, sub == 2, lds, tid, st, pre);
      LDSP char* wl = StreamCore::free_stage(lds, st) + wid * 6144;
      if (sub < 2) {
        const int hb = sub * 4 + wr;
#pragma unroll
        for (int ci = 0; ci < 2; ++ci) {
          const int row = ci * 32 + l31;
#pragma unroll
          for (int g = 0; g < 4; ++g) {
            float a4[4];
#pragma unroll
            for (int j = 0; j < 4; ++j) { const float gt = acc[0][ci][4 * g + j], up = acc[1][ci][4 * g + j]; a4[j] = silu_fast(gt) * up * 4.f; }
            *(LDSP unsigned*)(wl + row * 32 + ((((g >> 1) ^ (row >> 1)) & 1) << 4) + (g & 1) * 8 + 4 * hh) = pk4_fp8(a4[0], a4[1], a4[2], a4[3]);
          }
        }
        const int srow = lane >> 1, sch = lane & 1;
#pragma unroll
        for (int i = 0; i < 2; ++i) {
          const int row = srow + 32 * i;
          const u32x4 v = *(LDSP const u32x4*)(wl + row * 32 + (((sch ^ (row >> 1)) & 1) << 4));
          *(u32x4*)(q.actg + ((size_t)blockIdx.x * 128 + wc * 64 + row) * 256 + hb * 32 + sch * 16) = v;
        }
      } else {
        const int np = sub - 2;
        float wlw[2] = {1.f, 1.f};
        if (!SHARED) { wlw[0] = __shfl(w_l, l31); wlw[1] = __shfl(w_l, 32 + l31); }

        const int n0 = np * 256 + wr * 64 + ech * 8;
        if (!SHARED) {
#pragma unroll
          for (int ci = 0; ci < 2; ++ci) {
            const int row = ci * 32 + l31; const int sw2 = (row >> 1) & 3;
            const float ws = wlw[ci] * 64.f;
#pragma unroll
            for (int ri = 0; ri < 2; ++ri)
#pragma unroll
              for (int g = 0; g < 4; ++g) {
                const f32x16& a = acc[ri][ci];
                *(LDSP unsigned*)(wl + row * 64 + (((ri * 2 + (g >> 1)) ^ sw2) << 4) + (g & 1) * 8 + 4 * hh) = pk4_fp8(a[4 * g + 0] * ws, a[4 * g + 1] * ws, a[4 * g + 2] * ws, a[4 * g + 3] * ws);
              }
          }
          const int srow = lane >> 2, sch = lane & 3;
          const int nb = np * 256 + wr * 64 + sch * 16;
#pragma unroll
          for (int i = 0; i < 4; ++i) {
            const int row = srow + 16 * i;
            const u32x4 sv = *(LDSP const u32x4*)(wl + row * 64 + ((sch ^ ((row >> 1) & 3)) << 4));
            const int ent = __shfl(ent_l, row);
            if (ent >= 0) *(u32x4*)(q.ybuf + (size_t)ent * 1024 + nb) = sv;
          }
          asm volatile("s_waitcnt lgkmcnt(0)" ::: "memory");
        } else {
#pragma unroll 1
          for (int ci = 0; ci < 2; ++ci) {
            {
              const int row = l31; const int sw2 = (row >> 1) & 7;
#pragma unroll
              for (int ri = 0; ri < 2; ++ri)
#pragma unroll
                for (int g = 0; g < 4; ++g) {
                  const f32x16& a = (ci == 0) ? acc[ri][0] : acc[ri][1];
                  u32x2 w; w.x = pk_bf16(a[4 * g + 0], a[4 * g + 1]); w.y = pk_bf16(a[4 * g + 2], a[4 * g + 3]);
                  *(LDSP u32x2*)(wl + row * 128 + (((ri * 4 + g) ^ sw2) << 4) + 8 * hh) = w;
                }
            }
#pragma unroll 2
            for (int i = 0; i < 4; ++i) {
              const int row = erow + 8 * i;
              const int rowl = wc * 64 + ci * 32 + row;
              const u32x4 sv = *(LDSP const u32x4*)(wl + row * 128 + ((ech ^ ((row >> 1) & 7)) << 4));
              const int tok = cur.base + rowl;
              const int bb = tok / SEQ;
              const float* g2 = p.mod + bb * 6144 + 5120 + n0;
              float* orow = p.out + (size_t)tok * D_MODEL + n0;
              float a8[8] = {bf_lo(sv.x), bf_hi(sv.x), bf_lo(sv.y), bf_hi(sv.y), bf_lo(sv.z), bf_hi(sv.z), bf_lo(sv.w), bf_hi(sv.w)};
              u32x2 yv[8];
#pragma unroll
              for (int k = 0; k < 8; ++k) yv[k] = *(const u32x2*)(q.ybuf + ((size_t)tok * 8 + k) * 1024 + n0);
              const float4 x0 = *(const float4*)(orow), x1 = *(const float4*)(orow + 4);
              const float4 ga = *(const float4*)(g2), gb = *(const float4*)(g2 + 4);
              float r8[8] = {0.f, 0.f, 0.f, 0.f, 0.f, 0.f, 0.f, 0.f};
#pragma unroll
              for (int k = 0; k < 8; ++k) {
                const f32x2v p0 = __builtin_amdgcn_cvt_pk_f32_fp8((int)yv[k].x, false), p1 = __builtin_amdgcn_cvt_pk_f32_fp8((int)yv[k].x, true);
                const f32x2v p2 = __builtin_amdgcn_cvt_pk_f32_fp8((int)yv[k].y, false), p3 = __builtin_amdgcn_cvt_pk_f32_fp8((int)yv[k].y, true);
                r8[0] += p0[0]; r8[1] += p0[1]; r8[2] += p1[0]; r8[3] += p1[1]; r8[4] += p2[0]; r8[5] += p2[1]; r8[6] += p3[0]; r8[7] += p3[1];
              }
#pragma unroll
              for (int j = 0; j < 8; ++j) a8[j] += r8[j] * (1.f / 64.f);
              *(float4*)(orow) = make_float4(x0.x + ga.x * a8[0], x0.y + ga.y * a8[1], x0.z + ga.z * a8[2], x0.w + ga.w * a8[3]);
              *(float4*)(orow + 4) = make_float4(x1.x + gb.x * a8[4], x1.y + gb.y * a8[5], x1.z + gb.z * a8[6], x1.w + gb.w * a8[7]);
            }
            asm volatile("s_waitcnt lgkmcnt(0)" ::: "memory");
          }
        }
      }
    }
    if (!has_next) break;
    cur = nxt; ++r;
  }
  asm volatile("s_waitcnt vmcnt(0) lgkmcnt(0)\n\ts_barrier" ::: "memory");
}

struct RunDesc5 {
  const char* rbase; unsigned rlo, rstride;
  const char* cbase; unsigned clo;
  int nk; bool sc1; int bscale;
};
struct StreamCore5 {
  static constexpr int STAGE = 40960, RB = 32768;
  static __device__ __forceinline__ LDSP char* free_stage(LDSP char* lds, int st) { return lds + ((st + 3) & 3) * STAGE; }
  static __device__ __forceinline__ void issue_tile(const RunDesc5& d, int tile, unsigned dst) {
    const unsigned t64 = (unsigned)tile * 64u;
#pragma unroll
    for (int i = 0; i < 4; ++i) glds16s(d.rbase, d.rlo + (unsigned)i * d.rstride + t64, (unsigned)__builtin_amdgcn_readfirstlane(dst + (unsigned)(i * 8192)));
    if (d.sc1) glds16s_sc1(d.cbase, d.clo + t64, (unsigned)__builtin_amdgcn_readfirstlane(dst + (unsigned)RB));
    else glds16s(d.cbase, d.clo + t64, (unsigned)__builtin_amdgcn_readfirstlane(dst + (unsigned)RB));
  }
  template <class NextF>
  static __device__ __forceinline__ void run_stream(f32x16 (&acc)[4][2], const RunDesc5& d, const NextF& next, bool drain_first,
                                                    LDSP char* lds, int tid, int& st, int& pre) {
    const int lane = tid & 63; const int wid = __builtin_amdgcn_readfirstlane(tid >> 6);
    const int wr = wid >> 1, wc = wid & 1;
    const int l31 = lane & 31, h = lane >> 5, sw2 = (lane >> 2) & 3;
    const unsigned l0 = (unsigned)(uintptr_t)lds + (unsigned)wid * 1024u;
    const int fr_base = (wr * 128 + l31) * 64;
    const int fc_base = RB + (wc * 64 + l31) * 64;
    const int nk = d.nk;
    const bool grp1 = wid >= 4;
    if (pre == 0) {
      if (drain_first) asm volatile("s_waitcnt vmcnt(0) lgkmcnt(0)\n\ts_barrier" ::: "memory");
      else asm volatile("s_waitcnt lgkmcnt(0)\n\ts_barrier" ::: "memory");
      issue_tile(d, 0, l0 + (unsigned)(st * STAGE));
      issue_tile(d, 1, l0 + (unsigned)(((st + 1) & 3) * STAGE));
      issue_tile(d, 2, l0 + (unsigned)(((st + 2) & 3) * STAGE));
      VMW(10);
    } else {
      if (drain_first) asm volatile("s_waitcnt vmcnt(0) lgkmcnt(0)" ::: "memory");
      else asm volatile("s_waitcnt lgkmcnt(0)" ::: "memory");
    }
    if (grp1) asm volatile("s_barrier" ::: "memory");
    bool nvalid = false;
    const int co0 = (((2 * h) ^ sw2) << 4), co1 = (((2 * h + 1) ^ sw2) << 4);
    for (int t = 0; t < nk; ++t) {
      asm volatile("s_barrier" ::: "memory");
      __builtin_amdgcn_sched_barrier(0);
      LDSP char* sp = lds + st * STAGE;
      v8i_t fa[4], fb[2];
#pragma unroll
      for (int ri = 0; ri < 4; ++ri) {
        const v4i_t lo = *(LDSP const v4i_t*)(sp + fr_base + ri * 2048 + co0), hi = *(LDSP const v4i_t*)(sp + fr_base + ri * 2048 + co1);
        fa[ri] = __builtin_shufflevector(lo, hi, 0, 1, 2, 3, 4, 5, 6, 7);
      }
#pragma unroll
      for (int ci = 0; ci < 2; ++ci) {
        const v4i_t lo = *(LDSP const v4i_t*)(sp + fc_base + ci * 2048 + co0), hi = *(LDSP const v4i_t*)(sp + fc_base + ci * 2048 + co1);
        fb[ci] = __builtin_shufflevector(lo, hi, 0, 1, 2, 3, 4, 5, 6, 7);
      }
      const unsigned d3 = l0 + (unsigned)(((st + 3) & 3) * STAGE);
      int ahead;
      if (t + 3 < nk) { issue_tile(d, t + 3, d3); ahead = 2; }
      else {
        RunDesc5 dn;
        if (next(dn)) { issue_tile(dn, t + 3 - nk, d3); nvalid = true; ahead = 2; }
        else ahead = (t + 2 < nk) ? 1 : 0;
      }
      if (ahead == 2) VMW(10); else if (ahead == 1) VMW(5); else VMW(0);
      asm volatile("s_waitcnt lgkmcnt(0)\n\ts_barrier" ::: "memory");
      __builtin_amdgcn_sched_barrier(0);
      __builtin_amdgcn_s_setprio(1);
#pragma unroll
      for (int ri = 0; ri < 4; ++ri)
#pragma unroll
        for (int ci = 0; ci < 2; ++ci)
          acc[ri][ci] = __builtin_amdgcn_mfma_scale_f32_32x32x64_f8f6f4(fa[ri], fb[ci], acc[ri][ci], 0, 0, 0, 0x77777777, 0, d.bscale);
      __builtin_amdgcn_s_setprio(0);
      __builtin_amdgcn_sched_barrier(0);
      st = (st + 1) & 3;
    }
    if (!grp1) asm volatile("s_barrier" ::: "memory");
    pre = nvalid ? 3 : 0;
  }
};

template <bool SHARED>
__device__ __forceinline__ void exp_desc5(CQ& q, const ExpItem& u, int sub, int tid0, RunDesc5& d, int ctok) {
  int tid = tid0; asm volatile("" : "+v"(tid));
  const int row = tid >> 2, pos = tid & 3;
  const unsigned sc16 = (unsigned)((pos ^ ((row >> 2) & 3)) << 4);
  if (sub == 0) {
    d.rbase = (const char*)(q.wgu8 + (size_t)u.e * 512 * 1024); d.rstride = 128u * 1024u; d.rlo = (unsigned)row * 1024u + sc16;
    d.cbase = (const char*)q.h2f8;
    const int tokr = SHARED ? u.base + row : (ctok >> 3);
    d.clo = (unsigned)tokr * 1024u + sc16;
    d.nk = 16; d.sc1 = false; d.bscale = 0x7B7B7B7B;
  } else {
    d.rbase = (const char*)(q.wd8 + ((size_t)u.e * 1024 + (sub - 1) * 512) * 256); d.rstride = 128u * 256u; d.rlo = (unsigned)row * 256u + sc16;
    d.cbase = (const char*)(q.actg + (size_t)blockIdx.x * 128 * 256); d.clo = (unsigned)row * 256u + sc16;
    d.nk = 4; d.sc1 = true; d.bscale = 0x7D7D7D7D;
  }
}

template <bool SHARED, class GetItem>
__device__ __forceinline__ void expert_phase5(CQ& q, LDSP char* lds, int tid, const GetItem& get_item) {
  CP& p = q.p;
  const int lane = tid & 63, wid = __builtin_amdgcn_readfirstlane(tid >> 6);
  const int wr = wid >> 1, wc = wid & 1;
  ExpItem cur, nxt;
  int r = 0;
  if (!get_item(0, cur)) return;
  int st = 0, pre = 0;
  auto load_meta = [&](const ExpItem& u, int& ctok, int& ent) {
    ctok = 0; ent = -1;
    if (!SHARED) {
      const int row = tid >> 2; const int rr = row < u.nrows ? row : 0;
      ctok = q.list[(size_t)u.e * LCAP + u.base + rr];
      const int rowl = wc * 64 + lane;
      if (rowl < u.nrows) ent = q.list[(size_t)u.e * LCAP + u.base + rowl];
    }
  };
  int ctok, ent_l; float w_l = 0.f;
  load_meta(cur, ctok, ent_l);
  if (!SHARED) { if (ent_l >= 0) w_l = p.selw[ent_l]; }
  for (;;) {
    const bool has_next = get_item(r + 1, nxt);
    int ctok_n = 0, ent_n = -1; float w_n = 0.f;
#pragma unroll 1
    for (int sub = 0; sub < 3; ++sub) {
      RunDesc5 d;
      exp_desc5<SHARED>(q, cur, sub, tid, d, ctok);
      f32x16 acc[4][2];
#pragma unroll
      for (int a = 0; a < 4; ++a)
#pragma unroll
        for (int b2 = 0; b2 < 2; ++b2)
#pragma unroll
          for (int rr = 0; rr < 16; ++rr) acc[a][b2][rr] = 0.f;
      auto next = [&](RunDesc5& dn) -> bool {
        if (sub == 0) return false;
        if (sub == 1) { exp_desc5<SHARED>(q, cur, 2, tid, dn, ctok); return true; }
        if (has_next) { exp_desc5<SHARED>(q, nxt, 0, tid, dn, ctok_n); return true; }
        return false;
      };
      StreamCore5::run_stream(acc, d, next, sub == 1, lds, tid, st, pre);
      int lz = lane; asm volatile("" : "+v"(lz));
      const int l31 = lz & 31, hh = lz >> 5, erow = lz >> 3, ech = lz & 7;
      LDSP char* wl = StreamCore5::free_stage(lds, st) + wid * 5120;
      if (sub == 0) {
        if (!SHARED) { if (has_next) load_meta(nxt, ctok_n, ent_n); }
#pragma unroll
        for (int q2 = 0; q2 < 2; ++q2) {
          __builtin_amdgcn_sched_barrier(0);
          const int hb = wr * 2 + q2;
#pragma unroll
          for (int ci = 0; ci < 2; ++ci) {
            __builtin_amdgcn_sched_barrier(0);
            const int row = ci * 32 + l31;
#pragma unroll
            for (int g = 0; g < 4; ++g) {
              float a4[4];
#pragma unroll
              for (int j = 0; j < 4; ++j) { const float gt = acc[2 * q2][ci][4 * g + j], up = acc[2 * q2 + 1][ci][4 * g + j]; a4[j] = silu_fast(gt) * up * 4.f; }
              *(LDSP unsigned*)(wl + row * 32 + ((((g >> 1) ^ (row >> 1)) & 1) << 4) + (g & 1) * 8 + 4 * hh) = pk4_fp8(a4[0], a4[1], a4[2], a4[3]);
            }
          }
          const int srow = lz >> 1, sch = lz & 1;
#pragma unroll
          for (int i = 0; i < 2; ++i) {
            const int row = srow + 32 * i;
            const u32x4 v = *(LDSP const u32x4*)(wl + row * 32 + (((sch ^ (row >> 1)) & 1) << 4));
            *(u32x4*)(q.actg + ((size_t)blockIdx.x * 128 + wc * 64 + row) * 256 + hb * 32 + sch * 16) = v;
          }
          asm volatile("s_waitcnt lgkmcnt(0)" ::: "memory");
        }
        if (!SHARED) { if (ent_n >= 0) w_n = p.selw[ent_n]; }
      } else {
        float wlw[2] = {1.f, 1.f};
        if (!SHARED) { wlw[0] = __shfl(w_l, l31); wlw[1] = __shfl(w_l, 32 + l31); }
#pragma unroll
        for (int hn = 0; hn < 2; ++hn) {
          __builtin_amdgcn_sched_barrier(0);
          const int ncol = (sub - 1) * 512 + wr * 128 + hn * 64;
          if (!SHARED) {
#pragma unroll
            for (int ci = 0; ci < 2; ++ci) {
              __builtin_amdgcn_sched_barrier(0);
              const int row = ci * 32 + l31; const int sw2 = (row >> 1) & 3;
              const float ws = wlw[ci] * 64.f;
#pragma unroll
              for (int ri = 0; ri < 2; ++ri)
#pragma unroll
                for (int g = 0; g < 4; ++g) {
                  const f32x16& a = acc[2 * hn + ri][ci];
                  *(LDSP unsigned*)(wl + row * 64 + (((ri * 2 + (g >> 1)) ^ sw2) << 4) + (g & 1) * 8 + 4 * hh) = pk4_fp8(a[4 * g + 0] * ws, a[4 * g + 1] * ws, a[4 * g + 2] * ws, a[4 * g + 3] * ws);
                }
            }
            const int srow = lz >> 2, sch = lz & 3;
#pragma unroll
            for (int i = 0; i < 4; ++i) {
              const int row = srow + 16 * i;
              const u32x4 sv = *(LDSP const u32x4*)(wl + row * 64 + ((sch ^ ((row >> 1) & 3)) << 4));
              const int ent = __shfl(ent_l, row);
              if (ent >= 0) *(u32x4*)(q.ybuf + (size_t)ent * 1024 + ncol + sch * 16) = sv;
            }
            asm volatile("s_waitcnt lgkmcnt(0)" ::: "memory");
          } else {
            const int n0 = ncol + ech * 8;
#pragma unroll 1
            for (int ci = 0; ci < 2; ++ci) {
              {
                const int row = l31; const int sw2 = (row >> 1) & 7;
#pragma unroll
                for (int ri = 0; ri < 2; ++ri)
#pragma unroll
                  for (int g = 0; g < 4; ++g) {
                    const f32x16& a = (ci == 0) ? acc[2 * hn + ri][0] : acc[2 * hn + ri][1];
                    u32x2 w; w.x = pk_bf16(a[4 * g + 0], a[4 * g + 1]); w.y = pk_bf16(a[4 * g + 2], a[4 * g + 3]);
                    *(LDSP u32x2*)(wl + row * 128 + (((ri * 4 + g) ^ sw2) << 4) + 8 * hh) = w;
                  }
              }
#pragma unroll 1
              for (int i = 0; i < 4; ++i) {
                const int row = erow + 8 * i;
                const int rowl = wc * 64 + ci * 32 + row;
                const u32x4 sv = *(LDSP const u32x4*)(wl + row * 128 + ((ech ^ ((row >> 1) & 7)) << 4));
                const int tok = cur.base + rowl;
                const int bb = tok / SEQ;
                const float* g2 = p.mod + bb * 6144 + 5120 + n0;
                float* orow = p.out + (size_t)tok * D_MODEL + n0;
                float a8[8] = {bf_lo(sv.x), bf_hi(sv.x), bf_lo(sv.y), bf_hi(sv.y), bf_lo(sv.z), bf_hi(sv.z), bf_lo(sv.w), bf_hi(sv.w)};
                u32x2 yv[8];
#pragma unroll
                for (int k = 0; k < 8; ++k) yv[k] = *(const u32x2*)(q.ybuf + ((size_t)tok * 8 + k) * 1024 + n0);
                const float4 x0 = *(const float4*)(orow), x1 = *(const float4*)(orow + 4);
                const float4 ga = *(const float4*)(g2), gb = *(const float4*)(g2 + 4);
                float r8[8] = {0.f, 0.f, 0.f, 0.f, 0.f, 0.f, 0.f, 0.f};
#pragma unroll
                for (int k = 0; k < 8; ++k) {
                  const f32x2v p0 = __builtin_amdgcn_cvt_pk_f32_fp8((int)yv[k].x, false), p1 = __builtin_amdgcn_cvt_pk_f32_fp8((int)yv[k].x, true);
                  const f32x2v p2 = __builtin_amdgcn_cvt_pk_f32_fp8((int)yv[k].y, false), p3 = __builtin_amdgcn_cvt_pk_f32_fp8((int)yv[k].y, true);
                  r8[0] += p0[0]; r8[1] += p0[1]; r8[2] += p1[0]; r8[3] += p1[1]; r8[4] += p2[0]; r8[5] += p2[1]; r8[6] += p3[0]; r8[7] += p3[1];
                }
#pragma unroll
                for (int j = 0; j < 8; ++j) a8[j] += r8[j] * (1.f / 64.f);
                *(float4*)(orow) = make_float4(x0.x + ga.x * a8[0], x0.y + ga.y * a8[1], x0.z + ga.z * a8[2], x0.w + ga.w * a8[3]);
                *(float4*)(orow + 4) = make_float4(x1.x + gb.x * a8[4], x1.y + gb.y * a8[5], x1.z + gb.z * a8[6], x1.w + gb.w * a8[7]);
              }
              asm volatile("s_waitcnt lgkmcnt(0)" ::: "memory");
            }
          }
        }
      }
    }
    if (!has_next) break;
    cur = nxt; ++r; ctok = ctok_n; ent_l = ent_n; w_l = w_n;
  }
  asm volatile("s_waitcnt vmcnt(0) lgkmcnt(0)\n\ts_barrier" ::: "memory");
}

__device__ __forceinline__ void phase9(CQ& q, LDSP char* lds, int tid) {
  CP& p = q.p;
  const int lane = tid & 63;
  const int G = gridDim.x, bid = blockIdx.x;
  const int xcd = bid & 7, lix = bid >> 3, per = G >> 3;
  const int myexp = xcd + 8 * (lane & 31);
  const int cnt = p.counts[myexp * 64];
  const int nt = (cnt + 127) >> 7;
  int incl = nt;
#pragma unroll
  for (int o = 1; o < 32; o <<= 1) { const int v = __shfl_up(incl, o); if ((lane & 31) >= o) incl += v; }
  const int total = __shfl(incl, 31);
  auto get_item = [&](int r, ExpItem& u) -> bool {
    const int it = lix + r * per;
    if (it >= total) return false;
    const unsigned long long bal = __ballot((lane < 32) && (it < incl));
    const int k = __builtin_ctzll(bal);
    u.e = __builtin_amdgcn_readfirstlane(xcd + 8 * k);
    const int inck = __shfl(incl, k), ntk = __shfl(nt, k), cntk = __shfl(cnt, k);
    u.base = __builtin_amdgcn_readfirstlane((it - (inck - ntk)) * 128);
    u.nrows = __builtin_amdgcn_readfirstlane(min(128, cntk - u.base));
    return true;
  };
  expert_phase5<false>(q, lds, tid, get_item);
}
__device__ __forceinline__ void phase10(CQ& q, LDSP char* lds, int tid) {
  const int G = gridDim.x, bid = blockIdx.x;
  auto get_item = [&](int r, ExpItem& u) -> bool {
    const int it = bid + r * G;
    if (it >= NTOK / 128) return false;
    u.e = 256; u.base = it * 128; u.nrows = 128;
    return true;
  };
  expert_phase5<true>(q, lds, tid, get_item);
}

__device__ __forceinline__ void phase4(CQ& q, char* shm) {
  const int G = gridDim.x, bx = blockIdx.x;
  const int lix = bx >> 3;
  const int tid = threadIdx.x;
  if (lix & 1) phase0_experts(q, (LDSP char*)shm, tid, (bx & 7) * (G >> 4) + (lix >> 1), G >> 1);
  volatile LDSP int* sit = (volatile LDSP int*)((LDSP char*)shm + LDS_BYTES - 8);
  const int NU = BATCH * 8 * 8;
  int nxt = 0;
  if (tid == 0) nxt = atomicAdd(q.ictr + 16, 1);
  for (;;) {
    if (tid == 0) *sit = nxt;
    __syncthreads();
    const int u = *sit;
    __syncthreads();
    if (u >= NU) break;
    if (tid == 0) nxt = atomicAdd(q.ictr + 16, 1);
    const int qb = 7 - (u >> 7), bh = u & 127;
    att::attn_unit<8>(bh >> 3, bh & 7, qb, q.proj2, q.p.mask, q.p.attn_out_norm_w, q.mixer, shm);
  }
}

#define XB_TMO      128
#define XB_XCNT(j)  (256  + 64 * (j))
#define XB_XSUB(j)  (1280 + 64 * (j))
#define XB_XGEN(j)  (2304 + 64 * (j))
#define XB_TOP      3328
#define XB_TOPGEN   3392
#define XCD_BAR_WORDS 3456
#define XB_SPIN_CAP (1u << 22)
__device__ __forceinline__ unsigned xb_ld(unsigned* p)              { return __hip_atomic_load(p, __ATOMIC_RELAXED, __HIP_MEMORY_SCOPE_AGENT); }
__device__ __forceinline__ unsigned xb_add(unsigned* p, unsigned v) { return __hip_atomic_fetch_add(p, v, __ATOMIC_RELAXED, __HIP_MEMORY_SCOPE_AGENT); }
__device__ __forceinline__ unsigned xb_xcc_id() { return (unsigned)__builtin_amdgcn_s_getreg((3 << 11) | 20) & 0xFu; }
#define XB_SPIN(cond, bar) do { unsigned _sp = 0; while (cond) { __builtin_amdgcn_s_sleep(1); \
    if ((++_sp & 255u) == 0u) { if (xb_ld(&(bar)[XB_TMO])) break; if (_sp > XB_SPIN_CAP) { atomicAdd(&(bar)[XB_TMO], 1u); break; } } } } while (0)
struct XcdBarrier { unsigned* bar; unsigned x; unsigned* st; };
__device__ __forceinline__ XcdBarrier xcd_barrier_post(unsigned* bar, unsigned* st) {
  XcdBarrier b; b.bar = bar; b.x = xb_xcc_id(); b.st = st;
  if (threadIdx.x == 0) (void)xb_add(&bar[XB_XCNT(b.x)], 1u);
  return b;
}
__device__ __forceinline__ void xcd_barrier_complete(unsigned* bar, unsigned x, unsigned& nloc, unsigned& nx) {
  const unsigned G = gridDim.x * gridDim.y * gridDim.z;
  unsigned sum, cnt, mine, sp = 0u;
  for (;;) {
    sum = 0u; cnt = 0u; mine = 0u;
#pragma unroll
    for (unsigned j = 0; j < 16; ++j) { const unsigned c = xb_ld(&bar[XB_XCNT(j)]); sum += c; cnt += (c > 0u) ? 1u : 0u; mine = (j == x) ? c : mine; }
    if (sum == G) break;
    __builtin_amdgcn_s_sleep(1);
    if ((++sp & 255u) == 0u) { if (xb_ld(&bar[XB_TMO])) break; if (sp > XB_SPIN_CAP) { atomicAdd(&bar[XB_TMO], 1u); break; } }
  }
  nloc = mine > 0u ? mine : 1u; nx = cnt > 0u ? cnt : 1u;
}
__device__ __forceinline__ void xcd_barrier(const XcdBarrier& b) {
  asm volatile("s_waitcnt vmcnt(0)" ::: "memory");
  __syncthreads();
  if (threadIdx.x == 0) {
    unsigned* bar = b.bar;
    __builtin_amdgcn_s_waitcnt(0);
    unsigned nloc = xb_ld(&b.st[0]), nx = xb_ld(&b.st[1]);
    if (nloc == 0u) {
      xcd_barrier_complete(bar, b.x, nloc, nx);
      __hip_atomic_store(&b.st[0], nloc, __ATOMIC_RELAXED, __HIP_MEMORY_SCOPE_AGENT); __hip_atomic_store(&b.st[1], nx, __ATOMIC_RELAXED, __HIP_MEMORY_SCOPE_AGENT);
    }
    const unsigned old = xb_add(&bar[XB_XSUB(b.x)], 1u);
    const unsigned gen = old / nloc;
    if (old + 1u == (gen + 1u) * nloc) {
      __builtin_amdgcn_fence(__ATOMIC_RELEASE, "agent");
      asm volatile("s_waitcnt vmcnt(0)" ::: "memory");
      const unsigned og = xb_add(&bar[XB_TOP], 1u);
      const unsigned tg = og / nx;
      if (og + 1u == (tg + 1u) * nx) xb_add(&bar[XB_TOPGEN], 1u);
      else XB_SPIN(xb_ld(&bar[XB_TOPGEN]) == tg, bar);
      __builtin_amdgcn_fence(__ATOMIC_ACQUIRE, "agent");
      xb_add(&bar[XB_XGEN(b.x)], 1u);
      asm volatile("s_waitcnt vmcnt(0)" ::: "memory");
    } else {
      XB_SPIN(xb_ld(&bar[XB_XGEN(b.x)]) == gen, bar);
      __builtin_amdgcn_fence(__ATOMIC_ACQUIRE, "agent");
      asm volatile("s_waitcnt vmcnt(0)" ::: "memory");
    }
  }
  __syncthreads();
}

__global__ void __launch_bounds__(NTHR, 2) mk(Q qarg) {
  extern __shared__ __attribute__((aligned(16))) char smem[];
  LDSP char* lds = (LDSP char*)smem;
  const int tid = threadIdx.x;
  CQ* qp0 = (CQ*)__builtin_amdgcn_kernarg_segment_ptr();
  const int ph_lo = qp0->ph_lo, ph_hi = qp0->ph_hi;
  const bool multi = (ph_hi - ph_lo) > 1;
  unsigned* bst = qp0->barw + 8192 + 2 * blockIdx.x;
  XcdBarrier bar; bar.bar = qp0->barw; bar.x = 0; bar.st = bst;
  if (multi) bar = xcd_barrier_post(qp0->barw, bst);
#define QPH(name) CQ* name = qp0; asm volatile("" : "+s"(name));
#define IN(k) (ph_lo <= (k) && (k) < ph_hi)
#define GB(k) do { if (multi && IN(k) && IN((k) + 1)) xcd_barrier(bar); } while (0)
  if (IN(0)) { QPH(qa) phase0(*qa, lds, tid); }
  GB(0);
  if (IN(1)) { QPH(qa) phase1(*qa, tid); }
  GB(1);
  if (IN(2)) { QPH(qa) phase2(*qa, lds, tid); }
  GB(2);
  if (IN(3)) { QPH(qa) phase3b(*qa, lds, tid); QPH(qb) phase3(*qb, lds, tid); }
  GB(3);
  if (IN(4)) { QPH(qa) phase4(*qa, smem); }
  GB(4);
  if (IN(5)) { QPH(qa) phase6(*qa, lds, tid); }
  GB(5);
  if (IN(6)) { QPH(qa) phase8(*qa, lds, tid); }
  GB(6);
  if (IN(7)) { QPH(qa) phase9(*qa, lds, tid); }
  GB(7);
  if (IN(8)) { QPH(qa) phase10(*qa, lds, tid); }
}


extern "C" void kernel_launch(void* const* d_in, const int* in_sizes, int n_in, void* d_out, int out_size,
                              void* d_ws, size_t ws_size, hipStream_t stream) {
  P p{};
  p.x = (const float*)d_in[0]; p.c = (const float*)d_in[1]; p.pos = (const int*)d_in[2];
  p.norm1_w = (const float*)d_in[3]; p.norm2_w = (const float*)d_in[4];
  p.w_ada = (const float*)d_in[5]; p.b_ada = (const float*)d_in[6]; p.w_in = (const float*)d_in[7];
  p.q_norm_w = (const float*)d_in[8]; p.k_norm_w = (const float*)d_in[9]; p.attn_out_norm_w = (const float*)d_in[10];
  p.w_gk2 = (const float*)d_in[11]; p.b_gk = (const float*)d_in[12]; p.gla_norm_w = (const float*)d_in[13];
  p.w_out = (const float*)d_in[14]; p.w_router = (const float*)d_in[15]; p.b_router = (const float*)d_in[16];
  p.we_gate = (const float*)d_in[17]; p.we_up = (const float*)d_in[18]; p.we_down = (const float*)d_in[19];
  p.ws_gate = (const float*)d_in[20]; p.ws_up = (const float*)d_in[21]; p.ws_down = (const float*)d_in[22];
  p.out = (float*)d_out;
  char* ws = (char*)d_ws;
  size_t off = 0;
  auto take = [&](size_t bytes) { char* r = ws + off; off += (bytes + 255) & ~(size_t)255; return r; };
  char* ctl = take(131072);
  p.counts = (int*)ctl;
  p.mod = (float*)take((size_t)16 * 6144 * 4);
  Q q{};
  q.barw = (unsigned*)(ctl + 65536 + 4096);
  q.ictr = (int*)(ctl + 65536 + 2048);
  q.wt_in = (bf16_t*)take((size_t)NP * 1024 * 2);
  q.wt_out = (bf16_t*)take((size_t)1024 * 1024 * 2);
  q.rope = (float*)take((size_t)NTOK * 16 * 4);
  q.misc = (float*)take((size_t)NTOK * 32 * 4);
  { const size_t have = (size_t)((char*)q.misc - (char*)q.wt_in) + (size_t)NTOK * 32 * 4; const size_t need = (size_t)256 * 128 * 256 * 2; if (need > have) (void)take(need - have); }
  q.actg = (unsigned char*)q.wt_in;
  q.wt_router = (bf16_t*)take((size_t)256 * 1024 * 2);
  p.selw = (float*)take((size_t)NASSIGN * 4);
  q.list = (int*)take((size_t)256 * LCAP * 4);
  q.wgu8 = (unsigned char*)take((size_t)257 * 512 * 1024);
  q.h2f8 = (unsigned char*)take((size_t)NTOK * 1024);
  q.wd8 = (unsigned char*)take((size_t)257 * 1024 * 256);
  q.h1 = (bf16_t*)take((size_t)NTOK * 1024 * 2);
  q.h2 = q.h1;
  char* big = take((size_t)NASSIGN * 1024 * 2);
  q.ybuf = (unsigned char*)big;
  q.proj2 = (bf16_t*)big;
  p.mask = (unsigned*)(big + (size_t)NTOK * NP * 2);
  q.mixer = (bf16_t*)(big + (size_t)NTOK * NP * 2 + (size_t)NTOK * 64 * 4);
  if (off > ws_size) { fprintf(stderr, "workspace too small: need %zu have %zu\n", off, ws_size); return; }
  q.p = p;
  static bool attr_set = false;
  if (!attr_set) { (void)hipFuncSetAttribute((const void*)mk, hipFuncAttributeMaxDynamicSharedMemorySize, LDS_BYTES); attr_set = true; }
  (void)hipMemsetAsync(ctl, 0, 131072, stream);
  static int n_cu = 0;
  if (!n_cu) { int dev = 0; (void)hipGetDevice(&dev); (void)hipDeviceGetAttribute(&n_cu, hipDeviceAttributeMultiprocessorCount, dev); if (n_cu <= 0) n_cu = 1; }
  if (n_cu >= 256) {
    q.ph_lo = 0; q.ph_hi = 9;
    mk<<<256, NTHR, LDS_BYTES, stream>>>(q);
  } else {
    for (int ph = 0; ph < 9; ++ph) { q.ph_lo = ph; q.ph_hi = ph + 1; mk<<<256, NTHR, LDS_BYTES, stream>>>(q); }
  }
}
```

```cpp
#include <hip/hip_runtime.h>
#include <hip/hip_bf16.h>
#include <cstdio>
#include <cstdint>

#define D_MODEL 1024
#define BATCH 16
#define SEQ 2048
#define NTOK (BATCH * SEQ)
#define IN_WIDTH 2644
#define NEXP 256
#define EDIM 256
#define TOPK 8
#define NASSIGN (NTOK * TOPK)

#define C_QA 0
#define C_KA 512
#define C_VA 640
#define C_QI 768
#define C_KI 1024
#define C_WI 1088
#define C_QG 1092
#define C_KG 1348
#define C_VG 1604
#define C_GK 2116
#define C_GO 2132

struct P {
  const float* x; const float* c; const int* pos; const float* norm1_w; const float* norm2_w;
  const float* w_ada; const float* b_ada; const float* w_in; const float* q_norm_w; const float* k_norm_w;
  const float* attn_out_norm_w; const float* w_gk2; const float* b_gk; const float* gla_norm_w;
  const float* w_out; const float* w_router; const float* b_router;
  const float* we_gate; const float* we_up; const float* we_down;
  const float* ws_gate; const float* ws_up; const float* ws_down;
  float* out;
  float* mod;
  float* bufA;
  float* proj;
  float* h2;
  float* act_s;
  float* rscore;
  float* qa; float* ka; float* qi; float* ki; float* wi; float* log_a;
  float* scores;
  float* act;
  unsigned* mask;
  int* sel; float* selw; int* counts; int* offsets; int* cursor; int* list;
};

__device__ __forceinline__ float silu_f(float v) { return v / (1.f + expf(-v)); }
__device__ __forceinline__ float wave_sum(float v) {
#pragma unroll
  for (int o = 32; o > 0; o >>= 1) v += __shfl_xor(v, o);
  return v;
}
__device__ __forceinline__ float wave_max(float v) {
#pragma unroll
  for (int o = 32; o > 0; o >>= 1) v = fmaxf(v, __shfl_xor(v, o));
  return v;
}

typedef unsigned short bf16_t;
typedef short bf16x8 __attribute__((ext_vector_type(8)));
typedef float f32x16 __attribute__((ext_vector_type(16)));
typedef float f32x4v __attribute__((ext_vector_type(4)));
typedef float f32x2v __attribute__((ext_vector_type(2)));
typedef __bf16 bf16x2v __attribute__((ext_vector_type(2)));
typedef unsigned u32x4 __attribute__((ext_vector_type(4)));
typedef unsigned u32x2 __attribute__((ext_vector_type(2)));
#define LDSP __attribute__((address_space(3)))
#define NTHR 512
#define LCAP 32768
#define LDS_BYTES 163840
#define ATT_C2 (0.125f * 1.4426950408889634f)

#define D_QA 0
#define D_KA 512
#define D_VA 640
#define D_QI 768
#define D_KI 1024
#define D_MISC 1088
#define D_QG 1152
#define D_KG 1408
#define D_VG 1664
#define D_GO 2176
#define NP 2688

__device__ __forceinline__ unsigned pk_bf16(float lo, float hi) { f32x2v v = {lo, hi}; bf16x2v b = __builtin_convertvector(v, bf16x2v); return __builtin_bit_cast(unsigned, b); }
typedef int v8i_t __attribute__((ext_vector_type(8)));
typedef int v4i_t __attribute__((ext_vector_type(4)));
__device__ __forceinline__ unsigned pk4_fp8(float a, float b, float c, float d) {
  a = __builtin_amdgcn_fmed3f(a, -448.f, 448.f); b = __builtin_amdgcn_fmed3f(b, -448.f, 448.f);
  c = __builtin_amdgcn_fmed3f(c, -448.f, 448.f); d = __builtin_amdgcn_fmed3f(d, -448.f, 448.f);
  int w = __builtin_amdgcn_cvt_pk_fp8_f32(a, b, 0, false);
  w = __builtin_amdgcn_cvt_pk_fp8_f32(c, d, w, true);
  return (unsigned)w;
}
__device__ __forceinline__ float bf_lo(unsigned w) { return __uint_as_float(w << 16); }
__device__ __forceinline__ float bf_hi(unsigned w) { return __uint_as_float(w & 0xffff0000u); }

struct Q;
struct Q {
  P p;
  bf16_t* wt_in;
  bf16_t* wt_out;
  bf16_t* wt_router;
  bf16_t* h1;
  float* rope;
  bf16_t* proj2;
  float* misc;
  bf16_t* mixer;
  bf16_t* h2;
  unsigned char* wgu8;
  unsigned char* h2f8;
  unsigned char* wd8;
  unsigned char* ybuf;
  int* list;
  unsigned char* actg;
  bf16_t* x1b;
  unsigned* barw;
  int* ictr;
  int ph_lo, ph_hi;
};
typedef const __attribute__((address_space(4))) Q CQ;
typedef const __attribute__((address_space(4))) P CP;


__device__ __forceinline__ int win_src(int n) {
  if (n < D_MISC) return n;
  if (n < D_MISC + 4) return C_WI + (n - D_MISC);
  if (n < D_MISC + 20) return C_GK + (n - D_MISC - 4);
  if (n < D_QG) return -1;
  if (n < D_VG + 512) return C_QG + (n - D_QG);
  return C_GO + (n - D_GO);
}

template <class F>
__device__ __forceinline__ void conv_tile(const F& f, int k0, bf16_t* dst, int ldd, int nd0, LDSP float* T, int tid, int ktm_rows = 0) {
  {
    const int j4 = (tid & 15) * 4;
    int ld; const float* pcol = f(j4, ld);
#pragma unroll
    for (int hh = 0; hh < 2; ++hh) {
      const int kr = (tid >> 4) + hh * 32;
      float4 v = make_float4(0.f, 0.f, 0.f, 0.f);
      if (pcol) v = *(const float4*)(pcol + (size_t)(k0 + kr) * ld);
      T[kr * 65 + j4 + 0] = v.x; T[kr * 65 + j4 + 1] = v.y; T[kr * 65 + j4 + 2] = v.z; T[kr * 65 + j4 + 3] = v.w;
    }
  }
  __syncthreads();
  {
    const int n = tid >> 3, kc = tid & 7;
    float v[8];
#pragma unroll
    for (int i = 0; i < 8; ++i) v[i] = T[(kc * 8 + i) * 65 + n];
    u32x4 w; w.x = pk_bf16(v[0], v[1]); w.y = pk_bf16(v[2], v[3]); w.z = pk_bf16(v[4], v[5]); w.w = pk_bf16(v[6], v[7]);
    if (ktm_rows) { const int k = k0 + kc * 8; *(u32x4*)(dst + ((size_t)(k >> 5) * ktm_rows + (nd0 + n)) * 32 + (k & 31)) = w; }
    else *(u32x4*)(dst + (size_t)(nd0 + n) * ldd + k0 + kc * 8) = w;
  }
  __syncthreads();
}

struct SrcWin { const float* w; __device__ __forceinline__ const float* operator()(int j4, int& ld) const { ld = IN_WIDTH; return nullptr; } };

__device__ __forceinline__ void phase0(CQ& q, LDSP char* lds, int tid) {
  CP& p = q.p;
  const int G = gridDim.x, bid = blockIdx.x;
  for (int item = bid; item < 192; item += G) {
    LDSP float* cond = (LDSP float*)lds;
    LDSP float* red = (LDSP float*)(lds + 65536);
    for (int i = tid; i < 16 * 1024; i += NTHR) { const int b = i >> 10, k = i & 1023; cond[k * 16 + b] = silu_f(p.c[i]); }
    __syncthreads();
    const int kg = tid >> 5, cl = tid & 31, col = item * 32 + cl;
    float acc[16];
#pragma unroll
    for (int b = 0; b < 16; ++b) acc[b] = 0.f;
    for (int k0 = kg * 64; k0 < kg * 64 + 64; k0 += 16) {
      float wv[16];
#pragma unroll
      for (int u = 0; u < 16; ++u) wv[u] = p.w_ada[(size_t)(k0 + u) * 6144 + col];
#pragma unroll
      for (int u = 0; u < 16; ++u) {
      const int k = k0 + u; const float w = wv[u];
#pragma unroll
      for (int b4 = 0; b4 < 4; ++b4) {
        const f32x4v cv = *(LDSP const f32x4v*)(cond + k * 16 + b4 * 4);
        acc[b4 * 4 + 0] += cv[0] * w; acc[b4 * 4 + 1] += cv[1] * w; acc[b4 * 4 + 2] += cv[2] * w; acc[b4 * 4 + 3] += cv[3] * w;
      }
      }
    }
#pragma unroll
    for (int b = 0; b < 16; ++b) red[(kg * 16 + b) * 32 + cl] = acc[b];
    __syncthreads();
    {
      const int b = tid >> 5, c2 = tid & 31;
      float s2 = 0.f;
#pragma unroll
      for (int g = 0; g < 16; ++g) s2 += red[(g * 16 + b) * 32 + c2];
      p.mod[b * 6144 + item * 32 + c2] = s2 + p.b_ada[item * 32 + c2];
    }
    __syncthreads();
  }
  LDSP float* T = (LDSP float*)lds;
  const int n_in = 16 * 42, n_out = 16 * 16, n_rt = 16 * 4;
  const int total = n_in + n_out + n_rt;
  for (int it = (bid + G - 192 % G) % G; it < total; it += G) {
    if (it < n_in) {
      const int kt = it / 42, nt = it % 42;
      const float* w = p.w_in;
      auto f = [w, nt](int j4, int& ld) -> const float* { ld = IN_WIDTH; const int s = win_src(nt * 64 + j4); return s < 0 ? nullptr : w + s; };
      conv_tile(f, kt * 64, q.wt_in, 1024, nt * 64, T, tid, (nt < 40) ? 2560 : 0);
    } else if (it < n_in + n_out) {
      const int i2 = it - n_in; const int kt = i2 / 16, nt = i2 % 16;
      const float* w = p.w_out;
      auto f = [w, nt](int j4, int& ld) -> const float* { ld = 1024; return w + nt * 64 + j4; };
      conv_tile(f, kt * 64, q.wt_out, 1024, nt * 64, T, tid, 1024);
    } else {
      const int i2 = it - n_in - n_out; const int kt = i2 / 4, nt = i2 % 4;
      const float* w = p.w_router;
      auto f = [w, nt](int j4, int& ld) -> const float* { ld = 256; return w + nt * 64 + j4; };
      conv_tile(f, kt * 64, q.wt_router, 1024, nt * 64, T, tid);
    }
  }
}

__device__ __forceinline__ void phase1(CQ& q, int tid) {
  CP& p = q.p;
  const int lane = tid & 63, wv = tid >> 6;
  const int nwv = gridDim.x * 8;
  for (int tb = (blockIdx.x * 8 + wv) * 16; tb < NTOK; tb += nwv * 16) {
    const float* md = p.mod + (tb / SEQ) * 6144;
    float4 A[4], B[4];
#pragma unroll
    for (int i = 0; i < 4; ++i) {
      const int d = i * 256 + lane * 4;
      const float4 w = *(const float4*)(p.norm1_w + d);
      const float4 sc = *(const float4*)(md + 1024 + d);
      A[i] = make_float4(w.x * (1.f + sc.x), w.y * (1.f + sc.y), w.z * (1.f + sc.z), w.w * (1.f + sc.w));
      B[i] = *(const float4*)(md + 0 + d);
    }
#pragma unroll 1
    for (int r0 = 0; r0 < 16; r0 += 4) {
      const int t0 = tb + r0;
      float4 v[4][4];
#pragma unroll
      for (int u = 0; u < 4; ++u)
#pragma unroll
        for (int i = 0; i < 4; ++i) v[u][i] = *(const float4*)(p.x + (size_t)(t0 + u) * D_MODEL + i * 256 + lane * 4);
#pragma unroll
      for (int u = 0; u < 4; ++u) {
        const int t = t0 + u;
        float ss = 0.f;
#pragma unroll
        for (int i = 0; i < 4; ++i) ss += v[u][i].x * v[u][i].x + v[u][i].y * v[u][i].y + v[u][i].z * v[u][i].z + v[u][i].w * v[u][i].w;
        ss = wave_sum(ss);
        const float r = rsqrtf(ss / D_MODEL + 1e-6f);
#pragma unroll
        for (int i = 0; i < 4; ++i) {
          const int d = i * 256 + lane * 4;
          u32x2 w2; w2.x = pk_bf16(v[u][i].x * r * A[i].x + B[i].x, v[u][i].y * r * A[i].y + B[i].y);
          w2.y = pk_bf16(v[u][i].z * r * A[i].z + B[i].z, v[u][i].w * r * A[i].w + B[i].w);
          *(u32x2*)(q.h1 + (size_t)t * D_MODEL + d) = w2;
        }
        if (lane < 8) {
          const float inv_freq = powf(500000.0f, -(float)lane / 8.0f);
          const float ang = (float)p.pos[t] * inv_freq;
          q.rope[(size_t)t * 16 + lane] = cosf(ang);
          q.rope[(size_t)t * 16 + 8 + lane] = sinf(ang);
        }
      }
    }
  }
}

template <int WR, int WC>
struct GemmCore {
  static constexpr int BR = 64 * WR, BC = 64 * WC;
  static constexpr int STAGE = (BR + BC) * 128;
  static __device__ __forceinline__ void run(f32x16 (&acc)[2][2], const bf16_t* const (&rp)[WR], const bf16_t* const (&cp)[WC],
                                             int K, LDSP char* lds, int tid) {
    static_assert(WR * WC == 8, "8 waves");
    const int lane = tid & 63, wid = tid >> 6;
    const int wr = wid / WC, wc = wid % WC;
    const int crow = tid >> 3, cch = tid & 7;
    const int l31 = lane & 31, h = lane >> 5, sw = (lane >> 1) & 7;
    int wo_r[WR], wo_c[WC];
#pragma unroll
    for (int i = 0; i < WR; ++i) { const int row = crow + 64 * i; wo_r[i] = row * 128 + ((cch ^ ((row >> 1) & 7)) << 4); }
#pragma unroll
    for (int i = 0; i < WC; ++i) { const int row = crow + 64 * i; wo_c[i] = BR * 128 + row * 128 + ((cch ^ ((row >> 1) & 7)) << 4); }
    const int fr_base = (wr * 64 + l31) * 128;
    const int fc_base = BR * 128 + (wc * 64 + l31) * 128;
    u32x4 rreg[WR], creg[WC];
#pragma unroll
    for (int i = 0; i < WR; ++i) rreg[i] = *(const u32x4*)(rp[i]);
#pragma unroll
    for (int i = 0; i < WC; ++i) creg[i] = *(const u32x4*)(cp[i]);
    __syncthreads();
#pragma unroll
    for (int i = 0; i < WR; ++i) *(LDSP u32x4*)(lds + wo_r[i]) = rreg[i];
#pragma unroll
    for (int i = 0; i < WC; ++i) *(LDSP u32x4*)(lds + wo_c[i]) = creg[i];
    __syncthreads();
    const int nk = K >> 6;
    for (int kt = 0; kt < nk; ++kt) {
      const int cur = kt & 1;
      if (kt + 1 < nk) {
#pragma unroll
        for (int i = 0; i < WR; ++i) rreg[i] = *(const u32x4*)(rp[i] + (kt + 1) * 64);
#pragma unroll
        for (int i = 0; i < WC; ++i) creg[i] = *(const u32x4*)(cp[i] + (kt + 1) * 64);
      }
      LDSP char* st = lds + cur * STAGE;
#pragma unroll
      for (int kk = 0; kk < 4; ++kk) {
        const int co = (((kk * 2 + h) ^ sw) << 4);
        bf16x8 fr[2], fc[2];
#pragma unroll
        for (int ri = 0; ri < 2; ++ri) fr[ri] = *(LDSP const bf16x8*)(st + fr_base + ri * 4096 + co);
#pragma unroll
        for (int ci = 0; ci < 2; ++ci) fc[ci] = *(LDSP const bf16x8*)(st + fc_base + ci * 4096 + co);
#pragma unroll
        for (int ri = 0; ri < 2; ++ri)
#pragma unroll
          for (int ci = 0; ci < 2; ++ci) acc[ri][ci] = __builtin_amdgcn_mfma_f32_32x32x16_bf16(fr[ri], fc[ci], acc[ri][ci], 0, 0, 0);
      }
      if (kt + 1 < nk) {
        LDSP char* sn = lds + (cur ^ 1) * STAGE;
#pragma unroll
        for (int i = 0; i < WR; ++i) *(LDSP u32x4*)(sn + wo_r[i]) = rreg[i];
#pragma unroll
        for (int i = 0; i < WC; ++i) *(LDSP u32x4*)(sn + wo_c[i]) = creg[i];
      }
      __syncthreads();
    }
  }
};


__device__ __forceinline__ void glds16g(const void* gsrc, unsigned lds_dst) { unsigned keep;
  asm volatile("s_mov_b32 %0, m0\n\ts_mov_b32 m0, %2\n\ts_nop 0\n\tglobal_load_lds_dwordx4 %1, off\n\ts_mov_b32 m0, %0" : "=&s"(keep) : "v"(gsrc), "s"(lds_dst) : "memory"); }
__device__ __forceinline__ void glds16g_sc1(const void* gsrc, unsigned lds_dst) { unsigned keep;
  asm volatile("s_mov_b32 %0, m0\n\ts_mov_b32 m0, %2\n\ts_nop 0\n\tglobal_load_lds_dwordx4 %1, off sc1\n\ts_mov_b32 m0, %0" : "=&s"(keep) : "v"(gsrc), "s"(lds_dst) : "memory"); }
#define VMW(N) asm volatile("s_waitcnt vmcnt(" #N ")" ::: "memory")
template <int WR, int WC, int NST, bool CSC1 = false>
struct GemmCoreD {
  static constexpr int BR = 64 * WR, BC = 64 * WC;
  static constexpr int STAGE = (BR + BC) * 128;
  static __device__ __forceinline__ void prefetch0(const bf16_t* const (&rrow)[WR], const bf16_t* const (&crw)[WC], LDSP char* lds, int tid) {
    const int wid = __builtin_amdgcn_readfirstlane(tid >> 6);
    const int crow = tid >> 3, cch = tid & 7;
    const int sc8 = (cch ^ ((crow >> 1) & 7)) << 3;
    const unsigned l0 = (unsigned)(uintptr_t)lds + (unsigned)wid * 1024u;
#pragma unroll
    for (int i = 0; i < WR; ++i) glds16g(rrow[i] + sc8, (unsigned)__builtin_amdgcn_readfirstlane(l0 + (unsigned)(i * 8192)));
#pragma unroll
    for (int i = 0; i < WC; ++i) { if (CSC1) glds16g_sc1(crw[i] + sc8, (unsigned)__builtin_amdgcn_readfirstlane(l0 + (unsigned)(BR * 128 + i * 8192))); else glds16g(crw[i] + sc8, (unsigned)__builtin_amdgcn_readfirstlane(l0 + (unsigned)(BR * 128 + i * 8192))); }
  }
  static __device__ __forceinline__ void run(f32x16 (&acc)[2][2], const bf16_t* const (&rrow)[WR], const bf16_t* const (&crw)[WC],
                                             int K, LDSP char* lds, int tid, bool pre = false) {
    static_assert(WR * WC == 8 && WR + WC == 6 && NST == 3, "8 waves, 6 DMA pieces per wave and tile, 3-stage ring");
    const int lane = tid & 63; const int wid = __builtin_amdgcn_readfirstlane(tid >> 6);
    const int wr = wid / WC, wc = wid % WC;
    const int crow = tid >> 3, cch = tid & 7;
    const int l31 = lane & 31, h = lane >> 5, sw = (lane >> 1) & 7;
    const int sc8 = (cch ^ ((crow >> 1) & 7)) << 3;
    const bf16_t* rs[WR]; const bf16_t* cs[WC];
#pragma unroll
    for (int i = 0; i < WR; ++i) rs[i] = rrow[i] + sc8;
#pragma unroll
    for (int i = 0; i < WC; ++i) cs[i] = crw[i] + sc8;
    const unsigned l0 = (unsigned)(uintptr_t)lds + (unsigned)wid * 1024u;
    const int fr_base = (wr * 64 + l31) * 128;
    const int fc_base = BR * 128 + (wc * 64 + l31) * 128;
    const int nk = K >> 6;
    const bool grp1 = wid >= 4;
#define GD_ISSUE(t, st) do { \
      _Pragma("unroll") for (int i = 0; i < WR; ++i) glds16g(rs[i] + (t) * 64, (unsigned)__builtin_amdgcn_readfirstlane(l0 + (unsigned)((st) * STAGE + i * 8192))); \
      _Pragma("unroll") for (int i = 0; i < WC; ++i) { if (CSC1) glds16g_sc1(cs[i] + (t) * 64, (unsigned)__builtin_amdgcn_readfirstlane(l0 + (unsigned)((st) * STAGE + BR * 128 + i * 8192))); else glds16g(cs[i] + (t) * 64, (unsigned)__builtin_amdgcn_readfirstlane(l0 + (unsigned)((st) * STAGE + BR * 128 + i * 8192))); } } while (0)
    asm volatile("s_waitcnt lgkmcnt(0)\n\ts_barrier" ::: "memory");
    if (!pre) GD_ISSUE(0, 0);
    if (nk > 1) { GD_ISSUE(1, 1); VMW(6); } else VMW(0);
    if (grp1) asm volatile("s_barrier" ::: "memory");
    int st = 0;
    for (int t = 0; t < nk; ++t) {
      asm volatile("s_barrier" ::: "memory");
      __builtin_amdgcn_sched_barrier(0);
      LDSP char* sp = lds + st * STAGE;
      bf16x8 fr[4][2], fc[4][2];
#pragma unroll
      for (int kk = 0; kk < 4; ++kk) {
        const int co = (((kk * 2 + h) ^ sw) << 4);
#pragma unroll
        for (int ri = 0; ri < 2; ++ri) fr[kk][ri] = *(LDSP const bf16x8*)(sp + fr_base + ri * 4096 + co);
#pragma unroll
        for (int ci = 0; ci < 2; ++ci) fc[kk][ci] = *(LDSP const bf16x8*)(sp + fc_base + ci * 4096 + co);
      }
      if (t + 2 < nk) { const int s2 = (st >= 1) ? st - 1 : 2; GD_ISSUE(t + 2, s2); VMW(6); }
      else VMW(0);
      asm volatile("s_waitcnt lgkmcnt(0)\n\ts_barrier" ::: "memory");
      __builtin_amdgcn_sched_barrier(0);
      __builtin_amdgcn_s_setprio(1);
#pragma unroll
      for (int kk = 0; kk < 4; ++kk)
#pragma unroll
        for (int ri = 0; ri < 2; ++ri)
#pragma unroll
          for (int ci = 0; ci < 2; ++ci) acc[ri][ci] = __builtin_amdgcn_mfma_f32_32x32x16_bf16(fr[kk][ri], fc[kk][ci], acc[ri][ci], 0, 0, 0);
      __builtin_amdgcn_s_setprio(0);
      __builtin_amdgcn_sched_barrier(0);
      st = (st == 2) ? 0 : st + 1;
    }
    if (!grp1) asm volatile("s_barrier" ::: "memory");
    asm volatile("s_barrier" ::: "memory");
#undef GD_ISSUE
  }

  static __device__ __forceinline__ LDSP char* free_stage(LDSP char* lds, int st) { return lds + ((st >= 1) ? st - 1 : 2) * STAGE; }
};

struct RunDesc {
  const char* rbase; unsigned rstride;
  const char* cbase; unsigned clo0, clo1;
  unsigned rlo; int nk; bool sc1; bool fp8;
  int bscale;
};
__device__ __forceinline__ const char* uni64(const char* p) {
  const unsigned lo = __builtin_amdgcn_readfirstlane((unsigned)(uintptr_t)p), hi = __builtin_amdgcn_readfirstlane((unsigned)((uintptr_t)p >> 32));
  return (const char*)(((uintptr_t)hi << 32) | (uintptr_t)lo);
}
__device__ __forceinline__ void glds16s(const char* sbase, unsigned voff, unsigned lds_dst) { unsigned keep; sbase = uni64(sbase);
  asm volatile("s_mov_b32 %0, m0\n\ts_mov_b32 m0, %3\n\ts_nop 0\n\tglobal_load_lds_dwordx4 %1, %2\n\ts_mov_b32 m0, %0" : "=&s"(keep) : "v"(voff), "s"(sbase), "s"(lds_dst) : "memory"); }
__device__ __forceinline__ void glds16s_sc1(const char* sbase, unsigned voff, unsigned lds_dst) { unsigned keep; sbase = uni64(sbase);
  asm volatile("s_mov_b32 %0, m0\n\ts_mov_b32 m0, %3\n\ts_nop 0\n\tglobal_load_lds_dwordx4 %1, %2 sc1\n\ts_mov_b32 m0, %0" : "=&s"(keep) : "v"(voff), "s"(sbase), "s"(lds_dst) : "memory"); }

struct StreamCore {
  static constexpr int BR = 256, BC = 128, STAGE = (BR + BC) * 128, WC = 2;
  static __device__ __forceinline__ LDSP char* free_stage(LDSP char* lds, int st) { return lds + ((st >= 1) ? st - 1 : 2) * STAGE; }
  static __device__ __forceinline__ void issue_tile(const RunDesc& d, int tile, unsigned dst) {
    const unsigned t128 = (unsigned)tile * 128u;
#pragma unroll
    for (int i = 0; i < 4; ++i) glds16s(d.rbase, d.rlo + (unsigned)i * d.rstride + t128, (unsigned)__builtin_amdgcn_readfirstlane(dst + (unsigned)(i * 8192)));
    if (d.sc1) {
      glds16s_sc1(d.cbase, d.clo0 + t128, (unsigned)__builtin_amdgcn_readfirstlane(dst + (unsigned)(BR * 128)));
      glds16s_sc1(d.cbase, d.clo1 + t128, (unsigned)__builtin_amdgcn_readfirstlane(dst + (unsigned)(BR * 128 + 8192)));
    } else {
      glds16s(d.cbase, d.clo0 + t128, (unsigned)__builtin_amdgcn_readfirstlane(dst + (unsigned)(BR * 128)));
      glds16s(d.cbase, d.clo1 + t128, (unsigned)__builtin_amdgcn_readfirstlane(dst + (unsigned)(BR * 128 + 8192)));
    }
  }
  template <bool F8, class NextF>
  static __device__ __forceinline__ void run_stream(f32x16 (&acc)[2][2], const RunDesc& d, const NextF& next, bool drain_first,
                                                    LDSP char* lds, int tid, int& st, int& pre) {
    const int lane = tid & 63; const int wid = __builtin_amdgcn_readfirstlane(tid >> 6);
    const int wr = wid / WC, wc = wid % WC;
    const int l31 = lane & 31, h = lane >> 5, sw = (lane >> 1) & 7;
    const unsigned l0 = (unsigned)(uintptr_t)lds + (unsigned)wid * 1024u;
    const int fr_base = (wr * 64 + l31) * 128;
    const int fc_base = BR * 128 + (wc * 64 + l31) * 128;
    const int nk = d.nk;
    const bool grp1 = wid >= 4;
    if (pre == 0) {
      if (drain_first) asm volatile("s_waitcnt vmcnt(0) lgkmcnt(0)\n\ts_barrier" ::: "memory");
      else asm volatile("s_waitcnt lgkmcnt(0)\n\ts_barrier" ::: "memory");
      issue_tile(d, 0, l0 + (unsigned)(st * STAGE));
      issue_tile(d, 1, l0 + (unsigned)(((st == 2) ? 0 : st + 1) * STAGE));
      VMW(6);
    } else {
      if (drain_first) asm volatile("s_waitcnt vmcnt(0) lgkmcnt(0)" ::: "memory");
      else asm volatile("s_waitcnt lgkmcnt(0)" ::: "memory");
    }
    if (grp1) asm volatile("s_barrier" ::: "memory");
    bool nvalid = false;
    for (int t = 0; t < nk; ++t) {
      asm volatile("s_barrier" ::: "memory");
      __builtin_amdgcn_sched_barrier(0);
      LDSP char* sp = lds + st * STAGE;
      bf16x8 fr[4][2], fc[4][2];
      v8i_t fa[2][2], fb[2][2];
      if (F8) {
#pragma unroll
        for (int s2 = 0; s2 < 2; ++s2) {
          const int co0 = (((s2 * 4 + 2 * h) ^ sw) << 4), co1 = (((s2 * 4 + 2 * h + 1) ^ sw) << 4);
#pragma unroll
          for (int ri = 0; ri < 2; ++ri) {
            const v4i_t lo = *(LDSP const v4i_t*)(sp + fr_base + ri * 4096 + co0), hi = *(LDSP const v4i_t*)(sp + fr_base + ri * 4096 + co1);
            fa[s2][ri] = __builtin_shufflevector(lo, hi, 0, 1, 2, 3, 4, 5, 6, 7);
          }
#pragma unroll
          for (int ci = 0; ci < 2; ++ci) {
            const v4i_t lo = *(LDSP const v4i_t*)(sp + fc_base + ci * 4096 + co0), hi = *(LDSP const v4i_t*)(sp + fc_base + ci * 4096 + co1);
            fb[s2][ci] = __builtin_shufflevector(lo, hi, 0, 1, 2, 3, 4, 5, 6, 7);
          }
        }
      } else {
#pragma unroll
        for (int kk = 0; kk < 4; ++kk) {
          const int co = (((kk * 2 + h) ^ sw) << 4);
#pragma unroll
          for (int ri = 0; ri < 2; ++ri) fr[kk][ri] = *(LDSP const bf16x8*)(sp + fr_base + ri * 4096 + co);
#pragma unroll
          for (int ci = 0; ci < 2; ++ci) fc[kk][ci] = *(LDSP const bf16x8*)(sp + fc_base + ci * 4096 + co);
        }
      }
      const unsigned d2 = l0 + (unsigned)(((st >= 1) ? st - 1 : 2) * STAGE);
      bool issued = false;
      if (t + 2 < nk) { issue_tile(d, t + 2, d2); issued = true; }
      else {
        RunDesc dn;
        if (next(dn)) { issue_tile(dn, t + 2 - nk, d2); issued = true; nvalid = true; }
      }
      if (issued) VMW(6); else VMW(0);
      asm volatile("s_waitcnt lgkmcnt(0)\n\ts_barrier" ::: "memory");
      __builtin_amdgcn_sched_barrier(0);
      __builtin_amdgcn_s_setprio(1);
      if (F8) {
#pragma unroll
        for (int s2 = 0; s2 < 2; ++s2)
#pragma unroll
          for (int ri = 0; ri < 2; ++ri)
#pragma unroll
            for (int ci = 0; ci < 2; ++ci)
              acc[ri][ci] = __builtin_amdgcn_mfma_scale_f32_32x32x64_f8f6f4(fa[s2][ri], fb[s2][ci], acc[ri][ci], 0, 0, 0, 0x77777777, 0, d.bscale);
      } else {
#pragma unroll
        for (int kk = 0; kk < 4; ++kk)
#pragma unroll
          for (int ri = 0; ri < 2; ++ri)
#pragma unroll
            for (int ci = 0; ci < 2; ++ci) acc[ri][ci] = __builtin_amdgcn_mfma_f32_32x32x16_bf16(fr[kk][ri], fc[kk][ci], acc[ri][ci], 0, 0, 0);
      }
      __builtin_amdgcn_s_setprio(0);
      __builtin_amdgcn_sched_barrier(0);
      st = (st == 2) ? 0 : st + 1;
    }
    if (!grp1) asm volatile("s_barrier" ::: "memory");
    pre = nvalid ? 2 : 0;
  }
};


struct Desc2 { const char* rbase; unsigned rlo, rstride; const char* cbase; unsigned clo, cstride; int nk; unsigned rtile = 64u, ctile = 64u; };
struct Core256 {
  static constexpr int STAGE = 32768;
  static __device__ __forceinline__ unsigned lane_off(int tid, unsigned pitch) { const int row = tid >> 2, pos = tid & 3; return (unsigned)row * pitch + (unsigned)((pos ^ ((row >> 2) & 3)) << 4); }
  static __device__ __forceinline__ void issue_tile(const Desc2& d, int tile, unsigned dst) {
    const unsigned tr = (unsigned)tile * d.rtile, tc = (unsigned)tile * d.ctile;
#pragma unroll
    for (int i = 0; i < 2; ++i) glds16s(d.rbase, d.rlo + (unsigned)i * d.rstride + tr, (unsigned)__builtin_amdgcn_readfirstlane(dst + (unsigned)(i * 8192)));
#pragma unroll
    for (int i = 0; i < 2; ++i) glds16s(d.cbase, d.clo + (unsigned)i * d.cstride + tc, (unsigned)__builtin_amdgcn_readfirstlane(dst + (unsigned)(16384 + i * 8192)));
  }
  static __device__ __forceinline__ void prefetch0(const Desc2& d, LDSP char* lds, int tid) {
    const int wid = __builtin_amdgcn_readfirstlane(tid >> 6);
    issue_tile(d, 0, (unsigned)(uintptr_t)lds + (unsigned)wid * 1024u);
  }
  static __device__ __forceinline__ void run(f32x16 (&acc)[4][2], const Desc2& d, LDSP char* lds, int tid, bool pre) {
    const int lane = tid & 63; const int wid = __builtin_amdgcn_readfirstlane(tid >> 6);
    const int wr = wid >> 2, wc = wid & 3;
    const int l31 = lane & 31, h = lane >> 5, sw2 = (lane >> 2) & 3;
    const unsigned l0 = (unsigned)(uintptr_t)lds + (unsigned)wid * 1024u;
    const int fr_base = (wr * 128 + l31) * 64;
    const int fc_base = 16384 + (wc * 64 + l31) * 64;
    const int nk = d.nk;
    const bool grp1 = wid >= 4;
    asm volatile("s_waitcnt lgkmcnt(0)\n\ts_barrier" ::: "memory");
    if (!pre) issue_tile(d, 0, l0);
    issue_tile(d, 1, l0 + STAGE); VMW(4);
    if (grp1) asm volatile("s_barrier" ::: "memory");
    int st = 0;
    for (int t = 0; t < nk; ++t) {
      asm volatile("s_barrier" ::: "memory");
      __builtin_amdgcn_sched_barrier(0);
      LDSP char* sp = lds + st * STAGE;
      bf16x8 fr[2][4], fc[2][2];
#pragma unroll
      for (int kk = 0; kk < 2; ++kk) {
        const int co = (((kk * 2 + h) ^ sw2) << 4);
#pragma unroll
        for (int ri = 0; ri < 4; ++ri) fr[kk][ri] = *(LDSP const bf16x8*)(sp + fr_base + ri * 2048 + co);
#pragma unroll
        for (int ci = 0; ci < 2; ++ci) fc[kk][ci] = *(LDSP const bf16x8*)(sp + fc_base + ci * 2048 + co);
      }
      if (t + 2 < nk) { const int s2 = (st >= 1) ? st - 1 : 2; issue_tile(d, t + 2, l0 + (unsigned)(s2 * STAGE)); VMW(4); }
      else VMW(0);
      asm volatile("s_waitcnt lgkmcnt(0)\n\ts_barrier" ::: "memory");
      __builtin_amdgcn_sched_barrier(0);
      __builtin_amdgcn_s_setprio(1);
#pragma unroll
      for (int kk = 0; kk < 2; ++kk)
#pragma unroll
        for (int ri = 0; ri < 4; ++ri)
#pragma unroll
          for (int ci = 0; ci < 2; ++ci) acc[ri][ci] = __builtin_amdgcn_mfma_f32_32x32x16_bf16(fr[kk][ri], fc[kk][ci], acc[ri][ci], 0, 0, 0);
      __builtin_amdgcn_s_setprio(0);
      __builtin_amdgcn_sched_barrier(0);
      st = (st == 2) ? 0 : st + 1;
    }
    if (!grp1) asm volatile("s_barrier" ::: "memory");
    asm volatile("s_barrier" ::: "memory");
  }
};

__device__ __forceinline__ void stage_tile(const f32x16 (&acc)[2][2], LDSP char* wl, int lane) {
  const int cl = lane & 31, h = lane >> 5;
#pragma unroll
  for (int ci = 0; ci < 2; ++ci) {
    const int row = ci * 32 + cl; const int sw = (row >> 1) & 7;
#pragma unroll
    for (int ri = 0; ri < 2; ++ri)
#pragma unroll
      for (int g = 0; g < 4; ++g) {
        u32x2 w; w.x = pk_bf16(acc[ri][ci][4 * g + 0], acc[ri][ci][4 * g + 1]); w.y = pk_bf16(acc[ri][ci][4 * g + 2], acc[ri][ci][4 * g + 3]);
        *(LDSP u32x2*)(wl + row * 128 + (((ri * 4 + g) ^ sw) << 4) + 8 * h) = w;
      }
  }
}
__device__ __forceinline__ void read_row(float (&v)[64], LDSP const char* wl, int lane) {
  const int sw = (lane >> 1) & 7;
#pragma unroll
  for (int j = 0; j < 8; ++j) {
    const u32x4 w = *(LDSP const u32x4*)(wl + lane * 128 + ((j ^ sw) << 4));
    v[8 * j + 0] = bf_lo(w.x); v[8 * j + 1] = bf_hi(w.x); v[8 * j + 2] = bf_lo(w.y); v[8 * j + 3] = bf_hi(w.y);
    v[8 * j + 4] = bf_lo(w.z); v[8 * j + 5] = bf_hi(w.z); v[8 * j + 6] = bf_lo(w.w); v[8 * j + 7] = bf_hi(w.w);
  }
}

__device__ __forceinline__ void inproj_epilogue(CQ& q, const f32x16 (&acc)[2][2], int chunk, int mt0, LDSP char* wl, int lane) {
  CP& p = q.p;
    if (chunk == 17) {
      const int cl = lane & 31, h = lane >> 5;
#pragma unroll
      for (int ci = 0; ci < 2; ++ci) {
        float* mrow = q.misc + (size_t)(mt0 + ci * 32 + cl) * 32;
        const f32x16& a = acc[0][ci];
        if (h == 0) {
          *(float4*)(mrow + 0) = make_float4(a[0] * 0.0625f, a[1] * 0.0625f, a[2] * 0.0625f, a[3] * 0.0625f);
          *(float4*)(mrow + 8) = make_float4(a[4], a[5], a[6], a[7]);
          *(float4*)(mrow + 16) = make_float4(a[8], a[9], a[10], a[11]);
        } else {
          *(float4*)(mrow + 4) = make_float4(a[0], a[1], a[2], a[3]);
          *(float4*)(mrow + 12) = make_float4(a[4], a[5], a[6], a[7]);
        }
      }
    } else {
      stage_tile(acc, wl, lane);
      float v[64];
      read_row(v, wl, lane);
      const int tok = mt0 + lane;
      const bool do_norm = chunk < 10;
      const bool do_rope = chunk < 10 || (chunk >= 12 && chunk < 17);
      if (do_norm) {
        const float* nw = (chunk < 8) ? p.q_norm_w : p.k_norm_w;
        float ss = 0.f;
#pragma unroll
        for (int i = 0; i < 64; ++i) ss += v[i] * v[i];
        const float r = rsqrtf(ss * (1.f / 64.f) + 1e-6f);
#pragma unroll
        for (int i = 0; i < 64; ++i) v[i] = v[i] * r * nw[i];
      }
      if (do_rope) {
        const float* rt_ = q.rope + (size_t)tok * 16;
        const float4 c0 = *(const float4*)(rt_), c1 = *(const float4*)(rt_ + 4), s0 = *(const float4*)(rt_ + 8), s1 = *(const float4*)(rt_ + 12);
        const float cs[8] = {c0.x, c0.y, c0.z, c0.w, c1.x, c1.y, c1.z, c1.w};
        const float sn[8] = {s0.x, s0.y, s0.z, s0.w, s1.x, s1.y, s1.z, s1.w};
#pragma unroll
        for (int i = 0; i < 8; ++i) {
          const float x1 = v[i], x2 = v[i + 8];
          v[i] = x1 * cs[i] - x2 * sn[i];
          v[i + 8] = x2 * cs[i] + x1 * sn[i];
        }
      }
      if (chunk < 8) {
#pragma unroll
        for (int i = 0; i < 64; ++i) v[i] *= ATT_C2;
      }
      {
        const int sw2 = (lane >> 1) & 7;
#pragma unroll
        for (int j = 0; j < 8; ++j) {
          u32x4 w; w.x = pk_bf16(v[8 * j], v[8 * j + 1]); w.y = pk_bf16(v[8 * j + 2], v[8 * j + 3]);
          w.z = pk_bf16(v[8 * j + 4], v[8 * j + 5]); w.w = pk_bf16(v[8 * j + 6], v[8 * j + 7]);
          *(LDSP u32x4*)(wl + lane * 128 + ((j ^ sw2) << 4)) = w;
        }
        const int erow = lane >> 3, ech = lane & 7;
#pragma unroll
        for (int i = 0; i < 8; ++i) {
          const int row = erow + 8 * i;
          const u32x4 w = *(LDSP const u32x4*)(wl + row * 128 + ((ech ^ ((row >> 1) & 7)) << 4));
          *(u32x4*)(q.proj2 + (size_t)(mt0 + row) * NP + chunk * 64 + ech * 8) = w;
        }
      }
    }
}

__device__ __forceinline__ void phase2(CQ& q, LDSP char* lds, int tid) {
  const int lane = tid & 63, wid = tid >> 6;
  const int G = gridDim.x, bid = blockIdx.x;
  const int xcd = bid & 7, lix = bid >> 3, per = G >> 3;
  {
    const int wr = wid >> 2, wc = wid & 3;
    int t2a = tid; asm volatile("" : "+v"(t2a));
    const unsigned lo = Core256::lane_off(t2a, 2048u), lo64 = Core256::lane_off(t2a, 64u);
    bool pre = false;
    for (int it = lix; it < 16 * 10; it += per) {
      const int tt = xcd + 8 * (it / 10), ct = it % 10;
      const int m0 = tt * 256;
      Desc2 d;
      d.rbase = (const char*)(q.wt_in + (size_t)ct * 256 * 32); d.rlo = lo64; d.rstride = 128u * 64u; d.rtile = 2560u * 64u;
      d.cbase = (const char*)(q.h1 + (size_t)m0 * 1024); d.clo = lo; d.cstride = 128u * 2048u;
      d.nk = 32;
      f32x16 acc[4][2];
#pragma unroll
      for (int a = 0; a < 4; ++a)
#pragma unroll
        for (int b = 0; b < 2; ++b)
#pragma unroll
          for (int r = 0; r < 16; ++r) acc[a][b][r] = 0.f;
      Core256::run(acc, d, lds, tid, pre);
      pre = false;
      if (it + per < 16 * 10) {
        const int it2 = it + per; const int tt2 = xcd + 8 * (it2 / 10), ct2 = it2 % 10;
        Desc2 d2 = d;
        d2.rbase = (const char*)(q.wt_in + (size_t)ct2 * 256 * 32); d2.cbase = (const char*)(q.h1 + (size_t)tt2 * 256 * 1024);
        Core256::prefetch0(d2, lds, tid);
        pre = true;
      }
      LDSP char* wl = lds + 32768 + wid * 8192;
      const int mt0 = m0 + wc * 64;
      inproj_epilogue(q, *(const f32x16 (*)[2][2])&acc[0], ct * 4 + wr * 2, mt0, wl, lane);
      asm volatile("s_waitcnt lgkmcnt(0)" ::: "memory");
      inproj_epilogue(q, *(const f32x16 (*)[2][2])&acc[2], ct * 4 + wr * 2 + 1, mt0, wl, lane);
    }
  }
  {
    typedef GemmCoreD<2, 4, 3> GC;
    const int wr = wid / 4, wc = wid % 4;
    const int crow = tid >> 3;
    for (int it = lix; it < 16; it += per) {
      const int tt = xcd + 8 * it, rt = 20;
      const int m0 = tt * 256, n0 = rt * 128;
      const bf16_t* rp[2]; const bf16_t* cp[4];
#pragma unroll
      for (int i = 0; i < 2; ++i) rp[i] = q.wt_in + (size_t)(n0 + crow + 64 * i) * 1024;
#pragma unroll
      for (int i = 0; i < 4; ++i) cp[i] = q.h1 + (size_t)(m0 + crow + 64 * i) * 1024;
      f32x16 acc[2][2];
#pragma unroll
      for (int a = 0; a < 2; ++a)
#pragma unroll
        for (int b = 0; b < 2; ++b)
#pragma unroll
          for (int r = 0; r < 16; ++r) acc[a][b][r] = 0.f;
      GC::run(acc, rp, cp, 1024, lds, tid, false);
      inproj_epilogue(q, acc, rt * 2 + wr, m0 + wc * 64, lds + wid * 8192, lane);
    }
  }
}


typedef float f32x4a __attribute__((ext_vector_type(4)));
#define SROW 2052
__device__ __forceinline__ void transpose32(unsigned (&x)[32]) {
#pragma unroll
  for (int k = 0; k < 16; ++k) {
    const unsigned a = x[k], c = x[k + 16];
    x[k] = __builtin_amdgcn_perm(a, c, 0x07060302u); x[k + 16] = __builtin_amdgcn_perm(a, c, 0x05040100u);
  }
#pragma unroll
  for (int k = 0; k < 32; k = (k + 9) & ~8) {
    const unsigned a = x[k], c = x[k + 8];
    x[k] = __builtin_amdgcn_perm(a, c, 0x07030501u); x[k + 8] = __builtin_amdgcn_perm(a, c, 0x06020400u);
  }
  unsigned m = 0x0F0F0F0Fu;
#pragma unroll
  for (int j = 4; j != 0; j >>= 1) {
#pragma unroll
    for (int k = 0; k < 32; k = (k + j + 1) & ~j) {
      const unsigned t = (x[k] ^ (x[k + j] >> j)) & m;
      x[k] ^= t; x[k + j] ^= (t << j);
    }
    m ^= (m << (j >> 1));
  }
}
__device__ __forceinline__ void idx_item(CQ& q, LDSP char* lds, int tid, int b, int qt) {
  CP& p = q.p;
  const int lane = tid & 63, wid = tid >> 6;
  LDSP float* sbuf = (LDSP float*)lds;
  const int q0 = qt * 16;
  const size_t tok0 = (size_t)b * SEQ + q0;
  const int ql = lane & 15, kg = lane >> 4;
  bf16x8 qf[4][2]; float wq[4];
  {
    const bf16_t* qp = q.proj2 + (tok0 + ql) * NP + D_QI + kg * 8;
#pragma unroll
    for (int hd = 0; hd < 4; ++hd)
#pragma unroll
      for (int s2 = 0; s2 < 2; ++s2) qf[hd][s2] = *(const bf16x8*)(qp + hd * 64 + s2 * 32);
    const float4 w4 = *(const float4*)(q.misc + (tok0 + ql) * 32);
    wq[0] = w4.x; wq[1] = w4.y; wq[2] = w4.z; wq[3] = w4.w;
  }
  const int nkt = qt + 1;
  const bf16_t* kbase = q.proj2 + ((size_t)b * SEQ + ql) * NP + D_KI + kg * 8;
  bf16x8 kr0[4], kr1[4];
#pragma unroll
  for (int j = 0; j < 4; ++j) {
    const int kt0 = wid + 8 * j;
    const bf16_t* kp = kbase + (size_t)(kt0 < nkt ? kt0 : 0) * 16 * NP;
    kr0[j] = *(const bf16x8*)(kp); kr1[j] = *(const bf16x8*)(kp + 32);
  }
  for (int kt4 = wid; kt4 < nkt; kt4 += 32) {
#pragma unroll
    for (int j = 0; j < 4; ++j) {
      const int kt = kt4 + 8 * j;
      if (kt < nkt) {
        const bf16x8 k0 = kr0[j], k1 = kr1[j];
        { const int k2t = kt + 32; const bf16_t* kp = kbase + (size_t)(k2t < nkt ? k2t : 0) * 16 * NP; kr0[j] = *(const bf16x8*)(kp); kr1[j] = *(const bf16x8*)(kp + 32); }
        f32x4a sc = {0.f, 0.f, 0.f, 0.f};
#pragma unroll
        for (int hd = 0; hd < 4; ++hd) {
          f32x4a d = {0.f, 0.f, 0.f, 0.f};
          d = __builtin_amdgcn_mfma_f32_16x16x32_bf16(k0, qf[hd][0], d, 0, 0, 0);
          d = __builtin_amdgcn_mfma_f32_16x16x32_bf16(k1, qf[hd][1], d, 0, 0, 0);
#pragma unroll
          for (int jj = 0; jj < 4; ++jj) sc[jj] += wq[hd] * __int_as_float(max(__float_as_int(d[jj]), 0));
        }
        *(LDSP f32x4a*)(sbuf + ql * SROW + kt * 16 + kg * 4) = sc;
      }
    }
  }
  __syncthreads();
  const int qa_ = wid * 2, qb_ = wid * 2 + 1;
  const int ta = q0 + qa_, tb_ = q0 + qb_;
  if (tb_ < 256) {
#pragma unroll
    for (int qq = 0; qq < 2; ++qq) {
      const int t = q0 + wid * 2 + qq;
      const int lo = lane * 32;
      const unsigned w = (t >= lo + 31) ? 0xffffffffu : (t < lo ? 0u : ((2u << (t - lo)) - 1u));
      p.mask[(tok0 + wid * 2 + qq) * 64 + lane] = w;
    }
  } else {
    const int ngr = (tb_ >> 9) + 1;
    LDSP const float* srow_a = sbuf + qa_ * SROW + lane; LDSP const float* srow_b = sbuf + qb_ * SROW + lane;
    asm volatile("" : "+v"(srow_a), "+v"(srow_b));
    auto keyat = [&](int qrow, int t, int i) -> unsigned {
      const int key = lane + 64 * i;
      const float f = ((qrow == qa_) ? srow_a : srow_b)[64 * i] + 0.0f;
      const unsigned bts = __float_as_uint(f);
      const unsigned e = (bts & 0x80000000u) ? ~bts : (bts | 0x80000000u);
      return (key <= t) ? e : 0u;
    };
    auto wsum2 = [&](unsigned x) -> unsigned {
      x += (unsigned)__builtin_amdgcn_update_dpp(0, (int)x, 0xB1, 0xf, 0xf, true);
      x += (unsigned)__builtin_amdgcn_update_dpp(0, (int)x, 0x4E, 0xf, 0xf, true);
      x += (unsigned)__builtin_amdgcn_update_dpp(0, (int)x, 0x124, 0xf, 0xf, true);
      x += (unsigned)__builtin_amdgcn_update_dpp(0, (int)x, 0x128, 0xf, 0xf, true);
      return (unsigned)__builtin_amdgcn_readlane((int)x, 0) + (unsigned)__builtin_amdgcn_readlane((int)x, 16) +
             (unsigned)__builtin_amdgcn_readlane((int)x, 32) + (unsigned)__builtin_amdgcn_readlane((int)x, 48);
    };
    if (ngr >= 2) {
      unsigned Xa[32], Xb[32];
#pragma unroll
      for (int i = 0; i < 32; ++i) { Xa[i] = 0u; Xb[i] = 0u; }
#pragma unroll
      for (int gq = 0; gq < 4; ++gq) {
        if (gq < ngr) {
#pragma unroll
          for (int i = gq * 8; i < gq * 8 + 8; ++i) {
            const unsigned ba = __float_as_uint(srow_a[64 * i] + 0.0f), bb = __float_as_uint(srow_b[64 * i] + 0.0f);
            Xa[i] = ba ^ ((unsigned)((int)ba >> 31) | 0x80000000u); Xb[i] = bb ^ ((unsigned)((int)bb >> 31) | 0x80000000u);
          }
        }
      }
      transpose32(Xa); transpose32(Xb);
      const int cnta = ((ta - lane) >> 6) + 1, cntb = ((tb_ - lane) >> 6) + 1;
      unsigned Ma = (cnta <= 0) ? 0u : (unsigned)(0xffffffff00000000ull >> (cnta > 32 ? 32 : cnta));
      unsigned Mb = (cntb <= 0) ? 0u : (unsigned)(0xffffffff00000000ull >> (cntb > 32 ? 32 : cntb));
      unsigned Gma = 0u, Gmb = 0u;
      unsigned gca = 0u, gcb = 0u; bool exa = false, exb = false;
#pragma unroll
      for (int pl = 0; pl < 32; ++pl) {
        if (!(exa && exb)) {
          const unsigned sa = Ma & Xa[pl], sb2 = Mb & Xb[pl];
          const unsigned tot = wsum2((unsigned)__builtin_popcount(sa) | ((unsigned)__builtin_popcount(sb2) << 16));
          const unsigned na = gca + (tot & 0xffffu), nb = gcb + (tot >> 16);
          if (!exa) { if (na >= 256u) { Ma = sa; exa = (na == 256u); } else { gca = na; Gma |= sa; Ma ^= sa; } }
          if (!exb) { if (nb >= 256u) { Mb = sb2; exb = (nb == 256u); } else { gcb = nb; Gmb |= sb2; Mb ^= sb2; } }
        }
      }
      const unsigned long long ltmask = (1ull << lane) - 1ull;
#pragma unroll
      for (int qq = 0; qq < 2; ++qq) {
        const unsigned Gm = qq ? Gmb : Gma, Mm = qq ? Mb : Ma; const bool exact = qq ? exb : exa;
        const int need = 256 - (int)(qq ? gcb : gca);
        int running = 0; unsigned wout = 0u;
#pragma unroll
        for (int gq = 0; gq < 4; ++gq) {
          if (gq < ngr) {
#pragma unroll
            for (int i = gq * 8; i < gq * 8 + 8; ++i) {
              const unsigned bm = 1u << (31 - i);
              bool selb;
              if (exact) selb = ((Gm | Mm) & bm) != 0u;
              else {
                const bool tie = (Mm & bm) != 0u;
                const unsigned long long tb2 = __ballot(tie);
                const int pre = running + __builtin_popcountll(tb2 & ltmask);
                running += __builtin_popcountll(tb2);
                selb = ((Gm & bm) != 0u) || (tie && pre < need);
              }
              const unsigned long long sb = __ballot(selb);
              if (lane == 2 * i) wout = (unsigned)(sb & 0xffffffffull);
              if (lane == 2 * i + 1) wout = (unsigned)(sb >> 32);
            }
          }
        }
        p.mask[(tok0 + wid * 2 + qq) * 64 + lane] = wout;
      }
    } else {
    unsigned Ha[16], La[16], Hb[16], Lb[16];
#pragma unroll
    for (int j = 0; j < 16; ++j) { Ha[j] = 0u; La[j] = 0u; Hb[j] = 0u; Lb[j] = 0u; }
#pragma unroll
    for (int gq = 0; gq < 4; ++gq) {
      if (gq < ngr) {
#pragma unroll
        for (int j = gq * 4; j < gq * 4 + 4; ++j) {
          const unsigned a0 = keyat(qa_, ta, 2 * j), a1 = keyat(qa_, ta, 2 * j + 1), b0 = keyat(qb_, tb_, 2 * j), b1 = keyat(qb_, tb_, 2 * j + 1);
          Ha[j] = (a0 >> 16) | (a1 & 0xffff0000u); La[j] = (a0 & 0xffffu) | (a1 << 16);
          Hb[j] = (b0 >> 16) | (b1 & 0xffff0000u); Lb[j] = (b0 & 0xffffu) | (b1 << 16);
        }
      }
    }
    unsigned one2 = 0x00010001u; asm volatile("" : "+v"(one2));
    typedef unsigned short us2_t __attribute__((ext_vector_type(2)));
    auto pkc = [&](unsigned acc, unsigned x, unsigned cpk) -> unsigned {
      const us2_t d = __builtin_elementwise_sub_sat(__builtin_bit_cast(us2_t, x), __builtin_bit_cast(us2_t, cpk));
      const us2_t m = __builtin_elementwise_min(d, __builtin_bit_cast(us2_t, one2));
      return __builtin_bit_cast(unsigned, (us2_t)(__builtin_bit_cast(us2_t, acc) + m));
    };
    auto count2 = [&](const unsigned (&A)[16], const unsigned (&B)[16], unsigned cpa, unsigned cpb) -> unsigned {
      unsigned aa = 0u, ab = 0u;
#pragma unroll
      for (int gq = 0; gq < 4; ++gq) {
        if (gq < ngr) {
#pragma unroll
          for (int j = gq * 4; j < gq * 4 + 4; ++j) { aa = pkc(aa, A[j], cpa); ab = pkc(ab, B[j], cpb); }
        }
      }
      const unsigned la = (aa & 0xffffu) + (aa >> 16), lb = (ab & 0xffffu) + (ab >> 16);
      return wsum2(la | (lb << 16));
    };
    unsigned tha = 0u, thb = 0u; bool exa = false, exb = false;
    for (int bit = 15; bit >= 0; --bit) {
      if (exa && exb) break;
      const unsigned ca = tha | (1u << bit), cb = thb | (1u << bit);
      const unsigned tot = count2(Ha, Hb, (ca - 1u) * 0x10001u, (cb - 1u) * 0x10001u);
      const unsigned na = tot & 0xffffu, nb = tot >> 16;
      if (!exa && na >= 256u) { tha = ca; exa = (na == 256u); }
      if (!exb && nb >= 256u) { thb = cb; exb = (nb == 256u); }
    }
    unsigned tla = 0u, tlb = 0u; int needa = 0, needb = 0;
    if (!(exa && exb)) {
      const unsigned gt = count2(Ha, Hb, tha * 0x10001u, thb * 0x10001u);
      const unsigned ga = gt & 0xffffu, gb = gt >> 16;
#pragma unroll
      for (int gq = 0; gq < 4; ++gq) {
        if (gq < ngr) {
#pragma unroll
          for (int j = gq * 4; j < gq * 4 + 4; ++j) {
            unsigned xa = Ha[j] ^ (tha * 0x10001u), xb = Hb[j] ^ (thb * 0x10001u), ma, mb;
            asm("v_pk_min_u16 %0, %1, %2" : "=v"(ma) : "v"(xa), "v"(one2));
            asm("v_pk_min_u16 %0, %1, %2" : "=v"(mb) : "v"(xb), "v"(one2));
            asm("v_pk_sub_u16 %0, %1, %2" : "=v"(ma) : "v"(ma), "v"(one2));
            asm("v_pk_sub_u16 %0, %1, %2" : "=v"(mb) : "v"(mb), "v"(one2));
            La[j] &= ma; Lb[j] &= mb;
          }
        }
      }
      for (int bit = 15; bit >= 0; --bit) {
        if (exa && exb) break;
        const unsigned ca = tla | (1u << bit), cb = tlb | (1u << bit);
        const unsigned tot = count2(La, Lb, (ca - 1u) * 0x10001u, (cb - 1u) * 0x10001u);
        const unsigned na = (tot & 0xffffu) + ga, nb = (tot >> 16) + gb;
        if (!exa && na >= 256u) { tla = ca; exa = (na == 256u); }
        if (!exb && nb >= 256u) { tlb = cb; exb = (nb == 256u); }
      }
      if (!(exa && exb)) {
        const unsigned t2 = count2(La, Lb, tla * 0x10001u, tlb * 0x10001u);
        needa = 256 - (int)((t2 & 0xffffu) + ga); needb = 256 - (int)((t2 >> 16) + gb);
      }
    }
    const unsigned taua = (tha << 16) | tla, taub = (thb << 16) | tlb;
    const unsigned long long ltmask = (1ull << lane) - 1ull;
#pragma unroll
    for (int qq = 0; qq < 2; ++qq) {
      const unsigned tau = qq ? taub : taua; const bool exact = qq ? exb : exa;
      const int qrow = qq ? qb_ : qa_; const int tq = qq ? tb_ : ta;
      const int need = qq ? needb : needa;
      int running = 0; unsigned wout = 0u;
#pragma unroll
      for (int gq = 0; gq < 4; ++gq) {
        if (gq < ngr) {
#pragma unroll
          for (int i = gq * 8; i < gq * 8 + 8; ++i) {
            const unsigned uv = keyat(qrow, tq, i);
            bool selb;
            if (exact) selb = uv >= tau;
            else {
              const bool tie = (uv == tau);
              const unsigned long long tb2 = __ballot(tie);
              const int pre = running + __builtin_popcountll(tb2 & ltmask);
              running += __builtin_popcountll(tb2);
              selb = (uv > tau) || (tie && pre < need);
            }
            const unsigned long long sb = __ballot(selb);
            if (lane == 2 * i) wout = (unsigned)(sb & 0xffffffffull);
            if (lane == 2 * i + 1) wout = (unsigned)(sb >> 32);
          }
        }
      }
      p.mask[(tok0 + wid * 2 + qq) * 64 + lane] = wout;
    }
    }
  }
  __syncthreads();
}
__device__ __forceinline__ void phase3(CQ& q, LDSP char* lds, int tid) {
  volatile LDSP int* sit = (volatile LDSP int*)(lds + LDS_BYTES - 8);
  int nxt = 0;
  if (tid == 0) nxt = atomicAdd(q.ictr, 1);
  for (;;) {
    if (tid == 0) *sit = nxt;
    __syncthreads();
    const int it = *sit;
    __syncthreads();
    if (it >= BATCH * 128) break;
    if (tid == 0) nxt = atomicAdd(q.ictr, 1);
    const int qt = 127 - (it >> 4), b = it & 15;
    idx_item(q, lds, tid, b, qt);
  }
}

__device__ __forceinline__ int toff(int row, int chunk) { return row * 128 + ((chunk ^ ((row >> 1) & 7)) << 4); }
__device__ __forceinline__ bf16x8 frag(LDSP const char* base, int row0, int kk, int l31, int h) {
  const int row = row0 + l31;
  return *(LDSP const bf16x8*)(base + row * 128 + ((((kk * 2 + h)) ^ ((row >> 1) & 7)) << 4));
}
__device__ __forceinline__ float bfu(unsigned short v) { return __uint_as_float((unsigned)v << 16); }

__device__ __forceinline__ float silu_fast(float v) { return v * __builtin_amdgcn_rcpf(1.f + __expf(-v)); }
__device__ __forceinline__ void gla_unit(CQ& q, LDSP char* lds, int tid, int b, int h) {
  CP& p = q.p;
  const int lane = tid & 63, wid = tid >> 6, l31 = lane & 31, hh = lane >> 5;
  LDSP float* W2S = (LDSP float*)(lds);
  LDSP float* BG = W2S + 1024;
  LDSP float* GB = (LDSP float*)(lds + 4352);
  LDSP float* SEG = (LDSP float*)(lds + 20736);
  LDSP float* DEC = (LDSP float*)(lds + 22784);
  LDSP float* SSQ = (LDSP float*)(lds + 23040);
  LDSP char* QT = lds + 24064;
  LDSP char* KT = lds + 32256;
  LDSP char* KRAW = lds + 40448;
  LDSP char* KH = lds + 48640;
  LDSP char* VRAW = lds + 56832;
  LDSP char* VT = lds + 73216;
  LDSP char* AM = lds + 89600;
  LDSP char* ST = lds + 97792;
  LDSP char* OST = lds + 114176;
  const int t = tid >> 3, c8 = tid & 7;
  __syncthreads();
  for (int i = tid; i < 1024; i += NTHR) W2S[i] = p.w_gk2[(i >> 6) * 256 + h * 64 + (i & 63)];
  if (tid < 64) BG[tid] = p.b_gk[h * 64 + tid];
  for (int i = tid; i < 4096; i += NTHR) ((LDSP unsigned*)ST)[i] = 0u;
  f32x16 Sacc[2];
#pragma unroll
  for (int r = 0; r < 16; ++r) { Sacc[0][r] = 0.f; Sacc[1][r] = 0.f; }
  const size_t tokb = (size_t)b * SEQ;
  u32x4 rq, rk, rv[2], rgo[2]; float4 rgk[4];
  {
    const size_t tok = tokb + t;
    const bf16_t* pr = q.proj2 + tok * NP;
    rq = *(const u32x4*)(pr + D_QG + h * 64 + c8 * 8);
    rk = *(const u32x4*)(pr + D_KG + h * 64 + c8 * 8);
    rv[0] = *(const u32x4*)(pr + D_VG + h * 128 + c8 * 8);
    rv[1] = *(const u32x4*)(pr + D_VG + h * 128 + 64 + c8 * 8);
    rgo[0] = *(const u32x4*)(pr + D_GO + h * 128 + c8 * 8);
    rgo[1] = *(const u32x4*)(pr + D_GO + h * 128 + 64 + c8 * 8);
#pragma unroll
    for (int i = 0; i < 4; ++i) rgk[i] = *(const float4*)(q.misc + tok * 32 + 4 + 4 * i);
  }
  __syncthreads();
  for (int c = 0; c < SEQ / 64; ++c) {
    const size_t tok = tokb + c * 64 + t;
    {
      const float gk[16] = {rgk[0].x, rgk[0].y, rgk[0].z, rgk[0].w, rgk[1].x, rgk[1].y, rgk[1].z, rgk[1].w,
                            rgk[2].x, rgk[2].y, rgk[2].z, rgk[2].w, rgk[3].x, rgk[3].y, rgk[3].z, rgk[3].w};
      float z[8];
#pragma unroll
      for (int j = 0; j < 8; ++j) z[j] = BG[c8 * 8 + j];
#pragma unroll
      for (int r = 0; r < 16; ++r) {
        const f32x4v w0 = *(LDSP const f32x4v*)(W2S + r * 64 + c8 * 8), w1 = *(LDSP const f32x4v*)(W2S + r * 64 + c8 * 8 + 4);
        z[0] += gk[r] * w0[0]; z[1] += gk[r] * w0[1]; z[2] += gk[r] * w0[2]; z[3] += gk[r] * w0[3];
        z[4] += gk[r] * w1[0]; z[5] += gk[r] * w1[1]; z[6] += gk[r] * w1[2]; z[7] += gk[r] * w1[3];
      }
      f32x4v g0, g1;
#pragma unroll
      for (int j = 0; j < 8; ++j) {
        const float ls = (fminf(z[j], 0.f) - __logf(1.f + __expf(-fabsf(z[j])))) * (1.f / 16.f);
        if (j < 4) g0[j] = ls; else g1[j - 4] = ls;
      }
      *(LDSP f32x4v*)(GB + t * 64 + c8 * 8) = g0;
      *(LDSP f32x4v*)(GB + t * 64 + c8 * 8 + 4) = g1;
      *(LDSP u32x4*)(KRAW + t * 128 + c8 * 16) = rk;
      *(LDSP u32x4*)(VRAW + t * 256 + c8 * 16) = rv[0];
      *(LDSP u32x4*)(VRAW + t * 256 + 128 + c8 * 16) = rv[1];
    }
    __syncthreads();
    {
      const int d = lane, seg = wid;
      float run = 0.f;
#pragma unroll
      for (int i = 0; i < 8; ++i) { run += GB[(seg * 8 + i) * 64 + d]; GB[(seg * 8 + i) * 64 + d] = run; }
      SEG[seg * 64 + d] = run;
      __syncthreads();
      float base = 0.f;
      for (int s2 = 0; s2 < seg; ++s2) base += SEG[s2 * 64 + d];
#pragma unroll
      for (int i = 0; i < 8; ++i) GB[(seg * 8 + i) * 64 + d] += base;
      if (seg == 7) DEC[d] = __expf(run + base);
    }
    __syncthreads();
    {
      const f32x4v b0 = *(LDSP const f32x4v*)(GB + t * 64 + c8 * 8), b1 = *(LDSP const f32x4v*)(GB + t * 64 + c8 * 8 + 4);
      const float bv[8] = {b0[0], b0[1], b0[2], b0[3], b1[0], b1[1], b1[2], b1[3]};
      const unsigned qw[4] = {rq.x, rq.y, rq.z, rq.w}, kw[4] = {rk.x, rk.y, rk.z, rk.w};
      unsigned qo[4], ko[4];
#pragma unroll
      for (int j = 0; j < 4; ++j) {
        const float e0 = __expf(bv[2 * j]), e1 = __expf(bv[2 * j + 1]);
        qo[j] = pk_bf16(bf_lo(qw[j]) * 0.125f * e0, bf_hi(qw[j]) * 0.125f * e1);
        ko[j] = pk_bf16(bf_lo(kw[j]) * __builtin_amdgcn_rcpf(e0), bf_hi(kw[j]) * __builtin_amdgcn_rcpf(e1));
      }
      *(LDSP u32x4*)(QT + toff(t, c8)) = (u32x4){qo[0], qo[1], qo[2], qo[3]};
      *(LDSP u32x4*)(KT + toff(t, c8)) = (u32x4){ko[0], ko[1], ko[2], ko[3]};
      {
        const int d = lane, seg = wid;
        const float bend = GB[63 * 64 + d];
        float kh[8];
#pragma unroll
        for (int i = 0; i < 8; ++i) {
          const int s2 = seg * 8 + i;
          kh[i] = bfu(*(LDSP const unsigned short*)(KRAW + (s2 * 64 + d) * 2)) * __expf(bend - GB[s2 * 64 + d]);
        }
        *(LDSP u32x4*)(KH + toff(d, seg)) = (u32x4){pk_bf16(kh[0], kh[1]), pk_bf16(kh[2], kh[3]), pk_bf16(kh[4], kh[5]), pk_bf16(kh[6], kh[7])};
      }
      {
        const int vcol = tid & 127, sg4 = tid >> 7;
#pragma unroll
        for (int half = 0; half < 2; ++half) {
          unsigned short e[8];
#pragma unroll
          for (int i = 0; i < 8; ++i) e[i] = *(LDSP const unsigned short*)(VRAW + ((sg4 * 16 + half * 8 + i) * 128 + vcol) * 2);
          *(LDSP u32x4*)(VT + toff(vcol, sg4 * 2 + half)) = (u32x4){(unsigned)e[0] | ((unsigned)e[1] << 16), (unsigned)e[2] | ((unsigned)e[3] << 16),
                                                                   (unsigned)e[4] | ((unsigned)e[5] << 16), (unsigned)e[6] | ((unsigned)e[7] << 16)};
        }
      }
    }
    __syncthreads();
    if (c + 1 < SEQ / 64) {
      const bf16_t* pr = q.proj2 + (tok + 64) * NP;
      rq = *(const u32x4*)(pr + D_QG + h * 64 + c8 * 8);
      rk = *(const u32x4*)(pr + D_KG + h * 64 + c8 * 8);
      rv[0] = *(const u32x4*)(pr + D_VG + h * 128 + c8 * 8);
      rv[1] = *(const u32x4*)(pr + D_VG + h * 128 + 64 + c8 * 8);
#pragma unroll
      for (int i = 0; i < 4; ++i) rgk[i] = *(const float4*)(q.misc + (tok + 64) * 32 + 4 + 4 * i);
    }
    f32x16 oacc[2];
    if (wid < 4) {
      const int sblk = wid & 1, tblk = wid >> 1;
      f32x16 a;
#pragma unroll
      for (int r = 0; r < 16; ++r) a[r] = 0.f;
      if (!(sblk == 1 && tblk == 0)) {
#pragma unroll
        for (int kk = 0; kk < 4; ++kk) a = __builtin_amdgcn_mfma_f32_32x32x16_bf16(frag(KT, sblk * 32, kk, l31, hh), frag(QT, tblk * 32, kk, l31, hh), a, 0, 0, 0);
      }
      const int tt = tblk * 32 + l31;
#pragma unroll
      for (int r = 0; r < 16; ++r) { const int s2 = sblk * 32 + (r & 3) + 8 * (r >> 2) + 4 * hh; if (s2 > tt) a[r] = 0.f; }
#pragma unroll
      for (int g = 0; g < 4; ++g)
        *(LDSP u32x2*)(AM + toff(tt, sblk * 4 + g) + 8 * hh) = (u32x2){pk_bf16(a[4 * g], a[4 * g + 1]), pk_bf16(a[4 * g + 2], a[4 * g + 3])};
    } else {
      const int j = wid - 4;
#pragma unroll
      for (int tb = 0; tb < 2; ++tb) {
#pragma unroll
        for (int r = 0; r < 16; ++r) oacc[tb][r] = 0.f;
#pragma unroll
        for (int kk = 0; kk < 4; ++kk) oacc[tb] = __builtin_amdgcn_mfma_f32_32x32x16_bf16(frag(ST, j * 32, kk, l31, hh), frag(QT, tb * 32, kk, l31, hh), oacc[tb], 0, 0, 0);
      }
    }
    __syncthreads();
    if (wid >= 4) {
      const int j = wid - 4;
#pragma unroll
      for (int tb = 0; tb < 2; ++tb) {
#pragma unroll
        for (int kk = 0; kk < 4; ++kk) oacc[tb] = __builtin_amdgcn_mfma_f32_32x32x16_bf16(frag(VT, j * 32, kk, l31, hh), frag(AM, tb * 32, kk, l31, hh), oacc[tb], 0, 0, 0);
        float ss = 0.f;
#pragma unroll
        for (int r = 0; r < 16; ++r) ss += oacc[tb][r] * oacc[tb][r];
        ss += __shfl_xor(ss, 32);
        const int tt = tb * 32 + l31;
        if (hh == 0) SSQ[j * 64 + tt] = ss;
#pragma unroll
        for (int g = 0; g < 4; ++g)
          *(LDSP u32x2*)(OST + tt * 256 + (((j * 4 + g) ^ (tt & 15)) << 4) + 8 * hh) = (u32x2){pk_bf16(oacc[tb][4 * g], oacc[tb][4 * g + 1]), pk_bf16(oacc[tb][4 * g + 2], oacc[tb][4 * g + 3])};
      }
    } else {
      const int db = wid & 1;
      float dec[16];
#pragma unroll
      for (int r = 0; r < 16; ++r) dec[r] = DEC[db * 32 + (r & 3) + 8 * (r >> 2) + 4 * hh];
#pragma unroll
      for (int i = 0; i < 2; ++i) {
        const int vb = (wid >> 1) * 2 + i;
#pragma unroll
        for (int r = 0; r < 16; ++r) Sacc[i][r] *= dec[r];
#pragma unroll
        for (int kk = 0; kk < 4; ++kk) Sacc[i] = __builtin_amdgcn_mfma_f32_32x32x16_bf16(frag(KH, db * 32, kk, l31, hh), frag(VT, vb * 32, kk, l31, hh), Sacc[i], 0, 0, 0);
        const int vv = vb * 32 + l31;
#pragma unroll
        for (int g = 0; g < 4; ++g)
          *(LDSP u32x2*)(ST + toff(vv, db * 4 + g) + 8 * hh) = (u32x2){pk_bf16(Sacc[i][4 * g], Sacc[i][4 * g + 1]), pk_bf16(Sacc[i][4 * g + 2], Sacc[i][4 * g + 3])};
      }
    }
    __syncthreads();
    {
      const float ssq = SSQ[t] + SSQ[64 + t] + SSQ[128 + t] + SSQ[192 + t];
      const float rs = rsqrtf(ssq * (1.f / 128.f) + 1e-6f);
#pragma unroll
      for (int k2 = 0; k2 < 2; ++k2) {
        const int c16 = c8 + 8 * k2;
        const u32x4 ov = *(LDSP const u32x4*)(OST + t * 256 + ((c16 ^ (t & 15)) << 4));
        const u32x4 gv = rgo[k2];
        const float4 n0 = *(const float4*)(p.gla_norm_w + h * 128 + c16 * 8), n1 = *(const float4*)(p.gla_norm_w + h * 128 + c16 * 8 + 4);
        const float nw[8] = {n0.x, n0.y, n0.z, n0.w, n1.x, n1.y, n1.z, n1.w};
        const unsigned ow[4] = {ov.x, ov.y, ov.z, ov.w}, gw[4] = {gv.x, gv.y, gv.z, gv.w};
        unsigned yo[4];
#pragma unroll
        for (int j = 0; j < 4; ++j) {
          const float y0 = bf_lo(ow[j]) * rs * nw[2 * j] * silu_fast(bf_lo(gw[j]));
          const float y1 = bf_hi(ow[j]) * rs * nw[2 * j + 1] * silu_fast(bf_hi(gw[j]));
          yo[j] = pk_bf16(y0, y1);
        }
        { const int cm = 512 + h * 128 + c16 * 8;
          *(u32x4*)(q.mixer + ((size_t)(cm >> 5) * NTOK + tok) * 32 + (cm & 31)) = (u32x4){yo[0], yo[1], yo[2], yo[3]}; }
      }
      if (c + 1 < SEQ / 64) {
        const bf16_t* pr = q.proj2 + (tok + 64) * NP;
        rgo[0] = *(const u32x4*)(pr + D_GO + h * 128 + c8 * 8);
        rgo[1] = *(const u32x4*)(pr + D_GO + h * 128 + 64 + c8 * 8);
      }
    }
  }
  __syncthreads();
}
__device__ __forceinline__ void phase3b(CQ& q, LDSP char* lds, int tid) {
  for (int u = blockIdx.x; u < BATCH * 4; u += gridDim.x) gla_unit(q, lds, tid, u >> 2, u & 3);
}

namespace att {
typedef short s16x4 __attribute__((ext_vector_type(4)));
typedef short v4i16_t __attribute__((ext_vector_type(4)));
typedef __attribute__((address_space(3))) const char* lds_cptr;
constexpr int NW = 8, QBLK = 32, QB = 256, KVBLK = 64;
constexpr int NSLOT = 3, SLOTB = 8192;
constexpr int LDS_K = 0, LDS_V = NSLOT * SLOTB, LDS_WS = 2 * NSLOT * SLOTB, LDS_OST = LDS_WS + NW * 64 * 4, LDS_MASK = LDS_OST + NW * 4096, LDS_END = LDS_MASK + NW * 8192;
static_assert(LDS_END <= LDS_BYTES, "attention LDS");
__device__ __forceinline__ int crow(int r, int hi) { return (r & 3) + 8 * (r >> 2) + 4 * hi; }
#define SBAR() __builtin_amdgcn_sched_barrier(0)
__device__ __forceinline__ void glds16(const void* gsrc, unsigned lds_dst) { unsigned keep;
  asm volatile("s_mov_b32 %0, m0\n\ts_mov_b32 m0, %2\n\ts_nop 0\n\tglobal_load_lds_dwordx4 %1, off\n\ts_mov_b32 m0, %0" : "=&s"(keep) : "v"(gsrc), "s"(lds_dst) : "memory"); }
__device__ __forceinline__ float max3f(float a, float b, float c) { float r; asm("v_max3_f32 %0, %1, %2, %3" : "=v"(r) : "v"(a), "v"(b), "v"(c)); return r; }
__device__ __forceinline__ float max2f(float a, float b) { float r; asm("v_max_f32_e32 %0, %1, %2" : "=v"(r) : "v"(a), "v"(b)); return r; }
__device__ __forceinline__ float fadd_s(float a, float b) { float r; asm("v_add_f32_e32 %0, %1, %2" : "=v"(r) : "v"(a), "v"(b)); return r; }
__device__ __forceinline__ float fsub_s(float a, float b) { float r; asm("v_sub_f32_e32 %0, %1, %2" : "=v"(r) : "v"(a), "v"(b)); return r; }
__device__ __forceinline__ unsigned cvtpk_s(float lo, float hi) { return pk_bf16(lo, hi); }
#define WAIT_BAR(N) asm volatile("s_waitcnt vmcnt(" #N ") lgkmcnt(0)\n\ts_barrier" ::: "memory")

__device__ __forceinline__ void qkt(f32x16& p0, f32x16& p1, const char* Kslot, const bf16x8* qr, int r32, int hi) {
  const f32x16 negm = {};
  const char* kb = Kslot + hi * 1024 + r32 * 16;
#pragma unroll
  for (int d0 = 0; d0 < 4; ++d0) {
    const bf16x8 b0 = *reinterpret_cast<const bf16x8*>(kb + d0 * 2048);
    const bf16x8 b1 = *reinterpret_cast<const bf16x8*>(kb + d0 * 2048 + 512);
    if (d0 == 0) { p0 = __builtin_amdgcn_mfma_f32_32x32x16_bf16(b0, qr[0], negm, 0, 0, 0); p1 = __builtin_amdgcn_mfma_f32_32x32x16_bf16(b1, qr[0], negm, 0, 0, 0); }
    else { p0 = __builtin_amdgcn_mfma_f32_32x32x16_bf16(b0, qr[d0], p0, 0, 0, 0); p1 = __builtin_amdgcn_mfma_f32_32x32x16_bf16(b1, qr[d0], p1, 0, 0, 0); } }
}
__device__ __forceinline__ void kload8(bf16x8* kf, lds_cptr kp) {
  kf[0] = *(const __attribute__((address_space(3))) bf16x8*)(kp);        kf[1] = *(const __attribute__((address_space(3))) bf16x8*)(kp + 512);
  kf[2] = *(const __attribute__((address_space(3))) bf16x8*)(kp + 2048); kf[3] = *(const __attribute__((address_space(3))) bf16x8*)(kp + 2560);
  kf[4] = *(const __attribute__((address_space(3))) bf16x8*)(kp + 4096); kf[5] = *(const __attribute__((address_space(3))) bf16x8*)(kp + 4608);
  kf[6] = *(const __attribute__((address_space(3))) bf16x8*)(kp + 6144); kf[7] = *(const __attribute__((address_space(3))) bf16x8*)(kp + 6656);
}
__device__ __forceinline__ void kload2(bf16x8* kf, lds_cptr kp, int j) { kf[2 * j] = *(const __attribute__((address_space(3))) bf16x8*)(kp + j * 2048); kf[2 * j + 1] = *(const __attribute__((address_space(3))) bf16x8*)(kp + j * 2048 + 512); }
__device__ __forceinline__ s16x4 vtr(lds_cptr p) { return __builtin_bit_cast(s16x4, __builtin_amdgcn_ds_read_tr16_b64_v4i16((__attribute__((address_space(3))) v4i16_t*)p)); }
__device__ __forceinline__ float rowmax(const f32x16& p0, const f32x16& p1) {
  float a = max3f(p0[0], p0[1], p1[0]), b = max3f(p0[2], p0[3], p1[1]); a = max3f(a, p1[2], p1[3]);
#pragma unroll
  for (int r = 4; r < 16; r += 4) { a = max3f(a, p0[r], p0[r + 1]); b = max3f(b, p0[r + 2], p0[r + 3]); a = max3f(a, p1[r], p1[r + 1]); b = max3f(b, p1[r + 2], p1[r + 3]); }
  const float m = max2f(a, b);
  auto rr = __builtin_amdgcn_permlane32_swap(__float_as_uint(m), __float_as_uint(m), false, false);
  return max2f(__uint_as_float(rr[0]), __uint_as_float(rr[1]));
}
__device__ __forceinline__ void pv(f32x16* o, int vb, bf16x8 pa0, bf16x8 pa1, bf16x8 pa2, bf16x8 pa3) {
#pragma unroll
  for (int d0 = 0; d0 < 2; ++d0) { s16x4 lo[4], hi[4];
#pragma unroll
    for (int ks = 0; ks < 4; ++ks) {
      asm volatile("ds_read_b64_tr_b16 %0,%1 offset:%c2" : "=&v"(lo[ks]) : "v"(vb), "i"(d0 * 4096 + ks * 1024) : "memory");
      asm volatile("ds_read_b64_tr_b16 %0,%1 offset:%c2" : "=&v"(hi[ks]) : "v"(vb), "i"(d0 * 4096 + ks * 1024 + 512) : "memory"); }
    asm volatile("s_waitcnt lgkmcnt(0)" ::: "memory"); SBAR();
#define PK(k) (bf16x8){lo[k][0], lo[k][1], lo[k][2], lo[k][3], hi[k][0], hi[k][1], hi[k][2], hi[k][3]}
    o[d0] = __builtin_amdgcn_mfma_f32_32x32x16_bf16(pa0, PK(0), o[d0], 0, 0, 0);
    o[d0] = __builtin_amdgcn_mfma_f32_32x32x16_bf16(pa1, PK(1), o[d0], 0, 0, 0);
    o[d0] = __builtin_amdgcn_mfma_f32_32x32x16_bf16(pa2, PK(2), o[d0], 0, 0, 0);
    o[d0] = __builtin_amdgcn_mfma_f32_32x32x16_bf16(pa3, PK(3), o[d0], 0, 0, 0);
#undef PK
  }
}
__device__ __forceinline__ void maskb(f32x16& p0, f32x16& p1, lds_cptr mp, int t, int hi, float mh) {
  const u32x2 mw = *(const __attribute__((address_space(3))) u32x2*)(mp + t * 256);
  const unsigned m0 = mw.x >> (4 * hi), m1 = mw.y >> (4 * hi);
#pragma unroll
  for (int r = 0; r < 16; ++r) {
    const int bp = (r & 3) + 8 * (r >> 2);
    p0[r] = ((m0 >> bp) & 1u) ? p0[r] - mh : -INFINITY;
    p1[r] = ((m1 >> bp) & 1u) ? p1[r] - mh : -INFINITY;
  }
}

template <int THRL>
__device__ __forceinline__ void attn_unit(int b, int head, int qb, const bf16_t* PJ, const unsigned* MASK, const float* onw, bf16_t* MIX, char* shm) {
  const int tid = threadIdx.x, lane = tid & 63, r32 = lane & 31, hi = lane >> 5; const int wid = __builtin_amdgcn_readfirstlane(tid >> 6);
  const long rowbase = (long)b * SEQ; const int q0 = qb * QB; const int g = head >> 2;
  constexpr int DM = NP;
  const bf16_t* Qw = PJ + (rowbase + q0 + wid * QBLK) * DM + D_QA + head * 64;
  const bf16_t* Kh = PJ + rowbase * DM + D_KA + g * 64; const bf16_t* Vh = PJ + rowbase * DM + D_VA + g * 64;
  const unsigned lds0 = (unsigned)(uintptr_t)shm;
  float* wsf = (float*)(shm + LDS_WS) + wid * 64;
  const bf16_t* ksrc = Kh + (long)lane * DM + wid * 8;
  const bf16_t* vsrc = Vh + (long)(16 * (wid & 3) + (lane >> 2)) * DM + (wid >> 2) * 32 + (lane & 3) * 8;
  const unsigned kdst = lds0 + LDS_K + wid * 1024, vdst = lds0 + LDS_V + wid * 1024;
#define DMA_K(t, slot) glds16(ksrc + (long)(t) * KVBLK * DM, (unsigned)__builtin_amdgcn_readfirstlane(kdst + (slot)))
#define DMA_V(t, slot) glds16(vsrc + (long)(t) * KVBLK * DM, (unsigned)__builtin_amdgcn_readfirstlane(vdst + (slot)))
  const int vb0 = (int)(lds0 + LDS_V) + ((lane >> 4) & 1) * 32 + (lane & 3) * 8 + (4 * hi + ((lane & 15) >> 2)) * 64;
  const char* Kbase = shm + LDS_K; bf16x8 kf[8];
  const lds_cptr shm3 = (lds_cptr)shm; const lds_cptr kp0 = shm3 + LDS_K + hi * 1024 + r32 * 16; const lds_cptr vp0 = shm3 + LDS_V + ((lane >> 4) & 1) * 32 + (lane & 3) * 8 + (4 * hi + ((lane & 15) >> 2)) * 64;
  const lds_cptr mp0 = shm3 + LDS_MASK + wid * 8192 + r32 * 8;
  const int NT = (q0 + QB) / KVBLK;
  {
    const unsigned* mg = MASK + (size_t)(rowbase + q0 + wid * QBLK + r32) * 64;
    __attribute__((address_space(3))) char* mw = (__attribute__((address_space(3))) char*)shm + LDS_MASK + wid * 8192 + r32 * 8;
#pragma unroll 4
    for (int it = 0; it < 16; ++it) {
      const int wp = it * 2 + hi;
      if (wp < NT) { const u32x2 m = *(const u32x2*)(mg + wp * 2); *(__attribute__((address_space(3))) u32x2*)(mw + wp * 256) = m; }
    }
    asm volatile("s_waitcnt vmcnt(0) lgkmcnt(0)" ::: "memory");
  }
  DMA_K(0, 0); DMA_V(0, 0); DMA_K(1, SLOTB);
  bf16x8 qr[4];
#pragma unroll
  for (int d0 = 0; d0 < 4; ++d0) qr[d0] = *reinterpret_cast<const bf16x8*>(&Qw[(long)r32 * DM + d0 * 16 + hi * 8]);
  float mhat = 0.f, l_reg = 0.f; f32x16 o[2]; o[0] = f32x16{}; o[1] = f32x16{}; const f32x16 zc = f32x16{};
#define CMASK(P0, P1, t) maskb(P0, P1, mp0, (t), hi, mhat)
  long aneg0, aneg1;
  { const int j0 = r32 - 8 * hi, j1 = r32 - 16 - 8 * hi;
    aneg0 = (j0 >= 0 && j0 < 8) ? (long)(0xFEull << (8 * j0)) : 0l;
    aneg1 = (j1 >= 0 && j1 < 8) ? (long)(0xFEull << (8 * j1)) : 0l; }
#define SPREAD8(nb) ((long)((unsigned long long)(((((nb) & 0xFu) * 0x204081u) & 0x01010101u) * 0x7Eu) | ((unsigned long long)((((((nb) >> 4) & 0xFu) * 0x204081u) & 0x01010101u) * 0x7Eu) << 32)))
#define BIAS(C0, C1, t) do { const u32x2 mwq_ = *(const __attribute__((address_space(3))) u32x2*)(mp0 + (t) * 256); \
    const unsigned n0_ = (~mwq_.x) >> (8 * hi), n1_ = (~mwq_.y) >> (8 * hi); \
    C0 = __builtin_amdgcn_mfma_f32_32x32x16_fp8_fp8(aneg0, SPREAD8(n0_ & 0xFFu), zc, 0, 0, 0); \
    C1 = __builtin_amdgcn_mfma_f32_32x32x16_fp8_fp8(aneg0, SPREAD8(n1_ & 0xFFu), zc, 0, 0, 0); \
    C0 = __builtin_amdgcn_mfma_f32_32x32x16_fp8_fp8(aneg1, SPREAD8((n0_ >> 16) & 0xFFu), C0, 0, 0, 0); \
    C1 = __builtin_amdgcn_mfma_f32_32x32x16_fp8_fp8(aneg1, SPREAD8((n1_ >> 16) & 0xFFu), C1, 0, 0, 0); } while (0)
#define CSUB(C0, C1) do { _Pragma("unroll") for (int r_ = 0; r_ < 16; ++r_) { C0[r_] -= mhat; C1[r_] -= mhat; } } while (0)
  bool resc = false;
#define START(P0, P1) do { const float rm = max2f(rowmax(P0, P1), -30.f); resc = false; \
    { const float dl = rm; mhat = fadd_s(mhat, dl); \
      _Pragma("unroll") for (int r = 0; r < 16; ++r) { P0[r] = fsub_s(P0[r], dl); P1[r] = fsub_s(P1[r], dl); } } \
    _Pragma("unroll") for (int r = 0; r < 16; ++r) P0[r] = __builtin_amdgcn_exp2f(P0[r]); } while (0)
#define RESC() do { if (resc) { asm volatile("s_waitcnt lgkmcnt(0)" ::: "memory"); \
      _Pragma("unroll") for (int d_ = 0; d_ < 2; ++d_) _Pragma("unroll") for (int r = 0; r < 16; ++r) o[d_][r] *= wsf[crow(r, hi)]; } } while (0)
  f32x16 pA0, pA1, pB0, pB1;
  int sl_prev = 0, sl_cur = 0, sl_next = SLOTB;
#define ROT() do { sl_prev = sl_cur; sl_cur = sl_next; sl_next = (sl_next == (NSLOT - 1) * SLOTB) ? 0 : sl_next + SLOTB; } while (0)
  DMA_K(2, 2 * SLOTB);
  WAIT_BAR(3);
  qkt(pA0, pA1, Kbase, qr, r32, hi); asm volatile("s_nop 15\n\ts_nop 7" : "+v"(pA0), "+v"(pA1)); CMASK(pA0, pA1, 0);
  asm volatile("s_nop 3" : "+v"(pA0), "+v"(pA1));
  START(pA0, pA1);
  _Pragma("unroll") for (int r = 0; r < 16; ++r) pA1[r] = __builtin_amdgcn_exp2f(pA1[r]);
  WAIT_BAR(0);
  DMA_K(3, 0); DMA_V(1, SLOTB);
  ROT();
  kload8(kf, kp0 + sl_cur);
  WAIT_BAR(2);
  s16x4 vlo[8], vhi[8]; u32x4 pw0, pw1, pw2, pw3;
#define PKW(P, B) cvtpk_s(P[B], P[B + 1])
#define PAF(k) __builtin_bit_cast(bf16x8, pw##k)
#define VFR(i) (bf16x8){vlo[i][0], vlo[i][1], vlo[i][2], vlo[i][3], vhi[i][0], vhi[i][1], vhi[i][2], vhi[i][3]}
#define PIN(x) asm volatile("" : "+v"(x))
#define MX3(a, b, c) __builtin_fmaxf(__builtin_fmaxf((a), (b)), (c))
#define GAPA(MF, A0, A1, A2, A3, W0, W1, PW) do { MF; sacc += A0; sacc += A1; sacc += A2; sacc += A3; PIN(sacc); W0; W1; PIN(PW); SBAR(); } while (0)
#define EX(v) __builtin_amdgcn_exp2f(v)
#define GAPB(MF, X, B) do { MF; X[B] = EX(X[B]); X[B + 1] = EX(X[B + 1]); X[B + 2] = EX(X[B + 2]); X[B + 3] = EX(X[B + 3]); PIN(X); SBAR(); } while (0)
#define VRD(i) do { vlo[i] = vtr(vp_ + (((i) >> 2) * 4096 + ((i) & 3) * 1024)); vhi[i] = vtr(vp_ + (((i) >> 2) * 4096 + ((i) & 3) * 1024 + 512)); } while (0)
#define KRD(G, j) do { if (G) { kload2(kf, kp0 + sl_next, j); SBAR(); } } while (0)
#define STEP(C0, C1, P0, P1, t, GK, GV, GL) do { SBAR(); \
    BIAS(C0, C1, t); \
    const lds_cptr vp_ = vp0 + sl_prev; \
    VRD(0); SBAR(); float sacc = (P0[0] + P0[1]); \
    GAPA(C0 = __builtin_amdgcn_mfma_f32_32x32x16_bf16(kf[0], qr[0], C0, 0, 0, 0), P0[2], P0[3], P0[4], P0[5],     pw0[0] = PKW(P0, 0), pw0[1] = PKW(P0, 2), pw0); \
    VRD(4); SBAR(); GAPA(C1 = __builtin_amdgcn_mfma_f32_32x32x16_bf16(kf[1], qr[0], C1, 0, 0, 0), P0[6], P0[7], P0[8], P0[9],     pw0[2] = PKW(P0, 4), pw0[3] = PKW(P0, 6), pw0); \
    VRD(1); SBAR(); GAPA(C0 = __builtin_amdgcn_mfma_f32_32x32x16_bf16(kf[2], qr[1], C0, 0, 0, 0),   P0[10], P0[11], P0[12], P0[13], pw1[0] = PKW(P0, 8), pw1[1] = PKW(P0, 10), pw1); \
    VRD(5); SBAR(); GAPA(C1 = __builtin_amdgcn_mfma_f32_32x32x16_bf16(kf[3], qr[1], C1, 0, 0, 0),   P0[14], P0[15], P1[0], P1[1],   pw1[2] = PKW(P0, 12), pw1[3] = PKW(P0, 14), pw1); \
    VRD(2); SBAR(); GAPA(C0 = __builtin_amdgcn_mfma_f32_32x32x16_bf16(kf[4], qr[2], C0, 0, 0, 0),   P1[2], P1[3], P1[4], P1[5],     pw2[0] = PKW(P1, 0), pw2[1] = PKW(P1, 2), pw2); \
    VRD(6); SBAR(); GAPA(C1 = __builtin_amdgcn_mfma_f32_32x32x16_bf16(kf[5], qr[2], C1, 0, 0, 0),   P1[6], P1[7], P1[8], P1[9],     pw2[2] = PKW(P1, 4), pw2[3] = PKW(P1, 6), pw2); \
    VRD(3); SBAR(); GAPA(C0 = __builtin_amdgcn_mfma_f32_32x32x16_bf16(kf[6], qr[3], C0, 0, 0, 0),   P1[10], P1[11], P1[12], P1[13], pw3[0] = PKW(P1, 8), pw3[1] = PKW(P1, 10), pw3); \
    VRD(7); SBAR(); GAPA(C1 = __builtin_amdgcn_mfma_f32_32x32x16_bf16(kf[7], qr[3], C1, 0, 0, 0),   P1[14], P1[15], 0.f, 0.f,       pw3[2] = PKW(P1, 12), pw3[3] = PKW(P1, 14), pw3); \
    l_reg += sacc; \
    if (GK) { DMA_K((t) + 3, sl_cur); } if (GV) { DMA_V((t) + 1, sl_next); } \
    { float a = MX3(C0[0], C0[1], C1[0]), b_ = MX3(C0[2], C0[3], C1[1]); a = MX3(a, C1[2], C1[3]); \
      _Pragma("unroll") for (int r = 4; r < 16; r += 4) { a = MX3(a, C0[r], C0[r + 1]); b_ = MX3(b_, C0[r + 2], C0[r + 3]); a = MX3(a, C1[r], C1[r + 1]); b_ = MX3(b_, C1[r + 2], C1[r + 3]); } \
      float rm = __builtin_fmaxf(a, b_); { auto rr = __builtin_amdgcn_permlane32_swap(__float_as_uint(rm), __float_as_uint(rm), false, false); rm = __builtin_fmaxf(__uint_as_float(rr[0]), __uint_as_float(rr[1])); } \
      rm -= mhat;                        \
      resc = false; \
      if (__builtin_expect(__any(rm > (float)THRL), 0)) { const float dl = __builtin_fmaxf(rm, 0.f); mhat += dl; \
        const float f = __builtin_amdgcn_exp2f(-dl); l_reg *= f; if (hi == 0) wsf[r32] = f; resc = true; } \
        \
        \
      _Pragma("unroll") for (int r = 0; r < 16; ++r) { C0[r] = fsub_s(C0[r], mhat); C1[r] = fsub_s(C1[r], mhat); } } \
    SBAR(); \
    GAPB(o[0] = __builtin_amdgcn_mfma_f32_32x32x16_bf16(PAF(0), VFR(0), o[0], 0, 0, 0), C0, 0); \
    GAPB(o[1] = __builtin_amdgcn_mfma_f32_32x32x16_bf16(PAF(0), VFR(4), o[1], 0, 0, 0), C0, 4); \
    KRD(GL, 0); GAPB(o[0] = __builtin_amdgcn_mfma_f32_32x32x16_bf16(PAF(1), VFR(1), o[0], 0, 0, 0), C0, 8); \
    KRD(GL, 1); GAPB(o[1] = __builtin_amdgcn_mfma_f32_32x32x16_bf16(PAF(1), VFR(5), o[1], 0, 0, 0), C0, 12); \
    KRD(GL, 2); GAPB(o[0] = __builtin_amdgcn_mfma_f32_32x32x16_bf16(PAF(2), VFR(2), o[0], 0, 0, 0), C1, 0); \
    KRD(GL, 3); GAPB(o[1] = __builtin_amdgcn_mfma_f32_32x32x16_bf16(PAF(2), VFR(6), o[1], 0, 0, 0), C1, 4); \
    GAPB(o[0] = __builtin_amdgcn_mfma_f32_32x32x16_bf16(PAF(3), VFR(3), o[0], 0, 0, 0), C1, 8); \
    GAPB(o[1] = __builtin_amdgcn_mfma_f32_32x32x16_bf16(PAF(3), VFR(7), o[1], 0, 0, 0), C1, 12); \
    } while (0)
  int t = 1;
  for (; t + 5 < NT; t += 2) {
    STEP(pB0, pB1, pA0, pA1, t, true, true, true);     WAIT_BAR(2); RESC(); ROT();
    STEP(pA0, pA1, pB0, pB1, t + 1, true, true, true); WAIT_BAR(2); RESC(); ROT();
  }
#define ENDW(tt) do { if ((tt) + 3 < NT) { WAIT_BAR(2); } else if ((tt) + 2 < NT) { WAIT_BAR(1); } else { WAIT_BAR(0); } } while (0)
  for (; t + 1 < NT; t += 2) {
    STEP(pB0, pB1, pA0, pA1, t, (t + 3 < NT), (t + 1 < NT), (t + 1 < NT));         ENDW(t);     RESC(); ROT();
    STEP(pA0, pA1, pB0, pB1, t + 1, (t + 4 < NT), (t + 2 < NT), (t + 2 < NT));     ENDW(t + 1); RESC(); ROT();
  }
  STEP(pB0, pB1, pA0, pA1, NT - 1, false, false, false); RESC();
  { float sacc = pB0[0] + pB0[1]; _Pragma("unroll") for (int r = 2; r < 16; ++r) sacc += pB0[r]; _Pragma("unroll") for (int r = 0; r < 16; ++r) sacc += pB1[r]; l_reg += sacc;
    pw0 = (u32x4){PKW(pB0, 0), PKW(pB0, 2), PKW(pB0, 4), PKW(pB0, 6)}; pw1 = (u32x4){PKW(pB0, 8), PKW(pB0, 10), PKW(pB0, 12), PKW(pB0, 14)}; pw2 = (u32x4){PKW(pB1, 0), PKW(pB1, 2), PKW(pB1, 4), PKW(pB1, 6)}; pw3 = (u32x4){PKW(pB1, 8), PKW(pB1, 10), PKW(pB1, 12), PKW(pB1, 14)};
    SBAR(); pv(o, vb0 + sl_cur, PAF(0), PAF(1), PAF(2), PAF(3)); }
#undef PKW
#undef PAF
#undef VFR
#undef PIN
#undef MX3
#undef GAPA
#undef GAPB
#undef EX
#undef VRD
#undef KRD
#undef STEP
#undef ENDW
  { auto rr = __builtin_amdgcn_permlane32_swap(__float_as_uint(l_reg), __float_as_uint(l_reg), false, false); l_reg = __uint_as_float(rr[0]) + __uint_as_float(rr[1]); }
  if (hi == 0) wsf[32 + r32] = l_reg; asm volatile("s_waitcnt lgkmcnt(0)" ::: "memory");
  float rli[16];
#pragma unroll
  for (int r = 0; r < 16; ++r) rli[r] = __builtin_amdgcn_rcpf(wsf[32 + crow(r, hi)]);
  const long orow0 = rowbase + q0 + wid * QBLK;
  { __hip_bfloat16* stg = (__hip_bfloat16*)(shm + LDS_OST) + wid * 2048;
#pragma unroll
    for (int r = 0; r < 16; ++r) { const int orow = crow(r, hi);
#pragma unroll
      for (int d0 = 0; d0 < 2; ++d0) stg[orow * 64 + d0 * 32 + r32] = __float2bfloat16(o[d0][r] * rli[r]); }
    asm volatile("s_waitcnt lgkmcnt(0)" ::: "memory");
    const int ch = lane & 7;
    const float4 nw0 = *(const float4*)(onw + head * 64 + ch * 8), nw1 = *(const float4*)(onw + head * 64 + ch * 8 + 4);
#pragma unroll
    for (int i = 0; i < 4; ++i) { const int row = i * 8 + (lane >> 3);
      const u32x4 v = *(const u32x4*)(stg + row * 64 + ch * 8);
      float f[8] = {bf_lo(v.x), bf_hi(v.x), bf_lo(v.y), bf_hi(v.y), bf_lo(v.z), bf_hi(v.z), bf_lo(v.w), bf_hi(v.w)};
      float ss = 0.f;
#pragma unroll
      for (int j = 0; j < 8; ++j) ss += f[j] * f[j];
      ss += __shfl_xor(ss, 1); ss += __shfl_xor(ss, 2); ss += __shfl_xor(ss, 4);
      const float rs = rsqrtf(ss * (1.f / 64.f) + 1e-6f);
      u32x4 w; w.x = pk_bf16(f[0] * rs * nw0.x, f[1] * rs * nw0.y); w.y = pk_bf16(f[2] * rs * nw0.z, f[3] * rs * nw0.w);
      w.z = pk_bf16(f[4] * rs * nw1.x, f[5] * rs * nw1.y); w.w = pk_bf16(f[6] * rs * nw1.z, f[7] * rs * nw1.w);
      { const int cm = head * 64 + ch * 8; *(u32x4*)(MIX + ((long)(cm >> 5) * NTOK + orow0 + row) * 32 + (cm & 31)) = w; } } }
  asm volatile("s_waitcnt lgkmcnt(0)\n\ts_barrier" ::: "memory");
#undef DMA_K
#undef DMA_V
#undef CMASK
#undef BIAS
#undef CSUB
#undef SPREAD8
#undef START
#undef RESC
#undef ROT
}
#undef SBAR
#undef WAIT_BAR
}


__device__ __forceinline__ void phase6(CQ& q, LDSP char* lds, int tid) {
  CP& p = q.p;
  const int lane = tid & 63, wid = tid >> 6, l31 = lane & 31, hh = lane >> 5;
  const int G = gridDim.x, bid = blockIdx.x;
  const int xcd = bid & 7, lix = bid >> 3, per = G >> 3;
  const int wr = wid >> 2, wc = wid & 3;
  bool pre = false;
  int t6 = tid; asm volatile("" : "+v"(t6));
  const unsigned lo1024 = Core256::lane_off(t6, 2048u);
  for (int it = lix; it < 16 * 4; it += per) {
    const int tt = xcd + 8 * (it / 4), ct = it % 4;
    const int m0 = tt * 256, n0 = ct * 256;
    Desc2 d;
    d.rbase = (const char*)(q.mixer + (size_t)m0 * 32); d.rlo = Core256::lane_off(t6, 64u); d.rstride = 128u * 64u; d.rtile = (unsigned)NTOK * 64u;
    d.cbase = (const char*)(q.wt_out + (size_t)n0 * 32); d.clo = Core256::lane_off(t6, 64u); d.cstride = 128u * 64u; d.ctile = 1024u * 64u;
    d.nk = 32;
    f32x16 acc[4][2];
#pragma unroll
    for (int a = 0; a < 4; ++a)
#pragma unroll
      for (int b2 = 0; b2 < 2; ++b2)
#pragma unroll
        for (int r = 0; r < 16; ++r) acc[a][b2][r] = 0.f;
    Core256::run(acc, d, lds, tid, pre);
    pre = false;
    if (it + per < 16 * 4) {
      const int it2 = it + per; const int tt2 = xcd + 8 * (it2 / 4), ct2 = it2 % 4;
      Desc2 d2 = d;
      d2.rbase = (const char*)(q.mixer + (size_t)tt2 * 256 * 32); d2.cbase = (const char*)(q.wt_out + (size_t)ct2 * 256 * 32);
      Core256::prefetch0(d2, lds, tid);
      pre = true;
    }
    LDSP char* wl = lds + 32768 + wid * 13312;
    const int bb = m0 / SEQ;
    const int erow = lane >> 4, ech = lane & 15;
    const int n = n0 + wc * 64 + ech * 4;
    const float4 g1 = *(const float4*)(p.mod + bb * 6144 + 2048 + n);
    float4 xv[2][8];
#pragma unroll
    for (int i = 0; i < 8; ++i) xv[0][i] = *(const float4*)(p.x + ((size_t)m0 + wr * 128 + erow + 4 * i) * D_MODEL + n);
#pragma unroll
    for (int ri = 0; ri < 4; ++ri) {
      if (ri < 3) {
#pragma unroll
        for (int i = 0; i < 8; ++i) xv[(ri + 1) & 1][i] = *(const float4*)(p.x + ((size_t)m0 + wr * 128 + (ri + 1) * 32 + erow + 4 * i) * D_MODEL + n);
      }
#pragma unroll
      for (int ci = 0; ci < 2; ++ci)
#pragma unroll
        for (int r = 0; r < 16; ++r) {
          const int trow = (r & 3) + 8 * (r >> 2) + 4 * hh;
          *(LDSP float*)(wl + trow * 272 + (ci * 32 + l31) * 4) = acc[ri][ci][r];
        }
#pragma unroll
      for (int i = 0; i < 8; ++i) {
        const int row = erow + 4 * i;
        const f32x4v a4 = *(LDSP const f32x4v*)(wl + row * 272 + ech * 16);
        const size_t tok = (size_t)m0 + wr * 128 + ri * 32 + row;
        const float4 x4 = xv[ri & 1][i];
        u32x2 w2; w2.x = pk_bf16(x4.x + g1.x * a4[0], x4.y + g1.y * a4[1]); w2.y = pk_bf16(x4.z + g1.z * a4[2], x4.w + g1.w * a4[3]);
        *(u32x2*)(q.x1b + tok * D_MODEL + n) = w2;
      }
      asm volatile("s_waitcnt lgkmcnt(0)" ::: "memory");
    }
  }
}

__device__ __forceinline__ void phase7(CQ& q, int tid) {
  CP& p = q.p;
  const int lane = tid & 63, wv = tid >> 6;
  const int nwv = gridDim.x * 8;
  for (int t0 = (blockIdx.x * 8 + wv) * 2; t0 < NTOK; t0 += nwv * 2) {
    float4 v[2][4];
#pragma unroll
    for (int u = 0; u < 2; ++u)
#pragma unroll
      for (int i = 0; i < 4; ++i) v[u][i] = *(const float4*)(p.out + (size_t)(t0 + u) * D_MODEL + i * 256 + lane * 4);
#pragma unroll
    for (int u = 0; u < 2; ++u) {
      const int t = t0 + u;
      const int b = t / SEQ;
      float ss = 0.f;
#pragma unroll
      for (int i = 0; i < 4; ++i) ss += v[u][i].x * v[u][i].x + v[u][i].y * v[u][i].y + v[u][i].z * v[u][i].z + v[u][i].w * v[u][i].w;
      ss = wave_sum(ss);
      const float r = rsqrtf(ss / D_MODEL + 1e-6f);
      const float* md = p.mod + b * 6144;
#pragma unroll
      for (int i = 0; i < 4; ++i) {
        const int d = i * 256 + lane * 4;
        const float4 w = *(const float4*)(p.norm2_w + d);
        const float4 sh = *(const float4*)(md + 3072 + d);
        const float4 sc = *(const float4*)(md + 4096 + d);
        u32x2 w2; w2.x = pk_bf16(v[u][i].x * r * w.x * (1.f + sc.x) + sh.x, v[u][i].y * r * w.y * (1.f + sc.y) + sh.y);
        w2.y = pk_bf16(v[u][i].z * r * w.z * (1.f + sc.z) + sh.z, v[u][i].w * r * w.w * (1.f + sc.w) + sh.w);
        *(u32x2*)(q.h2 + (size_t)t * D_MODEL + d) = w2;
        *(unsigned*)(q.h2f8 + (size_t)t * D_MODEL + d) = pk4_fp8(bf_lo(w2.x) * 16.f, bf_hi(w2.x) * 16.f, bf_lo(w2.y) * 16.f, bf_hi(w2.y) * 16.f);
      }

    }
  }
}

#define LROW 260
__device__ __forceinline__ void phase8(CQ& q, LDSP char* lds, int tid) {
  CP& p = q.p;
  const int lane = tid & 63, wid = tid >> 6, l31 = lane & 31, hh = lane >> 5;
  typedef GemmCoreD<4, 2, 3, true> GC;
  const int wr = wid / 2, wc = wid % 2;
  for (int it = blockIdx.x; it < NTOK / 128; it += gridDim.x) {
    const int m0 = it * 128;
    {
      const float* md = p.mod + (m0 / SEQ) * 6144;
      float4 A[4], B[4];
#pragma unroll
      for (int i = 0; i < 4; ++i) {
        const int d = i * 256 + lane * 4;
        const float4 w = *(const float4*)(p.norm2_w + d);
        const float4 sc = *(const float4*)(md + 4096 + d);
        A[i] = make_float4(w.x * (1.f + sc.x), w.y * (1.f + sc.y), w.z * (1.f + sc.z), w.w * (1.f + sc.w));
        B[i] = *(const float4*)(md + 3072 + d);
      }
#pragma unroll 1
      for (int rr = 0; rr < 16; rr += 4) {
        const int t0 = m0 + wid * 16 + rr;
        u32x2 xb[4][4];
#pragma unroll
        for (int u = 0; u < 4; ++u)
#pragma unroll
          for (int i = 0; i < 4; ++i) xb[u][i] = *(const u32x2*)(q.x1b + (size_t)(t0 + u) * D_MODEL + i * 256 + lane * 4);
#pragma unroll
        for (int u = 0; u < 4; ++u) {
          const int t = t0 + u;
          float4 v[4];
#pragma unroll
          for (int i = 0; i < 4; ++i) v[i] = make_float4(bf_lo(xb[u][i].x), bf_hi(xb[u][i].x), bf_lo(xb[u][i].y), bf_hi(xb[u][i].y));
          float ss = 0.f;
#pragma unroll
          for (int i = 0; i < 4; ++i) ss += v[i].x * v[i].x + v[i].y * v[i].y + v[i].z * v[i].z + v[i].w * v[i].w;
          ss = wave_sum(ss);
          const float r = rsqrtf(ss / D_MODEL + 1e-6f);
#pragma unroll
          for (int i = 0; i < 4; ++i) {
            const int d = i * 256 + lane * 4;
            u32x2 w2; w2.x = pk_bf16(v[i].x * r * A[i].x + B[i].x, v[i].y * r * A[i].y + B[i].y);
            w2.y = pk_bf16(v[i].z * r * A[i].z + B[i].z, v[i].w * r * A[i].w + B[i].w);
            *(u32x2*)(q.h2 + (size_t)t * D_MODEL + d) = w2;
            *(unsigned*)(q.h2f8 + (size_t)t * D_MODEL + d) = pk4_fp8(bf_lo(w2.x) * 16.f, bf_hi(w2.x) * 16.f, bf_lo(w2.y) * 16.f, bf_hi(w2.y) * 16.f);
          }
        }
      }
    }
    asm volatile("s_waitcnt vmcnt(0)" ::: "memory");
    __syncthreads();
    f32x16 acc[2][2];
#pragma unroll
    for (int a = 0; a < 2; ++a)
#pragma unroll
      for (int b2 = 0; b2 < 2; ++b2)
#pragma unroll
        for (int r = 0; r < 16; ++r) acc[a][b2][r] = 0.f;
    {
      const int crow = tid >> 3, cch = tid & 7;
      const unsigned sc16 = (unsigned)((cch ^ ((crow >> 1) & 7)) << 4);
      RunDesc d;
      d.rbase = (const char*)q.wt_router; d.rstride = 64u * 2048u; d.rlo = (unsigned)crow * 2048u + sc16;
      d.cbase = (const char*)(q.h2 + (size_t)m0 * 1024); d.clo0 = (unsigned)crow * 2048u + sc16; d.clo1 = d.clo0 + 64u * 2048u;
      d.nk = 16; d.sc1 = true; d.fp8 = false; d.bscale = 0;
      int st = 0, pre = 0;
      auto next = [](RunDesc&) -> bool { return false; };
      StreamCore::run_stream<false>(acc, d, next, true, lds, tid, st, pre);
    }
    LDSP float* L = (LDSP float*)lds;
    LDSP int* REC = (LDSP int*)(lds + 139264);
#pragma unroll
    for (int ci = 0; ci < 2; ++ci) {
      const int tl = wc * 64 + ci * 32 + l31;
#pragma unroll
      for (int ri = 0; ri < 2; ++ri)
#pragma unroll
        for (int g = 0; g < 4; ++g) {
          const int e0 = wr * 64 + ri * 32 + 8 * g + 4 * hh;
          *(LDSP f32x4v*)(L + tl * LROW + e0) = (f32x4v){acc[ri][ci][4 * g], acc[ri][ci][4 * g + 1], acc[ri][ci][4 * g + 2], acc[ri][ci][4 * g + 3]};
        }
    }
    __syncthreads();
    const float4 br = *(const float4*)(p.b_router + lane * 4);
    const unsigned long long ltmask = (1ull << lane) - 1ull;
    for (int k = 0; k < 16; ++k) {
      const int tl = wid * 16 + k;
      const int t = m0 + tl;
      const f32x4v lg = *(LDSP const f32x4v*)(L + tl * LROW + lane * 4);
      float sg[4] = {1.f / (1.f + __expf(-lg[0])), 1.f / (1.f + __expf(-lg[1])), 1.f / (1.f + __expf(-lg[2])), 1.f / (1.f + __expf(-lg[3]))};
      const float bsc[4] = {sg[0] + br.x, sg[1] + br.y, sg[2] + br.z, sg[3] + br.w};
      float m1 = -INFINITY, m2 = -INFINITY;
#pragma unroll
      for (int i = 0; i < 4; ++i) { const float v = bsc[i]; if (v > m1) { m2 = m1; m1 = v; } else if (v > m2) m2 = v; }
#pragma unroll
      for (int o = 1; o < 8; o <<= 1) {
        const float o1 = __shfl_xor(m1, o), o2 = __shfl_xor(m2, o);
        const float n1 = fmaxf(m1, o1), n2 = fmaxf(fminf(m1, o1), fmaxf(m2, o2));
        m1 = n1; m2 = n2;
      }
      const float gs = m1 + m2;
      const int gi = lane >> 3;
      int rank = 0;
#pragma unroll
      for (int j = 0; j < 8; ++j) { const float gj = __uint_as_float(__builtin_amdgcn_readlane(__float_as_uint(gs), j * 8)); rank += (gj > gs || (gj == gs && j < gi)) ? 1 : 0; }
      unsigned u[4];
#pragma unroll
      for (int i = 0; i < 4; ++i) {
        const unsigned bits = __float_as_uint(bsc[i] + 0.0f);
        const unsigned enc = (bits & 0x80000000u) ? ~bits : (bits | 0x80000000u);
        u[i] = (rank < 4) ? enc : 0u;
      }
      unsigned tau = 0u; bool exact = false;
      for (int bit = 31; bit >= 0; --bit) {
        const unsigned cand = tau | (1u << bit);
        int cnt = 0;
#pragma unroll
        for (int i = 0; i < 4; ++i) cnt += __builtin_popcountll(__ballot(u[i] >= cand));
        if (cnt >= 8) { tau = cand; if (cnt == 8) { exact = true; break; } }
      }
      int need = 8;
      if (!exact) { int cgt = 0;
#pragma unroll
        for (int i = 0; i < 4; ++i) cgt += __builtin_popcountll(__ballot(u[i] > tau));
        need = 8 - cgt; }
      bool selb[4]; unsigned long long sb[4];
      {
        unsigned long long tb[4];
#pragma unroll
        for (int i = 0; i < 4; ++i) tb[i] = __ballot(u[i] == tau);
        int tpre = 0;
#pragma unroll
        for (int i = 0; i < 4; ++i) tpre += __builtin_popcountll(tb[i] & ltmask);
#pragma unroll
        for (int i = 0; i < 4; ++i) {
          const bool tie = (u[i] == tau);
          selb[i] = exact ? (u[i] >= tau) : ((u[i] > tau) || (tie && tpre < need));
          tpre += tie ? 1 : 0;
        }
#pragma unroll
        for (int i = 0; i < 4; ++i) sb[i] = __ballot(selb[i]);
      }
      float wsum = 0.f;
#pragma unroll
      for (int i = 0; i < 4; ++i) {
        unsigned long long m = sb[i];
        while (m) { const int l = __builtin_ctzll(m); m &= m - 1ull; wsum += __uint_as_float(__builtin_amdgcn_readlane(__float_as_uint(sg[i]), l)); }
      }
      int kpre = 0;
#pragma unroll
      for (int i = 0; i < 4; ++i) kpre += __builtin_popcountll(sb[i] & ltmask);
      const float wscale = 2.5f / wsum;
#pragma unroll
      for (int i = 0; i < 4; ++i) {
        if (selb[i]) {
          const int e = lane * 4 + i;
          const int tk = t * 8 + kpre;
          p.selw[tk] = sg[i] * wscale;
          REC[tl * 8 + kpre] = e;
          ++kpre;
        }
      }
    }
    __syncthreads();
#pragma unroll
    for (int a2 = 0; a2 < 2; ++a2) {
      const int ai = tid + a2 * NTHR;
      const int e = REC[ai];
      const int slot = atomicAdd(&p.counts[e * 64], 1);
      q.list[(size_t)e * LCAP + slot] = (m0 + (ai >> 3)) * 8 + (ai & 7);
    }
    __syncthreads();
  }
}

template <class F>
__device__ __forceinline__ void conv_tile4(const F& f, int k0, bf16_t* dst, int ldd, int nd0, LDSP float* T, int tid) {
  LDSP char* Tb = (LDSP char*)(T + 64 * 260);
  {
    const int j4 = (tid & 63) * 4;
    int ld; const float* pcol = f(j4, ld);
    float4 v[8];
#pragma unroll
    for (int hh = 0; hh < 8; ++hh) v[hh] = *(const float4*)(pcol + (size_t)(k0 + (tid >> 6) + 8 * hh) * ld);
#pragma unroll
    for (int hh = 0; hh < 8; ++hh) { const int kr = (tid >> 6) + 8 * hh; *(LDSP f32x4v*)(T + kr * 260 + j4) = (f32x4v){v[hh].x, v[hh].y, v[hh].z, v[hh].w}; }
  }
  __syncthreads();
  {
    const int kc = tid >> 6;
#pragma unroll
    for (int pp = 0; pp < 4; ++pp) {
      const int n = (tid & 63) + 64 * pp;
      float v[8];
#pragma unroll
      for (int i = 0; i < 8; ++i) v[i] = T[(kc * 8 + i) * 260 + n];
      u32x4 w; w.x = pk_bf16(v[0], v[1]); w.y = pk_bf16(v[2], v[3]); w.z = pk_bf16(v[4], v[5]); w.w = pk_bf16(v[6], v[7]);
      *(LDSP u32x4*)(Tb + n * 128 + ((kc ^ (n & 7)) << 4)) = w;
    }
  }
  __syncthreads();
  {
    const int ch = tid & 7;
#pragma unroll
    for (int pp = 0; pp < 4; ++pp) {
      const int n = (tid >> 3) + 64 * pp;
      const u32x4 w = *(LDSP const u32x4*)(Tb + n * 128 + ((ch ^ (n & 7)) << 4));
      *(u32x4*)(dst + (size_t)(nd0 + n) * ldd + k0 + ch * 8) = w;
    }
  }
  __syncthreads();
}

template <class F>
__device__ __forceinline__ void conv_tile4_fp8(const F& f, int k0, unsigned char* dst, int ldd, int nd0, float scale, LDSP float* T, int tid) {
  LDSP char* Tb = (LDSP char*)(T + 64 * 260);
  {
    const int j4 = (tid & 63) * 4;
    int ld; const float* pcol = f(j4, ld);
    float4 v[8];
#pragma unroll
    for (int hh = 0; hh < 8; ++hh) v[hh] = *(const float4*)(pcol + (size_t)(k0 + (tid >> 6) + 8 * hh) * ld);
#pragma unroll
    for (int hh = 0; hh < 8; ++hh) { const int kr = (tid >> 6) + 8 * hh; *(LDSP f32x4v*)(T + kr * 260 + j4) = (f32x4v){v[hh].x, v[hh].y, v[hh].z, v[hh].w}; }
  }
  __syncthreads();
  {
    const int kc = tid >> 6;
#pragma unroll
    for (int pp = 0; pp < 4; ++pp) {
      const int n = (tid & 63) + 64 * pp;
      float v[8];
#pragma unroll
      for (int i = 0; i < 8; ++i) v[i] = T[(kc * 8 + i) * 260 + n] * scale;
      *(LDSP u32x2*)(Tb + n * 64 + kc * 8) = (u32x2){pk4_fp8(v[0], v[1], v[2], v[3]), pk4_fp8(v[4], v[5], v[6], v[7])};
    }
  }
  __syncthreads();
  {
    const int ch = tid & 3;
#pragma unroll
    for (int pp = 0; pp < 2; ++pp) {
      const int n = (tid >> 2) + 128 * pp;
      const u32x4 w = *(LDSP const u32x4*)(Tb + n * 64 + ch * 16);
      *(u32x4*)(dst + (size_t)(nd0 + n) * ldd + k0 + ch * 16) = w;
    }
  }
  __syncthreads();
}
struct ConvSrc { const float* p0; const float* p1; int ld; };
__device__ __forceinline__ const float* conv_addr(CP& p, int it, int tid, int& ld, int& k0) {
  const int e = it / 48, r = it % 48;
  const int j4 = (tid & 63) * 4;
  if (r < 32) {
    const int kt = r >> 1, hq = r & 1;
    const float* wg = (e < 256) ? p.we_gate + (size_t)e * 1024 * 256 : p.ws_gate;
    const float* wu = (e < 256) ? p.we_up + (size_t)e * 1024 * 256 : p.ws_up;
    ld = 256; k0 = kt * 64;
    const int hb = hq * 4 + (j4 >> 6), w64 = j4 & 63;
    return (w64 < 32) ? wg + hb * 32 + w64 : wu + hb * 32 + (w64 - 32);
  } else {
    const int r2 = r - 32, kt = r2 >> 2, nq = r2 & 3;
    const float* wdn = (e < 256) ? p.we_down + (size_t)e * 256 * 1024 : p.ws_down;
    ld = 1024; k0 = kt * 64;
    return wdn + nq * 256 + j4;
  }
}
__device__ __forceinline__ void phase0_experts(CQ& q, LDSP char* lds, int tid, int first, int G) {
  CP& p = q.p;
  LDSP float* T = (LDSP float*)lds;
  LDSP char* Tb = (LDSP char*)(T + 64 * 260);
  const int total = 257 * 48;
  auto load = [&](float4 (&v)[8], int itl) {
    int ld, k0; const float* pc = conv_addr(p, itl, tid, ld, k0);
#pragma unroll
    for (int hh = 0; hh < 8; ++hh) v[hh] = *(const float4*)(pc + (size_t)(k0 + (tid >> 6) + 8 * hh) * ld);
  };
  auto step = [&](float4 (&v)[8], int it, int itl) {
    const int e = it / 48, r = it % 48;
    {
      const int j4 = (tid & 63) * 4;
#pragma unroll
      for (int hh = 0; hh < 8; ++hh) { const int kr = (tid >> 6) + 8 * hh; *(LDSP f32x4v*)(T + kr * 260 + j4) = (f32x4v){v[hh].x, v[hh].y, v[hh].z, v[hh].w}; }
    }
    if (itl < total) load(v, itl);
    __syncthreads();
    if (r < 32) {
      const int kt = r >> 1, hq = r & 1;
      unsigned char* dst = q.wgu8 + (size_t)e * 512 * 1024;
      {
        const int kc = tid >> 6;
#pragma unroll
        for (int pp = 0; pp < 4; ++pp) {
          const int n = (tid & 63) + 64 * pp;
          float x[8];
#pragma unroll
          for (int i = 0; i < 8; ++i) x[i] = T[(kc * 8 + i) * 260 + n] * 256.f;
          *(LDSP u32x2*)(Tb + n * 64 + kc * 8) = (u32x2){pk4_fp8(x[0], x[1], x[2], x[3]), pk4_fp8(x[4], x[5], x[6], x[7])};
        }
      }
      __syncthreads();
      {
        const int ch = tid & 3;
#pragma unroll
        for (int pp = 0; pp < 2; ++pp) {
          const int n = (tid >> 2) + 128 * pp;
          const u32x4 w = *(LDSP const u32x4*)(Tb + n * 64 + ch * 16);
          *(u32x4*)(dst + (size_t)kt * 32768 + (size_t)(hq * 256 + n) * 64 + ch * 16) = w;
        }
      }
    } else {
      const int r2 = r - 32, kt = r2 >> 2, nq = r2 & 3;
      unsigned char* dst = q.wd8 + (size_t)e * 1024 * 256;
      {
        const int kc = tid >> 6;
#pragma unroll
        for (int pp = 0; pp < 4; ++pp) {
          const int n = (tid & 63) + 64 * pp;
          float x[8];
#pragma unroll
          for (int i = 0; i < 8; ++i) x[i] = T[(kc * 8 + i) * 260 + n] * 256.f;
          *(LDSP u32x2*)(Tb + n * 64 + kc * 8) = (u32x2){pk4_fp8(x[0], x[1], x[2], x[3]), pk4_fp8(x[4], x[5], x[6], x[7])};
        }
      }
      __syncthreads();
      {
        const int ch = tid & 3;
#pragma unroll
        for (int pp = 0; pp < 2; ++pp) {
          const int n = (tid >> 2) + 128 * pp;
          const u32x4 w = *(LDSP const u32x4*)(Tb + n * 64 + ch * 16);
          *(u32x4*)(dst + ((size_t)((nq >> 1) * 4 + kt) * 512 + (nq & 1) * 256 + n) * 64 + ch * 16) = w;
        }
      }
    }
    __syncthreads();
  };
  int it = first;
  float4 va[8], vb[8];
  if (it < total) load(va, it);
  if (it + G < total) load(vb, it + G);
  for (; it < total; it += 2 * G) {
    step(va, it, it + 2 * G);
    if (it + G < total) step(vb, it + G, it + 3 * G);
  }
}

struct ExpItem { int e, base, nrows; };
template <bool SHARED>
__device__ __forceinline__ void exp_desc(CQ& q, const ExpItem& u, int sub, int tid, RunDesc& d) {
  const int crow = tid >> 3, cch = tid & 7;
  const unsigned sc16 = (unsigned)((cch ^ ((crow >> 1) & 7)) << 4);
  if (sub < 2) {
    d.rbase = (const char*)(q.wgu8 + ((size_t)u.e * 512 + sub * 256) * 1024); d.rstride = 64u * 1024u;
    d.rlo = (unsigned)crow * 1024u + sc16;
    d.cbase = (const char*)q.h2f8;
    unsigned lo[2];
#pragma unroll
    for (int i = 0; i < 2; ++i) {
      const int row = crow + 64 * i;
      int tokr;
      if (SHARED) tokr = u.base + row;
      else { const int rr = row < u.nrows ? row : 0; tokr = q.list[(size_t)u.e * LCAP + u.base + rr] >> 3; }
      lo[i] = (unsigned)tokr * 1024u + sc16;
    }
    d.clo0 = lo[0]; d.clo1 = lo[1];
    d.nk = 8; d.sc1 = false; d.fp8 = true; d.bscale = 0x7B7B7B7B;
  } else {
    d.rbase = (const char*)(q.wd8 + ((size_t)u.e * 1024 + (sub - 2) * 256) * 256); d.rstride = 64u * 256u;
    d.rlo = (unsigned)crow * 256u + sc16;
    d.cbase = (const char*)(q.actg + (size_t)blockIdx.x * 128 * 256);
    d.clo0 = (unsigned)crow * 256u + sc16; d.clo1 = d.clo0 + 64u * 256u;
    d.nk = 2; d.sc1 = true; d.fp8 = true; d.bscale = 0x7D7D7D7D;
  }
}

template <bool SHARED, class GetItem>
__device__ __forceinline__ void expert_phase(CQ& q, LDSP char* lds, int tid, const GetItem& get_item) {
  CP& p = q.p;
  const int lane = tid & 63, wid = tid >> 6, l31 = lane & 31, hh = lane >> 5;
  const int wr = wid / 2, wc = wid % 2;
  const int crow = tid >> 3;
  ExpItem cur, nxt;
  int r = 0;
  if (!get_item(0, cur)) return;
  int st = 0, pre = 0;
  const int erow = lane >> 3, ech = lane & 7;
  for (;;) {
    const bool has_next = get_item(r + 1, nxt);
    int ent_l = -1; float w_l = 0.f;
    if (!SHARED) {
      const int rowl = wc * 64 + lane;
      if (rowl < cur.nrows) { ent_l = q.list[(size_t)cur.e * LCAP + cur.base + rowl]; w_l = p.selw[ent_l]; }
    }

#pragma unroll 1
    for (int sub = 0; sub < 6; ++sub) {
      RunDesc d;
      exp_desc<SHARED>(q, cur, sub, tid, d);
      f32x16 acc[2][2];
#pragma unroll
      for (int a = 0; a < 2; ++a)
#pragma unroll
        for (int b2 = 0; b2 < 2; ++b2)
#pragma unroll
          for (int rr = 0; rr < 16; ++rr) acc[a][b2][rr] = 0.f;
      auto next = [&](RunDesc& dn) -> bool {
        if (sub == 1) return false;
        if (sub < 5) { exp_desc<SHARED>(q, cur, sub + 1, tid, dn); return true; }
        if (has_next) { exp_desc<SHARED>(q, nxt, 0, tid, dn); return true; }
        return false;
      };
      StreamCore::run_stream<true>(acc, d, next, sub == 2, lds, tid, st, pre);
      LDSP char* wl = StreamCore::free_stage(lds, st) + wid * 6144;
      if (sub < 2) {
        const int hb = sub * 4 + wr;
#pragma unroll
        for (int ci = 0; ci < 2; ++ci) {
          const int row = ci * 32 + l31;
#pragma unroll
          for (int g = 0; g < 4; ++g) {
            float a4[4];
#pragma unroll
            for (int j = 0; j < 4; ++j) { const float gt = acc[0][ci][4 * g + j], up = acc[1][ci][4 * g + j]; a4[j] = silu_fast(gt) * up * 4.f; }
            *(LDSP unsigned*)(wl + row * 32 + ((((g >> 1) ^ (row >> 1)) & 1) << 4) + (g & 1) * 8 + 4 * hh) = pk4_fp8(a4[0], a4[1], a4[2], a4[3]);
          }
        }
        const int srow = lane >> 1, sch = lane & 1;
#pragma unroll
        for (int i = 0; i < 2; ++i) {
          const int row = srow + 32 * i;
          const u32x4 v = *(LDSP const u32x4*)(wl + row * 32 + (((sch ^ (row >> 1)) & 1) << 4));
          *(u32x4*)(q.actg + ((size_t)blockIdx.x * 128 + wc * 64 + row) * 256 + hb * 32 + sch * 16) = v;
        }
      } else {
        const int np = sub - 2;
        float wlw[2] = {1.f, 1.f};
        if (!SHARED) { wlw[0] = __shfl(w_l, l31); wlw[1] = __shfl(w_l, 32 + l31); }

        const int n0 = np * 256 + wr * 64 + ech * 8;
        if (!SHARED) {
#pragma unroll
          for (int ci = 0; ci < 2; ++ci) {
            const int row = ci * 32 + l31; const int sw2 = (row >> 1) & 3;
            const float ws = wlw[ci] * 64.f;
#pragma unroll
            for (int ri = 0; ri < 2; ++ri)
#pragma unroll
              for (int g = 0; g < 4; ++g) {
                const f32x16& a = acc[ri][ci];
                *(LDSP unsigned*)(wl + row * 64 + (((ri * 2 + (g >> 1)) ^ sw2) << 4) + (g & 1) * 8 + 4 * hh) = pk4_fp8(a[4 * g + 0] * ws, a[4 * g + 1] * ws, a[4 * g + 2] * ws, a[4 * g + 3] * ws);
              }
          }
          const int srow = lane >> 2, sch = lane & 3;
          const int nb = np * 256 + wr * 64 + sch * 16;
#pragma unroll
          for (int i = 0; i < 4; ++i) {
            const int row = srow + 16 * i;
            const u32x4 sv = *(LDSP const u32x4*)(wl + row * 64 + ((sch ^ ((row >> 1) & 3)) << 4));
            const int ent = __shfl(ent_l, row);
            if (ent >= 0) *(u32x4*)(q.ybuf + (size_t)ent * 1024 + nb) = sv;
          }
          asm volatile("s_waitcnt lgkmcnt(0)" ::: "memory");
        } else {
#pragma unroll 1
          for (int ci = 0; ci < 2; ++ci) {
            {
              const int row = l31; const int sw2 = (row >> 1) & 7;
#pragma unroll
              for (int ri = 0; ri < 2; ++ri)
#pragma unroll
                for (int g = 0; g < 4; ++g) {
                  const f32x16& a = (ci == 0) ? acc[ri][0] : acc[ri][1];
                  u32x2 w; w.x = pk_bf16(a[4 * g + 0], a[4 * g + 1]); w.y = pk_bf16(a[4 * g + 2], a[4 * g + 3]);
                  *(LDSP u32x2*)(wl + row * 128 + (((ri * 4 + g) ^ sw2) << 4) + 8 * hh) = w;
                }
            }
#pragma unroll 2
            for (int i = 0; i < 4; ++i) {
              const int row = erow + 8 * i;
              const int rowl = wc * 64 + ci * 32 + row;
              const u32x4 sv = *(LDSP const u32x4*)(wl + row * 128 + ((ech ^ ((row >> 1) & 7)) << 4));
              const int tok = cur.base + rowl;
              const int bb = tok / SEQ;
              const float* g2 = p.mod + bb * 6144 + 5120 + n0;
              float* orow = p.out + (size_t)tok * D_MODEL + n0;
              float a8[8] = {bf_lo(sv.x), bf_hi(sv.x), bf_lo(sv.y), bf_hi(sv.y), bf_lo(sv.z), bf_hi(sv.z), bf_lo(sv.w), bf_hi(sv.w)};
              u32x2 yv[8];
#pragma unroll
              for (int k = 0; k < 8; ++k) yv[k] = *(const u32x2*)(q.ybuf + ((size_t)tok * 8 + k) * 1024 + n0);
              const float4 x0 = *(const float4*)(orow), x1 = *(const float4*)(orow + 4);
              const float4 ga = *(const float4*)(g2), gb = *(const float4*)(g2 + 4);
              float r8[8] = {0.f, 0.f, 0.f, 0.f, 0.f, 0.f, 0.f, 0.f};
#pragma unroll
              for (int k = 0; k < 8; ++k) {
                const f32x2v p0 = __builtin_amdgcn_cvt_pk_f32_fp8((int)yv[k].x, false), p1 = __builtin_amdgcn_cvt_pk_f32_fp8((int)yv[k].x, true);
                const f32x2v p2 = __builtin_amdgcn_cvt_pk_f32_fp8((int)yv[k].y, false), p3 = __builtin_amdgcn_cvt_pk_f32_fp8((int)yv[k].y, true);
                r8[0] += p0[0]; r8[1] += p0[1]; r8[2] += p1[0]; r8[3] += p1[1]; r8[4] += p2[0]; r8[5] += p2[1]; r8[6] += p3[0]; r8[7] += p3[1];
              }
#pragma unroll
              for (int j = 0; j < 8; ++j) a8[j] += r8[j] * (1.f / 64.f);
              *(float4*)(orow) = make_float4(x0.x + ga.x * a8[0], x0.y + ga.y * a8[1], x0.z + ga.z * a8[2], x0.w + ga.w * a8[3]);
              *(float4*)(orow + 4) = make_float4(x1.x + gb.x * a8[4], x1.y + gb.y * a8[5], x1.z + gb.z * a8[6], x1.w + gb.w * a8[7]);
            }
            asm volatile("s_waitcnt lgkmcnt(0)" ::: "memory");
          }
        }
      }
    }
    if (!has_next) break;
    cur = nxt; ++r;
  }
  asm volatile("s_waitcnt vmcnt(0) lgkmcnt(0)\n\ts_barrier" ::: "memory");
}

struct RunDesc5 {
  const char* rbase; unsigned rlo, rstride, rtile;
  const char* cbase; unsigned clo;
  int nk; bool noc; int bscale;
};
struct StreamCore5 {
  static constexpr int STAGE = 40960, RB = 32768, ALDS = 3 * 40960;
  static __device__ __forceinline__ LDSP char* free_stage(LDSP char* lds, int st) { return lds + ((st >= 1) ? st - 1 : 2) * STAGE; }
  static __device__ __forceinline__ void issue_tile(const RunDesc5& d, int tile, unsigned dst) {
    const unsigned t64 = (unsigned)tile * 64u, tr = (unsigned)tile * d.rtile;
#pragma unroll
    for (int i = 0; i < 4; ++i) glds16s(d.rbase, d.rlo + (unsigned)i * d.rstride + tr, (unsigned)__builtin_amdgcn_readfirstlane(dst + (unsigned)(i * 8192)));
    if (!d.noc) glds16s(d.cbase, d.clo + t64, (unsigned)__builtin_amdgcn_readfirstlane(dst + (unsigned)RB));
  }
  template <class NextF>
  static __device__ __forceinline__ void run_stream(f32x16 (&acc)[4][2], const RunDesc5& d, const NextF& next,
                                                    LDSP char* lds, int tid, int& st, int& pre) {
    const int lane = tid & 63; const int wid = __builtin_amdgcn_readfirstlane(tid >> 6);
    const int wr = wid >> 1, wc = wid & 1;
    const int l31 = lane & 31, h = lane >> 5, sw2 = (lane >> 2) & 3;
    const unsigned l0 = (unsigned)(uintptr_t)lds + (unsigned)wid * 1024u;
    const int fr_base = (wr * 128 + l31) * 64;
    const int fc_base = (wc * 64 + l31) * 64;
    const int nk = d.nk;
    const bool grp1 = wid >= 4;
    if (pre == 0) {
      asm volatile("s_waitcnt lgkmcnt(0)\n\ts_barrier" ::: "memory");
      issue_tile(d, 0, l0 + (unsigned)(st * STAGE));
      issue_tile(d, 1, l0 + (unsigned)(((st == 2) ? 0 : st + 1) * STAGE));
      if (d.noc) VMW(4); else VMW(5);
    } else {
      asm volatile("s_waitcnt lgkmcnt(0)" ::: "memory");
    }
    if (grp1) asm volatile("s_barrier" ::: "memory");
    bool nvalid = false;
    const int co0 = (((2 * h) ^ sw2) << 4), co1 = (((2 * h + 1) ^ sw2) << 4);
    for (int t = 0; t < nk; ++t) {
      asm volatile("s_barrier" ::: "memory");
      __builtin_amdgcn_sched_barrier(0);
      LDSP char* sp = lds + st * STAGE;
      LDSP char* cb = d.noc ? (lds + ALDS + t * 8192) : (sp + RB);
      v8i_t fa[4], fb[2];
#pragma unroll
      for (int ri = 0; ri < 4; ++ri) {
        const v4i_t lo = *(LDSP const v4i_t*)(sp + fr_base + ri * 2048 + co0), hi = *(LDSP const v4i_t*)(sp + fr_base + ri * 2048 + co1);
        fa[ri] = __builtin_shufflevector(lo, hi, 0, 1, 2, 3, 4, 5, 6, 7);
      }
#pragma unroll
      for (int ci = 0; ci < 2; ++ci) {
        const v4i_t lo = *(LDSP const v4i_t*)(cb + fc_base + ci * 2048 + co0), hi = *(LDSP const v4i_t*)(cb + fc_base + ci * 2048 + co1);
        fb[ci] = __builtin_shufflevector(lo, hi, 0, 1, 2, 3, 4, 5, 6, 7);
      }
      const unsigned d2 = l0 + (unsigned)(((st >= 1) ? st - 1 : 2) * STAGE);
      int pn = 0;
      if (t + 2 < nk) { issue_tile(d, t + 2, d2); pn = d.noc ? 4 : 5; }
      else {
        RunDesc5 dn;
        if (next(dn)) { issue_tile(dn, t + 2 - nk, d2); pn = dn.noc ? 4 : 5; nvalid = true; }
      }
      if (pn == 5) VMW(5); else if (pn == 4) VMW(4); else VMW(0);
      asm volatile("s_waitcnt lgkmcnt(0)\n\ts_barrier" ::: "memory");
      __builtin_amdgcn_sched_barrier(0);
      __builtin_amdgcn_s_setprio(1);
#pragma unroll
      for (int ri = 0; ri < 4; ++ri)
#pragma unroll
        for (int ci = 0; ci < 2; ++ci)
          acc[ri][ci] = __builtin_amdgcn_mfma_scale_f32_32x32x64_f8f6f4(fa[ri], fb[ci], acc[ri][ci], 0, 0, 0, 0x77777777, 0, d.bscale);
      __builtin_amdgcn_s_setprio(0);
      __builtin_amdgcn_sched_barrier(0);
      st = (st == 2) ? 0 : st + 1;
    }
    if (!grp1) asm volatile("s_barrier" ::: "memory");
    pre = nvalid ? 2 : 0;
  }
};

template <bool SHARED>
__device__ __forceinline__ void exp_desc5(CQ& q, const ExpItem& u, int sub, int tid0, RunDesc5& d, int ctok) {
  int tid = tid0; asm volatile("" : "+v"(tid));
  const int row = tid >> 2, pos = tid & 3;
  const unsigned sc16 = (unsigned)((pos ^ ((row >> 2) & 3)) << 4);
  if (sub == 0) {
    d.rbase = (const char*)(q.wgu8 + (size_t)u.e * 512 * 1024); d.rstride = 128u * 64u; d.rlo = (unsigned)row * 64u + sc16; d.rtile = 512u * 64u;
    d.cbase = (const char*)q.h2f8;
    const int tokr = SHARED ? u.base + row : (ctok >> 3);
    d.clo = (unsigned)tokr * 1024u + sc16;
    d.nk = 16; d.noc = false; d.bscale = 0x7B7B7B7B;
  } else {
    d.rbase = (const char*)(q.wd8 + (size_t)u.e * 1024 * 256 + (size_t)(sub - 1) * 4 * 512 * 64); d.rstride = 128u * 64u; d.rlo = (unsigned)row * 64u + sc16; d.rtile = 512u * 64u;
    d.cbase = d.rbase; d.clo = 0u;
    d.nk = 4; d.noc = true; d.bscale = 0x7D7D7D7D;
  }
}

template <bool SHARED, class GetItem>
__device__ __forceinline__ void expert_phase5(CQ& q, LDSP char* lds, int tid, const GetItem& get_item) {
  CP& p = q.p;
  const int lane = tid & 63, wid = __builtin_amdgcn_readfirstlane(tid >> 6);
  const int wr = wid >> 1, wc = wid & 1;
  ExpItem cur, nxt;
  int r = 0;
  if (!get_item(0, cur)) return;
  int st = 0, pre = 0;
  auto load_meta = [&](const ExpItem& u, int& ctok, int& ent) {
    ctok = 0; ent = -1;
    if (!SHARED) {
      const int row = tid >> 2; const int rr = row < u.nrows ? row : 0;
      ctok = q.list[(size_t)u.e * LCAP + u.base + rr];
      const int rowl = wc * 64 + lane;
      if (rowl < u.nrows) ent = q.list[(size_t)u.e * LCAP + u.base + rowl];
    }
  };
  int ctok, ent_l; float w_l = 0.f;
  load_meta(cur, ctok, ent_l);
  if (!SHARED) { if (ent_l >= 0) w_l = p.selw[ent_l]; }
  for (;;) {
    const bool has_next = get_item(r + 1, nxt);
    int ctok_n = 0, ent_n = -1; float w_n = 0.f;
#pragma unroll 1
    for (int sub = 0; sub < 3; ++sub) {
      RunDesc5 d;
      exp_desc5<SHARED>(q, cur, sub, tid, d, ctok);
      f32x16 acc[4][2];
#pragma unroll
      for (int a = 0; a < 4; ++a)
#pragma unroll
        for (int b2 = 0; b2 < 2; ++b2)
#pragma unroll
          for (int rr = 0; rr < 16; ++rr) acc[a][b2][rr] = 0.f;
      auto next = [&](RunDesc5& dn) -> bool {
        if (sub < 2) { exp_desc5<SHARED>(q, cur, sub + 1, tid, dn, ctok); return true; }
        if (has_next) { exp_desc5<SHARED>(q, nxt, 0, tid, dn, ctok_n); return true; }
        return false;
      };
      StreamCore5::run_stream(acc, d, next, lds, tid, st, pre);
      int lz = lane; asm volatile("" : "+v"(lz));
      const int l31 = lz & 31, hh = lz >> 5, erow = lz >> 3, ech = lz & 7;
      LDSP char* wl = StreamCore5::free_stage(lds, st) + wid * 5120;
      if (sub == 0) {
        if (!SHARED) { if (has_next) load_meta(nxt, ctok_n, ent_n); }
        LDSP char* al = lds + StreamCore5::ALDS + wr * 8192;
#pragma unroll
        for (int q2 = 0; q2 < 2; ++q2) {
          __builtin_amdgcn_sched_barrier(0);
#pragma unroll
          for (int ci = 0; ci < 2; ++ci) {
            __builtin_amdgcn_sched_barrier(0);
            const int row = wc * 64 + ci * 32 + l31;
#pragma unroll
            for (int g = 0; g < 4; ++g) {
              float a4[4];
#pragma unroll
              for (int j = 0; j < 4; ++j) { const float gt = acc[2 * q2][ci][4 * g + j], up = acc[2 * q2 + 1][ci][4 * g + j]; a4[j] = silu_fast(gt) * up * 4.f; }
              *(LDSP unsigned*)(al + row * 64 + ((((q2 * 2 + (g >> 1)) ^ (row >> 2)) & 3) << 4) + (g & 1) * 8 + 4 * hh) = pk4_fp8(a4[0], a4[1], a4[2], a4[3]);
            }
          }
        }
        if (!SHARED) { if (ent_n >= 0) w_n = p.selw[ent_n]; }
      } else {
        float wlw[2] = {1.f, 1.f};
        if (!SHARED) { wlw[0] = __shfl(w_l, l31); wlw[1] = __shfl(w_l, 32 + l31); }
#pragma unroll
        for (int hn = 0; hn < 2; ++hn) {
          __builtin_amdgcn_sched_barrier(0);
          const int ncol = (sub - 1) * 512 + wr * 128 + hn * 64;
          if (!SHARED) {
#pragma unroll
            for (int ci = 0; ci < 2; ++ci) {
              __builtin_amdgcn_sched_barrier(0);
              const int row = ci * 32 + l31; const int sw2 = (row >> 1) & 3;
              const float ws = wlw[ci] * 64.f;
#pragma unroll
              for (int ri = 0; ri < 2; ++ri)
#pragma unroll
                for (int g = 0; g < 4; ++g) {
                  const f32x16& a = acc[2 * hn + ri][ci];
                  *(LDSP unsigned*)(wl + row * 64 + ((g ^ sw2) << 4) + 8 * hh + 4 * ri) = pk4_fp8(a[4 * g + 0] * ws, a[4 * g + 1] * ws, a[4 * g + 2] * ws, a[4 * g + 3] * ws);
                }
            }
            const int srow = lz >> 2, sch = lz & 3;
#pragma unroll
            for (int i = 0; i < 4; ++i) {
              const int row = srow + 16 * i;
              const u32x4 sv = *(LDSP const u32x4*)(wl + row * 64 + ((sch ^ ((row >> 1) & 3)) << 4));
              const int ent = __shfl(ent_l, row);
              if (ent >= 0) *(u32x4*)(q.ybuf + (size_t)ent * 1024 + ncol + sch * 16) = sv;
            }
            asm volatile("s_waitcnt lgkmcnt(0)" ::: "memory");
          } else {
            const int n0 = ncol + ech * 8;
#pragma unroll 1
            for (int ci = 0; ci < 2; ++ci) {
              {
                const int row = l31; const int sw2 = (row >> 1) & 7;
#pragma unroll
                for (int ri = 0; ri < 2; ++ri)
#pragma unroll
                  for (int g = 0; g < 4; ++g) {
                    const f32x16& a = (ci == 0) ? acc[2 * hn + ri][0] : acc[2 * hn + ri][1];
                    u32x2 w; w.x = pk_bf16(a[4 * g + 0], a[4 * g + 1]); w.y = pk_bf16(a[4 * g + 2], a[4 * g + 3]);
                    *(LDSP u32x2*)(wl + row * 128 + (((ri * 4 + g) ^ sw2) << 4) + 8 * hh) = w;
                  }
              }
#pragma unroll 1
              for (int i = 0; i < 4; ++i) {
                const int row = erow + 8 * i;
                const int rowl = wc * 64 + ci * 32 + row;
                const int swr = (row >> 1) & 7;
                const u32x2 sva = *(LDSP const u32x2*)(wl + row * 128 + (((ech >> 1) ^ swr) << 4) + (ech & 1) * 8);
                const u32x2 svb = *(LDSP const u32x2*)(wl + row * 128 + (((4 + (ech >> 1)) ^ swr) << 4) + (ech & 1) * 8);
                const int tok = cur.base + rowl;
                const int bb = tok / SEQ;
                const int ca = ncol + ech * 4, cb = ca + 32;
                const float* g2 = p.mod + bb * 6144 + 5120;
                float* orow = p.out + (size_t)tok * D_MODEL;
                float a8[8] = {bf_lo(sva.x), bf_hi(sva.x), bf_lo(sva.y), bf_hi(sva.y), bf_lo(svb.x), bf_hi(svb.x), bf_lo(svb.y), bf_hi(svb.y)};
                u32x2 yv[8];
#pragma unroll
                for (int k = 0; k < 8; ++k) yv[k] = *(const u32x2*)(q.ybuf + ((size_t)tok * 8 + k) * 1024 + n0);
                const u32x2 xa = *(const u32x2*)(q.x1b + (size_t)tok * D_MODEL + ca), xb2 = *(const u32x2*)(q.x1b + (size_t)tok * D_MODEL + cb);
                const float4 x0 = make_float4(bf_lo(xa.x), bf_hi(xa.x), bf_lo(xa.y), bf_hi(xa.y)), x1 = make_float4(bf_lo(xb2.x), bf_hi(xb2.x), bf_lo(xb2.y), bf_hi(xb2.y));
                const float4 ga = *(const float4*)(g2 + ca), gb = *(const float4*)(g2 + cb);
                float r8[8] = {0.f, 0.f, 0.f, 0.f, 0.f, 0.f, 0.f, 0.f};
#pragma unroll
                for (int k = 0; k < 8; ++k) {
                  const f32x2v p0 = __builtin_amdgcn_cvt_pk_f32_fp8((int)yv[k].x, false), p1 = __builtin_amdgcn_cvt_pk_f32_fp8((int)yv[k].x, true);
                  const f32x2v p2 = __builtin_amdgcn_cvt_pk_f32_fp8((int)yv[k].y, false), p3 = __builtin_amdgcn_cvt_pk_f32_fp8((int)yv[k].y, true);
                  r8[0] += p0[0]; r8[1] += p0[1]; r8[2] += p1[0]; r8[3] += p1[1]; r8[4] += p2[0]; r8[5] += p2[1]; r8[6] += p3[0]; r8[7] += p3[1];
                }
#pragma unroll
                for (int j = 0; j < 8; ++j) a8[j] += r8[j] * (1.f / 64.f);
                *(float4*)(orow + ca) = make_float4(x0.x + ga.x * a8[0], x0.y + ga.y * a8[1], x0.z + ga.z * a8[2], x0.w + ga.w * a8[3]);
                *(float4*)(orow + cb) = make_float4(x1.x + gb.x * a8[4], x1.y + gb.y * a8[5], x1.z + gb.z * a8[6], x1.w + gb.w * a8[7]);
              }
              asm volatile("s_waitcnt lgkmcnt(0)" ::: "memory");
            }
          }
        }
      }
    }
    if (!has_next) break;
    cur = nxt; ++r; ctok = ctok_n; ent_l = ent_n; w_l = w_n;
  }
  asm volatile("s_waitcnt vmcnt(0) lgkmcnt(0)\n\ts_barrier" ::: "memory");
}

__device__ __forceinline__ void phase9(CQ& q, LDSP char* lds, int tid) {
  CP& p = q.p;
  const int lane = tid & 63;
  const int G = gridDim.x, bid = blockIdx.x;
  const int xcd = bid & 7, lix = bid >> 3, per = G >> 3;
  const int myexp = xcd + 8 * (lane & 31);
  const int cnt = p.counts[myexp * 64];
  const int nt = (cnt + 127) >> 7;
  int incl = nt;
#pragma unroll
  for (int o = 1; o < 32; o <<= 1) { const int v = __shfl_up(incl, o); if ((lane & 31) >= o) incl += v; }
  const int total = __shfl(incl, 31);
  auto get_item = [&](int r, ExpItem& u) -> bool {
    const int it = lix + r * per;
    if (it >= total) return false;
    const unsigned long long bal = __ballot((lane < 32) && (it < incl));
    const int k = __builtin_ctzll(bal);
    u.e = __builtin_amdgcn_readfirstlane(xcd + 8 * k);
    const int inck = __shfl(incl, k), ntk = __shfl(nt, k), cntk = __shfl(cnt, k);
    u.base = __builtin_amdgcn_readfirstlane((it - (inck - ntk)) * 128);
    u.nrows = __builtin_amdgcn_readfirstlane(min(128, cntk - u.base));
    return true;
  };
  expert_phase5<false>(q, lds, tid, get_item);
}
__device__ __forceinline__ void phase10(CQ& q, LDSP char* lds, int tid) {
  const int G = gridDim.x, bid = blockIdx.x;
  auto get_item = [&](int r, ExpItem& u) -> bool {
    const int it = bid + r * G;
    if (it >= NTOK / 128) return false;
    u.e = 256; u.base = it * 128; u.nrows = 128;
    return true;
  };
  expert_phase5<true>(q, lds, tid, get_item);
}

__device__ __forceinline__ void phase4(CQ& q, char* shm) {
  const int G = gridDim.x, bx = blockIdx.x;
  const int lix = bx >> 3;
  const int tid = threadIdx.x;
  if (lix & 1) phase0_experts(q, (LDSP char*)shm, tid, (bx & 7) * (G >> 4) + (lix >> 1), G >> 1);
  volatile LDSP int* sit = (volatile LDSP int*)((LDSP char*)shm + LDS_BYTES - 8);
  const int NU = BATCH * 8 * 8;
  int nxt = 0;
  if (tid == 0) nxt = atomicAdd(q.ictr + 16, 1);
  for (;;) {
    if (tid == 0) *sit = nxt;
    __syncthreads();
    const int u = *sit;
    __syncthreads();
    if (u >= NU) break;
    if (tid == 0) nxt = atomicAdd(q.ictr + 16, 1);
    const int qb = 7 - (u >> 7), bh = u & 127;
    att::attn_unit<8>(bh >> 3, bh & 7, qb, q.proj2, q.p.mask, q.p.attn_out_norm_w, q.mixer, shm);
  }
}

#define XB_TMO      128
#define XB_XCNT(j)  (256  + 64 * (j))
#define XB_XSUB(j)  (1280 + 64 * (j))
#define XB_XGEN(j)  (2304 + 64 * (j))
#define XB_TOP      3328
#define XB_TOPGEN   3392
#define XCD_BAR_WORDS 3456
#define XB_SPIN_CAP (1u << 22)
__device__ __forceinline__ unsigned xb_ld(unsigned* p)              { return __hip_atomic_load(p, __ATOMIC_RELAXED, __HIP_MEMORY_SCOPE_AGENT); }
__device__ __forceinline__ unsigned xb_add(unsigned* p, unsigned v) { return __hip_atomic_fetch_add(p, v, __ATOMIC_RELAXED, __HIP_MEMORY_SCOPE_AGENT); }
__device__ __forceinline__ unsigned xb_xcc_id() { return (unsigned)__builtin_amdgcn_s_getreg((3 << 11) | 20) & 0xFu; }
#define XB_SPIN(cond, bar) do { unsigned _sp = 0; while (cond) { __builtin_amdgcn_s_sleep(1); \
    if ((++_sp & 255u) == 0u) { if (xb_ld(&(bar)[XB_TMO])) break; if (_sp > XB_SPIN_CAP) { atomicAdd(&(bar)[XB_TMO], 1u); break; } } } } while (0)
struct XcdBarrier { unsigned* bar; unsigned x; unsigned* st; };
__device__ __forceinline__ XcdBarrier xcd_barrier_post(unsigned* bar, unsigned* st) {
  XcdBarrier b; b.bar = bar; b.x = xb_xcc_id(); b.st = st;
  if (threadIdx.x == 0) (void)xb_add(&bar[XB_XCNT(b.x)], 1u);
  return b;
}
__device__ __forceinline__ void xcd_barrier_complete(unsigned* bar, unsigned x, unsigned& nloc, unsigned& nx) {
  const unsigned G = gridDim.x * gridDim.y * gridDim.z;
  unsigned sum, cnt, mine, sp = 0u;
  for (;;) {
    sum = 0u; cnt = 0u; mine = 0u;
#pragma unroll
    for (unsigned j = 0; j < 16; ++j) { const unsigned c = xb_ld(&bar[XB_XCNT(j)]); sum += c; cnt += (c > 0u) ? 1u : 0u; mine = (j == x) ? c : mine; }
    if (sum == G) break;
    __builtin_amdgcn_s_sleep(1);
    if ((++sp & 255u) == 0u) { if (xb_ld(&bar[XB_TMO])) break; if (sp > XB_SPIN_CAP) { atomicAdd(&bar[XB_TMO], 1u); break; } }
  }
  nloc = mine > 0u ? mine : 1u; nx = cnt > 0u ? cnt : 1u;
}
__device__ __forceinline__ void xcd_barrier(const XcdBarrier& b) {
  asm volatile("s_waitcnt vmcnt(0)" ::: "memory");
  __syncthreads();
  if (threadIdx.x == 0) {
    unsigned* bar = b.bar;
    __builtin_amdgcn_s_waitcnt(0);
    unsigned nloc = xb_ld(&b.st[0]), nx = xb_ld(&b.st[1]);
    if (nloc == 0u) {
      xcd_barrier_complete(bar, b.x, nloc, nx);
      __hip_atomic_store(&b.st[0], nloc, __ATOMIC_RELAXED, __HIP_MEMORY_SCOPE_AGENT); __hip_atomic_store(&b.st[1], nx, __ATOMIC_RELAXED, __HIP_MEMORY_SCOPE_AGENT);
    }
    const unsigned old = xb_add(&bar[XB_XSUB(b.x)], 1u);
    const unsigned gen = old / nloc;
    if (old + 1u == (gen + 1u) * nloc) {
      __builtin_amdgcn_fence(__ATOMIC_RELEASE, "agent");
      asm volatile("s_waitcnt vmcnt(0)" ::: "memory");
      const unsigned og = xb_add(&bar[XB_TOP], 1u);
      const unsigned tg = og / nx;
      if (og + 1u == (tg + 1u) * nx) {
#pragma unroll
        for (unsigned j = 0; j < 16; ++j) (void)xb_add(&bar[XB_XGEN(j)], 1u);
      } else XB_SPIN(xb_ld(&bar[XB_XGEN(b.x)]) == gen, bar);
      __builtin_amdgcn_fence(__ATOMIC_ACQUIRE, "agent");
      asm volatile("s_waitcnt vmcnt(0)" ::: "memory");
    } else {
      XB_SPIN(xb_ld(&bar[XB_XGEN(b.x)]) == gen, bar);
      __builtin_amdgcn_fence(__ATOMIC_ACQUIRE, "agent");
      asm volatile("s_waitcnt vmcnt(0)" ::: "memory");
    }
  }
  __syncthreads();
}

__global__ void __launch_bounds__(NTHR, 2) mk(Q qarg) {
  extern __shared__ __attribute__((aligned(16))) char smem[];
  LDSP char* lds = (LDSP char*)smem;
  const int tid = threadIdx.x;
  CQ* qp0 = (CQ*)__builtin_amdgcn_kernarg_segment_ptr();
  const int ph_lo = qp0->ph_lo, ph_hi = qp0->ph_hi;
  const bool multi = (ph_hi - ph_lo) > 1;
  unsigned* bst = qp0->barw + 8192 + 2 * blockIdx.x;
  XcdBarrier bar; bar.bar = qp0->barw; bar.x = 0; bar.st = bst;
  if (multi) bar = xcd_barrier_post(qp0->barw, bst);
#define QPH(name) CQ* name = qp0; asm volatile("" : "+s"(name));
#define IN(k) (ph_lo <= (k) && (k) < ph_hi)
#define GB(k) do { if (multi && IN(k) && IN((k) + 1)) xcd_barrier(bar); } while (0)
  if (IN(0)) { QPH(qa) phase0(*qa, lds, tid); }
  GB(0);
  if (IN(1)) { QPH(qa) phase1(*qa, tid); }
  GB(1);
  if (IN(2)) { QPH(qa) phase2(*qa, lds, tid); }
  GB(2);
  if (IN(3)) { QPH(qa) phase3b(*qa, lds, tid); QPH(qb) phase3(*qb, lds, tid); }
  GB(3);
  if (IN(4)) { QPH(qa) phase4(*qa, smem); }
  GB(4);
  if (IN(5)) { QPH(qa) phase6(*qa, lds, tid); }
  GB(5);
  if (IN(6)) { QPH(qa) phase8(*qa, lds, tid); }
  GB(6);
  if (IN(7)) { QPH(qa) phase9(*qa, lds, tid); }
  GB(7);
  if (IN(8)) { QPH(qa) phase10(*qa, lds, tid); }
}


extern "C" void kernel_launch(void* const* d_in, const int* in_sizes, int n_in, void* d_out, int out_size,
                              void* d_ws, size_t ws_size, hipStream_t stream) {
  P p{};
  p.x = (const float*)d_in[0]; p.c = (const float*)d_in[1]; p.pos = (const int*)d_in[2];
  p.norm1_w = (const float*)d_in[3]; p.norm2_w = (const float*)d_in[4];
  p.w_ada = (const float*)d_in[5]; p.b_ada = (const float*)d_in[6]; p.w_in = (const float*)d_in[7];
  p.q_norm_w = (const float*)d_in[8]; p.k_norm_w = (const float*)d_in[9]; p.attn_out_norm_w = (const float*)d_in[10];
  p.w_gk2 = (const float*)d_in[11]; p.b_gk = (const float*)d_in[12]; p.gla_norm_w = (const float*)d_in[13];
  p.w_out = (const float*)d_in[14]; p.w_router = (const float*)d_in[15]; p.b_router = (const float*)d_in[16];
  p.we_gate = (const float*)d_in[17]; p.we_up = (const float*)d_in[18]; p.we_down = (const float*)d_in[19];
  p.ws_gate = (const float*)d_in[20]; p.ws_up = (const float*)d_in[21]; p.ws_down = (const float*)d_in[22];
  p.out = (float*)d_out;
  char* ws = (char*)d_ws;
  size_t off = 0;
  auto take = [&](size_t bytes) { char* r = ws + off; off += (bytes + 255) & ~(size_t)255; return r; };
  char* ctl = take(131072);
  p.counts = (int*)ctl;
  p.mod = (float*)take((size_t)16 * 6144 * 4);
  Q q{};
  q.barw = (unsigned*)(ctl + 65536 + 4096);
  q.ictr = (int*)(ctl + 65536 + 2048);
  q.wt_in = (bf16_t*)take((size_t)NP * 1024 * 2);
  q.wt_out = (bf16_t*)take((size_t)1024 * 1024 * 2);
  q.rope = (float*)take((size_t)NTOK * 16 * 4);
  q.misc = (float*)take((size_t)NTOK * 32 * 4);
  { const size_t have = (size_t)((char*)q.misc - (char*)q.wt_in) + (size_t)NTOK * 32 * 4; const size_t need = (size_t)256 * 128 * 256 * 2; if (need > have) (void)take(need - have); }
  q.actg = (unsigned char*)q.wt_in;
  q.wt_router = (bf16_t*)take((size_t)256 * 1024 * 2);
  p.selw = (float*)take((size_t)NASSIGN * 4);
  q.list = (int*)take((size_t)256 * LCAP * 4);
  q.wgu8 = (unsigned char*)take((size_t)257 * 512 * 1024);
  q.h2f8 = (unsigned char*)take((size_t)NTOK * 1024);
  q.wd8 = (unsigned char*)take((size_t)257 * 1024 * 256);
  q.h1 = (bf16_t*)take((size_t)NTOK * 1024 * 2);
  q.h2 = q.h1;
  char* big = take((size_t)NASSIGN * 1024 * 2);
  q.ybuf = (unsigned char*)big;
  q.x1b = (bf16_t*)(big + (size_t)NASSIGN * 1024);
  q.proj2 = (bf16_t*)big;
  p.mask = (unsigned*)(big + (size_t)NTOK * NP * 2);
  q.mixer = (bf16_t*)(big + (size_t)NTOK * NP * 2 + (size_t)NTOK * 64 * 4);
  if (off > ws_size) { fprintf(stderr, "workspace too small: need %zu have %zu\n", off, ws_size); return; }
  q.p = p;
  static bool attr_set = false;
  if (!attr_set) { (void)hipFuncSetAttribute((const void*)mk, hipFuncAttributeMaxDynamicSharedMemorySize, LDS_BYTES); attr_set = true; }
  (void)hipMemsetAsync(ctl, 0, 131072, stream);
  static int n_cu = 0;
  if (!n_cu) { int dev = 0; (void)hipGetDevice(&dev); (void)hipDeviceGetAttribute(&n_cu, hipDeviceAttributeMultiprocessorCount, dev); if (n_cu <= 0) n_cu = 1; }
  if (n_cu >= 256) {
    q.ph_lo = 0; q.ph_hi = 9;
    mk<<<256, NTHR, LDS_BYTES, stream>>>(q);
  } else {
    for (int ph = 0; ph < 9; ++ph) { q.ph_lo = ph; q.ph_hi = ph + 1; mk<<<256, NTHR, LDS_BYTES, stream>>>(q); }
  }
}
```
